# Optimizing an MI355X kernel written in HIP

```python
import math
import jax, jax.numpy as jnp
from jax import lax
import numpy as np

D_MODEL = 1024
BATCH = 8
SEQ = 4096
DEPTH = 1

EPS = 1e-6
SSD_HEAD_DIM = 64
D_SSD = D_MODEL
SSD_HEADS = D_SSD // SSD_HEAD_DIM
SSD_GROUPS = 2
SSD_STATE = 128
CONV_K = 4
SSD_CHUNK = 128
CONV_CH = D_SSD + 2 * SSD_GROUPS * SSD_STATE
ATTN_HEAD_DIM = 64
D_ATTN = D_MODEL
ATTN_Q_HEADS = D_ATTN // ATTN_HEAD_DIM
ATTN_KV_HEADS = 2
Q_PER_KV = ATTN_Q_HEADS // ATTN_KV_HEADS
D_KV = ATTN_KV_HEADS * ATTN_HEAD_DIM
WINDOW = 128
ATTN_SCALE = ATTN_HEAD_DIM ** -0.5
D_MIX = D_SSD + D_ATTN
SPLITS = (D_SSD,
          D_SSD + CONV_CH,
          D_SSD + CONV_CH + SSD_HEADS,
          D_SSD + CONV_CH + SSD_HEADS + D_ATTN,
          D_SSD + CONV_CH + SSD_HEADS + D_ATTN + D_KV)
IN_DIM = D_SSD + CONV_CH + SSD_HEADS + D_ATTN + 2 * D_KV
MOE_GROUPS = 8
EXPERTS_PER_GROUP = 8
N_EXPERTS = MOE_GROUPS * EXPERTS_PER_GROUP
TOP_K = 2
D_FF_EXPERT = D_MODEL // 2
MOE_BLOCK = 128

kernel_name = "hymba_ssd_swa_sink_hmoe_block"


def rmsnorm(x, g):
    xf = x.astype(jnp.float32)
    y = xf * lax.rsqrt(jnp.mean(xf * xf, axis=-1, keepdims=True) + EPS)
    return (y * g.astype(jnp.float32)).astype(x.dtype)


def causal_depthwise_conv(u, w, b):
    c = u.shape[-1]
    y = lax.conv_general_dilated(u, w[:, None, :], window_strides=(1,),
                                 padding=[(CONV_K - 1, 0)],
                                 dimension_numbers=("NWC", "WIO", "NWC"),
                                 feature_group_count=c)
    return y + b


def ssd_chunked(x, dt, A, B, C):
    b, s, h, p = x.shape
    g, n = B.shape[2], B.shape[3]
    r = h // g
    c = s // SSD_CHUNK
    L = SSD_CHUNK
    xc = x.reshape(b, c, L, g, r, p)
    dtc = dt.reshape(b, c, L, g, r)
    Bc = B.reshape(b, c, L, g, n)
    Cc = C.reshape(b, c, L, g, n)
    a = jnp.moveaxis(dtc * A.reshape(g, r), 2, -1)
    a_cs = jnp.cumsum(a, axis=-1)
    xdt = xc * dtc[..., None]
    idx = jnp.arange(L)
    causal = idx[:, None] >= idx[None, :]
    seg = a_cs[..., :, None] - a_cs[..., None, :]
    decay = jnp.exp(jnp.where(causal, seg, -jnp.inf))
    cb = jnp.einsum("bclgn,bcsgn->bcgls", Cc, Bc)
    y_diag = jnp.einsum("bcgls,bcgrls,bcsgrp->bclgrp", cb, decay, xdt)
    decay_to_end = jnp.exp(a_cs[..., -1:] - a_cs)
    states = jnp.einsum("bclgn,bcgrl,bclgrp->bcgrpn", Bc, decay_to_end, xdt)
    chunk_decay = jnp.exp(a_cs[..., -1])

    def step(carry, inp):
        st, dec = inp
        return carry * dec[..., None, None] + st, carry

    init = jnp.zeros((b, g, r, p, n), states.dtype)
    _, prev = lax.scan(step, init, (jnp.moveaxis(states, 1, 0), jnp.moveaxis(chunk_decay, 1, 0)))
    prev = jnp.moveaxis(prev, 0, 1)
    y_off = jnp.einsum("bclgn,bcgrpn,bcgrl->bclgrp", Cc, prev, jnp.exp(a_cs))
    return (y_diag + y_off).reshape(b, s, h, p)


def gated_group_rmsnorm(y, z, gain):
    u = y * jax.nn.silu(z.astype(jnp.float32))
    u = u.reshape(*y.shape[:-1], SSD_GROUPS, -1)
    u = u * lax.rsqrt(jnp.mean(u * u, axis=-1, keepdims=True) + EPS)
    return u.reshape(y.shape) * gain.astype(jnp.float32)


def swa_gqa_sinks(q, k, v, sinks):
    b, s = q.shape[0], q.shape[1]
    nb = s // WINDOW
    W = WINDOW
    qb = q.astype(jnp.float32).reshape(b, nb, W, ATTN_KV_HEADS, Q_PER_KV, ATTN_HEAD_DIM) * ATTN_SCALE
    kb = k.astype(jnp.float32).reshape(b, nb, W, ATTN_KV_HEADS, ATTN_HEAD_DIM)
    vb = v.astype(jnp.float32).reshape(b, nb, W, ATTN_KV_HEADS, ATTN_HEAD_DIM)
    pad = ((0, 0), (1, 0), (0, 0), (0, 0), (0, 0))
    kcat = jnp.concatenate([jnp.pad(kb, pad)[:, :-1], kb], axis=2)
    vcat = jnp.concatenate([jnp.pad(vb, pad)[:, :-1], vb], axis=2)
    scores = jnp.einsum("bnqhrd,bnkhd->bnhrqk", qb, kcat)
    qi = jnp.arange(W)[:, None]
    kj = jnp.arange(2 * W)[None, :]
    rel = qi + W - kj
    band = (rel >= 0) & (rel < WINDOW)
    blk = jnp.arange(nb)[:, None, None]
    valid = band[None] & ((blk > 0) | (kj >= W)[None])
    scores = jnp.where(valid[None, :, None, None], scores, -jnp.inf)
    sink = sinks.astype(jnp.float32).reshape(ATTN_KV_HEADS, Q_PER_KV)[None, None, :, :, None, None]
    m = jnp.maximum(jnp.max(scores, axis=-1, keepdims=True), sink)
    pr = jnp.exp(scores - m)
    denom = jnp.sum(pr, axis=-1, keepdims=True) + jnp.exp(sink - m)
    out = jnp.einsum("bnhrqk,bnkhd->bnqhrd", pr / denom, vcat)
    return out.reshape(b, s, ATTN_Q_HEADS * ATTN_HEAD_DIM)


def hybrid_mixer(h, w_in, conv_w, conv_b, dt_bias, a_log, d_skip, ssd_norm,
                 attn_sinks, attn_norm, w_out):
    b, s, _ = h.shape
    proj = h @ w_in
    z, xbc, dt_raw, q, k, v = jnp.split(proj, SPLITS, axis=-1)
    xbc = jax.nn.silu(causal_depthwise_conv(xbc, conv_w, conv_b)).astype(jnp.float32)
    xs, Bm, Cm = jnp.split(xbc, (D_SSD, D_SSD + SSD_GROUPS * SSD_STATE), axis=-1)
    xs = xs.reshape(b, s, SSD_HEADS, SSD_HEAD_DIM)
    dt = jax.nn.softplus(dt_raw.astype(jnp.float32) + dt_bias.astype(jnp.float32))
    A = -jnp.exp(a_log.astype(jnp.float32))
    y = ssd_chunked(xs, dt, A,
                    Bm.reshape(b, s, SSD_GROUPS, SSD_STATE),
                    Cm.reshape(b, s, SSD_GROUPS, SSD_STATE))
    y = y + xs * d_skip.astype(jnp.float32)[:, None]
    y_ssd = gated_group_rmsnorm(y.reshape(b, s, D_SSD), z, ssd_norm)
    att = swa_gqa_sinks(q.reshape(b, s, ATTN_Q_HEADS, ATTN_HEAD_DIM),
                        k.reshape(b, s, ATTN_KV_HEADS, ATTN_HEAD_DIM),
                        v.reshape(b, s, ATTN_KV_HEADS, ATTN_HEAD_DIM), attn_sinks)
    y_att = rmsnorm(att, attn_norm)
    mixed = jnp.concatenate([y_ssd, y_att], axis=-1).astype(h.dtype)
    return mixed @ w_out


def hierarchical_moe(h, w_router_group, w_router_expert, w_gate, w_up, w_down):
    b, s, d = h.shape
    t = h.reshape(-1, d)
    n = t.shape[0]
    rows = jnp.arange(n)
    group_logits = (t @ w_router_group).astype(jnp.float32)
    group_prob = jax.nn.softmax(group_logits, axis=-1)
    g_sel = jnp.argmax(group_logits, axis=-1)
    p_group = group_prob[rows, g_sel][:, None]
    exp_logits = (t @ w_router_expert).astype(jnp.float32).reshape(n, MOE_GROUPS, EXPERTS_PER_GROUP)
    in_group = exp_logits[rows, g_sel]
    top_logit, top_local = lax.top_k(in_group, TOP_K)
    gate = jax.nn.softmax(top_logit, axis=-1) * p_group
    expert_id = g_sel[:, None] * EXPERTS_PER_GROUP + top_local
    a = n * TOP_K
    flat_e = expert_id.reshape(-1)
    flat_g = gate.reshape(-1)
    order = jnp.argsort(flat_e)
    e_sorted = flat_e[order]
    tok_sorted = order // TOP_K
    counts = jnp.bincount(flat_e, length=N_EXPERTS)
    padded = ((counts + MOE_BLOCK - 1) // MOE_BLOCK) * MOE_BLOCK
    start = jnp.cumsum(counts) - counts
    pend = jnp.cumsum(padded)
    pstart = pend - padded
    dest = pstart[e_sorted] + jnp.arange(a) - start[e_sorted]
    n_blocks = -(-(a + N_EXPERTS * (MOE_BLOCK - 1)) // MOE_BLOCK)
    buf = jnp.zeros((n_blocks * MOE_BLOCK, d), t.dtype).at[dest].set(t[tok_sorted])
    block_expert = jnp.minimum(
        jnp.searchsorted(pend, jnp.arange(n_blocks) * MOE_BLOCK, side="right"), N_EXPERTS - 1)

    def expert_block(args):
        xb, e = args
        hid = jax.nn.silu(xb @ w_gate[e]) * (xb @ w_up[e])
        return hid @ w_down[e]

    y_buf = lax.map(expert_block, (buf.reshape(n_blocks, MOE_BLOCK, d), block_expert))
    y_buf = y_buf.reshape(-1, d)
    y = jnp.zeros_like(t).at[tok_sorted].add(y_buf[dest] * flat_g[order][:, None].astype(t.dtype))
    return y.reshape(b, s, d)


def setup_inputs(seed: int = 0) -> dict:
    key = jax.random.key(seed)
    ks = jax.random.split(key, 20)
    f32 = jnp.float32
    nrm = lambda k, shp, sc: jax.random.normal(k, shp, f32) * sc
    dt0 = jnp.exp(jax.random.uniform(ks[5], (DEPTH, SSD_HEADS), f32)
                  * (math.log(0.1) - math.log(1e-3)) + math.log(1e-3))
    return {
        "x": nrm(ks[0], (BATCH, SEQ, D_MODEL), 1.0),
        "norm_mix": 1.0 + nrm(ks[1], (DEPTH, D_MODEL), 0.02),
        "w_in": nrm(ks[2], (DEPTH, D_MODEL, IN_DIM), D_MODEL ** -0.5),
        "conv_w": nrm(ks[3], (DEPTH, CONV_K, CONV_CH), CONV_K ** -0.5),
        "conv_b": nrm(ks[4], (DEPTH, CONV_CH), 0.02),
        "dt_bias": dt0 + jnp.log(-jnp.expm1(-dt0)),
        "a_log": jnp.log(jax.random.uniform(ks[6], (DEPTH, SSD_HEADS), f32, 1.0, 16.0)),
        "d_skip": 1.0 + nrm(ks[7], (DEPTH, SSD_HEADS), 0.02),
        "ssd_norm": 1.0 + nrm(ks[8], (DEPTH, D_SSD), 0.02),
        "attn_sinks": nrm(ks[9], (DEPTH, ATTN_Q_HEADS), 0.5),
        "attn_norm": 1.0 + nrm(ks[10], (DEPTH, D_ATTN), 0.02),
        "w_out": nrm(ks[11], (DEPTH, D_MIX, D_MODEL), D_MIX ** -0.5),
        "norm_ffn": 1.0 + nrm(ks[12], (DEPTH, D_MODEL), 0.02),
        "w_router_group": nrm(ks[13], (DEPTH, D_MODEL, MOE_GROUPS), D_MODEL ** -0.5),
        "w_router_expert": nrm(ks[14], (DEPTH, D_MODEL, N_EXPERTS), D_MODEL ** -0.5),
        "w_gate": nrm(ks[15], (DEPTH, N_EXPERTS, D_MODEL, D_FF_EXPERT), D_MODEL ** -0.5),
        "w_up": nrm(ks[16], (DEPTH, N_EXPERTS, D_MODEL, D_FF_EXPERT), D_MODEL ** -0.5),
        "w_down": nrm(ks[17], (DEPTH, N_EXPERTS, D_FF_EXPERT, D_MODEL), D_FF_EXPERT ** -0.5),
        "norm_final": 1.0 + nrm(ks[18], (D_MODEL,), 0.02),
    }


def reference(x, norm_mix, w_in, conv_w, conv_b, dt_bias, a_log, d_skip, ssd_norm,
              attn_sinks, attn_norm, w_out, norm_ffn, w_router_group, w_router_expert,
              w_gate, w_up, w_down, norm_final):
    h = x
    for l in range(DEPTH):
        h = h + hybrid_mixer(rmsnorm(h, norm_mix[l]), w_in[l], conv_w[l], conv_b[l],
                             dt_bias[l], a_log[l], d_skip[l], ssd_norm[l],
                             attn_sinks[l], attn_norm[l], w_out[l])
        h = h + hierarchical_moe(rmsnorm(h, norm_ffn[l]), w_router_group[l],
                                 w_router_expert[l], w_gate[l], w_up[l], w_down[l])
    return rmsnorm(h, norm_final)
```

```cpp
#include <hip/hip_runtime.h>
#include <cstdio>
#include <cstdint>

#ifndef ONE_LAUNCH
#define ONE_LAUNCH 0
#endif

#define LAS __attribute__((address_space(3)))
typedef unsigned short bf16;
typedef float f32x4 __attribute__((ext_vector_type(4)));
typedef unsigned u32x4 __attribute__((ext_vector_type(4)));
typedef unsigned u32x2 __attribute__((ext_vector_type(2)));

constexpr int NB = 8, SEQ = 4096, DM = 1024, M = NB * SEQ;
constexpr int INDIM = 3856;
constexpr int NPROJ = 3840;
constexpr int PZ = 0, PX = 1024, PQ = 2560, PK = 3584, PV = 3712;
constexpr int DT0 = 2560;
constexpr int CONVCH = 1536;
constexpr int NH = 16, HD = 64, NST = 128, CHK = 128, NCH = SEQ / CHK;
constexpr int NE = 64, FF = 512, LISTCAP = 32768;
constexpr int SLOT_MAX = 81920;
constexpr float EPS = 1e-6f;

constexpr size_t MiB = 1u << 20;
constexpr size_t WS_CTL = 0, CTL_BYTES = 1 * MiB;
constexpr size_t WS_XN = 1 * MiB;
constexpr size_t WS_DT = 65 * MiB;
constexpr size_t WS_PROJ = 67 * MiB;
constexpr size_t WS_HID = WS_PROJ;
constexpr size_t WS_YB = WS_PROJ + 80 * MiB;
constexpr size_t WS_ST = 307 * MiB;
constexpr size_t WS_MIX = 371 * MiB;
constexpr size_t WS_MISC = 511 * MiB;
constexpr size_t WS_CDEC = WS_MISC;
constexpr size_t WS_TE = WS_MISC + 1 * MiB;
constexpr size_t WS_TP = WS_TE + 256 * 1024;
constexpr size_t WS_TG = WS_TP + 256 * 1024;
constexpr size_t WS_LIST = WS_MISC + 2 * MiB;
constexpr size_t WS_END = WS_LIST + 8 * MiB;
constexpr int CW_BAR = 4096;
constexpr int CW_CNT = 8192;

constexpr int NTHREADS = 512, NWAVES = 8;
constexpr int LDS_BYTES = 159744;
constexpr int MISC_OFF = LDS_BYTES - 256;

__device__ __forceinline__ unsigned f2bf(float f) { unsigned u = __builtin_bit_cast(unsigned, f); return (u + 0x7fffu + ((u >> 16) & 1u)) >> 16; }
__device__ __forceinline__ float bf2f(unsigned b) { return __builtin_bit_cast(float, (b & 0xffffu) << 16); }
__device__ __forceinline__ unsigned pk2(float lo, float hi) { return f2bf(lo) | (f2bf(hi) << 16); }
__device__ __forceinline__ float wave_sum(float v) {
#pragma unroll
    for (int o = 1; o < 64; o <<= 1) v += __shfl_xor(v, o);
    return v;
}
__device__ __forceinline__ float silu_f(float x) { return x / (1.0f + __expf(-x)); }
__device__ __forceinline__ float softplus_f(float x) { return x > 20.f ? x : log1pf(expf(x)); }

#define XB_TMO      128
#define XB_XCNT(j)  (256  + 64 * (j))
#define XB_XSUB(j)  (1280 + 64 * (j))
#define XB_XGEN(j)  (2304 + 64 * (j))
#define XB_TOP      3328
#define XB_TOPGEN   3392
#define XCD_BAR_WORDS 3456
#define XB_SPIN_CAP (1u << 27)
__device__ __forceinline__ unsigned xb_ld(unsigned* p)              { return __hip_atomic_load(p, __ATOMIC_RELAXED, __HIP_MEMORY_SCOPE_AGENT); }
__device__ __forceinline__ unsigned xb_add(unsigned* p, unsigned v) { return __hip_atomic_fetch_add(p, v, __ATOMIC_RELAXED, __HIP_MEMORY_SCOPE_AGENT); }
__device__ __forceinline__ unsigned xb_xcc_id() { return (unsigned)__builtin_amdgcn_s_getreg((3 << 11) | 20) & 0xFu; }
#define XB_SPIN(cond, bar) do { unsigned _sp = 0; while (cond) { __builtin_amdgcn_s_sleep(1); \
    if ((++_sp & 255u) == 0u) { if (xb_ld(&(bar)[XB_TMO])) break; if (_sp > XB_SPIN_CAP) { atomicAdd(&(bar)[XB_TMO], 1u); break; } } } } while (0)
struct XcdBarrier { unsigned* bar; unsigned x; volatile LAS unsigned* st; };
__device__ __forceinline__ XcdBarrier xcd_barrier_post(unsigned* bar, volatile LAS unsigned* st) {
    XcdBarrier b; b.bar = bar; b.x = xb_xcc_id(); b.st = st;
    if (threadIdx.x == 0) (void)xb_add(&bar[XB_XCNT(b.x)], 1u);
    return b;
}
__device__ __forceinline__ void xcd_barrier_complete(unsigned* bar, unsigned x, unsigned& nloc, unsigned& nx) {
    const unsigned G = gridDim.x * gridDim.y * gridDim.z;
    unsigned sum, cnt, mine, sp = 0u;
    for (;;) {
        sum = 0u; cnt = 0u; mine = 0u;
#pragma unroll
        for (unsigned j = 0; j < 16; ++j) { const unsigned c = xb_ld(&bar[XB_XCNT(j)]); sum += c; cnt += (c > 0u) ? 1u : 0u; mine = (j == x) ? c : mine; }
        if (sum == G) break;
        __builtin_amdgcn_s_sleep(1);
        if ((++sp & 255u) == 0u) { if (xb_ld(&bar[XB_TMO])) break; if (sp > XB_SPIN_CAP) { atomicAdd(&bar[XB_TMO], 1u); break; } }
    }
    nloc = mine > 0u ? mine : 1u; nx = cnt > 0u ? cnt : 1u;
}
__device__ __forceinline__ void xcd_barrier(const XcdBarrier& b) {
    asm volatile("s_waitcnt vmcnt(0)" ::: "memory");
    __syncthreads();
    if (threadIdx.x == 0) {
        unsigned* bar = b.bar;
        __builtin_amdgcn_s_waitcnt(0);
        unsigned nloc = b.st[0], nx = b.st[1];
        if (nloc == 0u) { xcd_barrier_complete(bar, b.x, nloc, nx); b.st[0] = nloc; b.st[1] = nx; }
        const unsigned old = xb_add(&bar[XB_XSUB(b.x)], 1u);
        const unsigned gen = old / nloc;
        if (old + 1u == (gen + 1u) * nloc) {
            __builtin_amdgcn_fence(__ATOMIC_RELEASE, "agent");
            asm volatile("s_waitcnt vmcnt(0)" ::: "memory");
            const unsigned og = xb_add(&bar[XB_TOP], 1u);
            const unsigned tg = og / nx;
            if (og + 1u == (tg + 1u) * nx) xb_add(&bar[XB_TOPGEN], 1u);
            else XB_SPIN(xb_ld(&bar[XB_TOPGEN]) == tg, bar);
            __builtin_amdgcn_fence(__ATOMIC_ACQUIRE, "agent");
            xb_add(&bar[XB_XGEN(b.x)], 1u);
            asm volatile("s_waitcnt vmcnt(0)" ::: "memory");
        } else {
            XB_SPIN(xb_ld(&bar[XB_XGEN(b.x)]) == gen, bar);
            __builtin_amdgcn_fence(__ATOMIC_ACQUIRE, "agent");
            asm volatile("s_waitcnt vmcnt(0)" ::: "memory");
        }
    }
    __syncthreads();
}

struct Args { const float* in[19]; float* out; unsigned char* ws; int ph_lo, ph_hi; };
struct Ctx {
    unsigned char* lds; int tid, lane, wave, G, bid;
    const float *x, *norm_mix, *w_in, *conv_w, *conv_b, *dt_bias, *a_log, *d_skip, *ssd_norm, *sinks, *attn_norm, *w_out, *norm_ffn, *w_rg, *w_re, *w_gate, *w_up, *w_down, *norm_final;
    float* out; unsigned char* ws;
    bf16 *XN, *PROJ, *HID, *YB, *ST, *MIX; float *DT, *CDEC, *TG; int *TE, *TP, *LIST; unsigned* ctl;
};

template <class RowPtr>
__device__ __forceinline__ void ngemm128(Ctx& C, RowPtr arow, const float* Bm, int ldb, int K, float (&acc)[8][4]) {
    float* As = (float*)C.lds;
    float* Bs = As + 32 * 132;
    const int tid = C.tid, tx = tid & 31, ty = tid >> 5;
#pragma unroll
    for (int i = 0; i < 8; ++i)
#pragma unroll
        for (int j = 0; j < 4; ++j) acc[i][j] = 0.f;
    const int am = tid >> 2, akc = (tid & 3) * 8;
    const bf16* ap = arow(am) + akc;
    const int bk = tid >> 4, bn = (tid & 15) * 8;
    for (int k0 = 0; k0 < K; k0 += 32) {
        const u32x4 av = *(const u32x4*)(ap + k0);
        const f32x4 b0 = *(const f32x4*)(Bm + (size_t)(k0 + bk) * ldb + bn);
        const f32x4 b1 = *(const f32x4*)(Bm + (size_t)(k0 + bk) * ldb + bn + 4);
        __syncthreads();
#pragma unroll
        for (int i = 0; i < 4; ++i) { As[(akc + 2 * i) * 132 + am] = bf2f(av[i]); As[(akc + 2 * i + 1) * 132 + am] = bf2f(av[i] >> 16); }
        *(f32x4*)(Bs + bk * 132 + bn) = b0; *(f32x4*)(Bs + bk * 132 + bn + 4) = b1;
        __syncthreads();
#pragma unroll 8
        for (int kk = 0; kk < 32; ++kk) {
            const f32x4 a0 = *(const f32x4*)(As + kk * 132 + ty * 8), a1 = *(const f32x4*)(As + kk * 132 + ty * 8 + 4);
            const f32x4 b = *(const f32x4*)(Bs + kk * 132 + tx * 4);
#pragma unroll
            for (int j = 0; j < 4; ++j) {
                acc[0][j] += a0[0] * b[j]; acc[1][j] += a0[1] * b[j]; acc[2][j] += a0[2] * b[j]; acc[3][j] += a0[3] * b[j];
                acc[4][j] += a1[0] * b[j]; acc[5][j] += a1[1] * b[j]; acc[6][j] += a1[2] * b[j]; acc[7][j] += a1[3] * b[j];
            }
        }
    }
    __syncthreads();
}

__device__ __forceinline__ float conv_silu(const Ctx& C, int b, int t, int ch) {
    float acc = C.conv_b[ch];
#pragma unroll
    for (int j = 0; j < 4; ++j) { const int tt = t - 3 + j; if (tt >= 0) acc += C.conv_w[j * CONVCH + ch] * bf2f(C.PROJ[(size_t)(b * SEQ + tt) * NPROJ + PX + ch]); }
    return silu_f(acc);
}

__device__ __forceinline__ void phase_prologue(Ctx& C) {
    float* W = (float*)C.lds;
    for (int idx = C.tid; idx < 16 * 1024; idx += NTHREADS) { const int k = idx >> 4, j = idx & 15; W[j * 1024 + k] = C.w_in[(size_t)k * INDIM + DT0 + j]; }
    __syncthreads();
    const int gw = C.bid * NWAVES + C.wave, NGW = C.G * NWAVES;
    for (int row = gw; row < M; row += NGW) {
        const f32x4* xr = (const f32x4*)(C.x + (size_t)row * DM) + C.lane;
        f32x4 v[4]; float ss = 0.f;
#pragma unroll
        for (int j = 0; j < 4; ++j) { v[j] = xr[64 * j]; ss += v[j][0] * v[j][0] + v[j][1] * v[j][1] + v[j][2] * v[j][2] + v[j][3] * v[j][3]; }
        const float rstd = 1.0f / sqrtf(wave_sum(ss) * (1.0f / DM) + EPS);
        u32x2* o = (u32x2*)(C.XN + (size_t)row * DM) + C.lane;
#pragma unroll
        for (int j = 0; j < 4; ++j) { const f32x4 g = ((const f32x4*)C.norm_mix)[C.lane + 64 * j]; v[j] = v[j] * rstd * g; u32x2 w; w.x = pk2(v[j][0], v[j][1]); w.y = pk2(v[j][2], v[j][3]); o[64 * j] = w; }
        float mine = 0.f;
#pragma unroll 2
        for (int jj = 0; jj < 16; ++jj) {
            float p = 0.f;
#pragma unroll
            for (int j = 0; j < 4; ++j) { const f32x4 w4 = *(const f32x4*)(W + jj * 1024 + (C.lane + 64 * j) * 4); p += v[j][0] * w4[0] + v[j][1] * w4[1] + v[j][2] * w4[2] + v[j][3] * w4[3]; }
            p = wave_sum(p);
            if (C.lane == jj) mine = p;
        }
        if (C.lane < 16) C.DT[(size_t)row * 16 + C.lane] = softplus_f(mine + C.dt_bias[C.lane]);
    }
}

__device__ __forceinline__ void phase_gemm1(Ctx& C) {
    constexpr int NT = NPROJ / 128;
    const int tx = C.tid & 31, ty = C.tid >> 5;
    for (int u = C.bid; u < (M / 128) * NT; u += C.G) {
        const int mt = u / NT, nt = u % NT, n0 = nt * 128, bcol0 = n0 < DT0 ? n0 : n0 + 16;
        float acc[8][4];
        const bf16* A = C.XN + (size_t)mt * 128 * DM;
        ngemm128(C, [&](int m) { return A + (size_t)m * DM; }, C.w_in + bcol0, INDIM, DM, acc);
#pragma unroll
        for (int i = 0; i < 8; ++i) { u32x2 w; w.x = pk2(acc[i][0], acc[i][1]); w.y = pk2(acc[i][2], acc[i][3]);
            *(u32x2*)(C.PROJ + (size_t)(mt * 128 + ty * 8 + i) * NPROJ + n0 + tx * 4) = w; }
    }
}

__device__ __forceinline__ void ssd_states_unit(Ctx& C, int u) {
    const int g = u & 1, c = (u >> 1) & 31, b = u >> 6;
    float* Bs = (float*)C.lds;
    float* xs = Bs + 128 * 128;
    float* dtl = xs + 128 * 64;
    float* acs = dtl + 128;
    float* wl = acs + 128;
    const int t0 = c * CHK;
    __syncthreads();
    for (int idx = C.tid; idx < 128 * 128; idx += NTHREADS) { const int l = idx >> 7, n = idx & 127; Bs[idx] = conv_silu(C, b, t0 + l, 1024 + g * 128 + n); }
    for (int r = 0; r < 8; ++r) {
        const int h = g * 8 + r;
        __syncthreads();
        if (C.tid < 128) dtl[C.tid] = C.DT[(size_t)(b * SEQ + t0 + C.tid) * 16 + h];
        __syncthreads();
        if (C.tid == 0) { const float A = -expf(C.a_log[h]); float run = 0.f; for (int l = 0; l < 128; ++l) { run += dtl[l] * A; acs[l] = run; } }
        __syncthreads();
        if (C.tid < 128) wl[C.tid] = dtl[C.tid] * expf(acs[127] - acs[C.tid]);
        for (int idx = C.tid; idx < 128 * 64; idx += NTHREADS) { const int l = idx >> 6, p = idx & 63; xs[idx] = conv_silu(C, b, t0 + l, h * 64 + p); }
        __syncthreads();
        const int n = C.tid & 127, pg = C.tid >> 7;
        float acc[16];
#pragma unroll
        for (int i = 0; i < 16; ++i) acc[i] = 0.f;
        for (int l = 0; l < 128; ++l) {
            const float bv = Bs[l * 128 + n] * wl[l];
#pragma unroll
            for (int i = 0; i < 16; ++i) acc[i] += xs[l * 64 + pg * 16 + i] * bv;
        }
        bf16* st = C.ST + ((size_t)((b * NCH + c) * NH + h)) * (HD * NST);
#pragma unroll
        for (int i = 0; i < 16; ++i) st[(pg * 16 + i) * NST + n] = (bf16)f2bf(acc[i]);
        if (C.tid == 0) C.CDEC[(b * NCH + c) * NH + h] = expf(acs[127]);
    }
    __syncthreads();
}

__device__ __forceinline__ void attn_unit(Ctx& C, int u) {
    const int blk = u & 31, b = u >> 5;
    float* Ks = (float*)C.lds;
    float* Vs = Ks + 256 * 68;
    float* ssq = Vs + 256 * 68;
    const int t0 = blk * 128;
    __syncthreads();
    if (C.tid < 128) ssq[C.tid] = 0.f;
    for (int kv = 0; kv < 2; ++kv) {
        __syncthreads();
        for (int idx = C.tid; idx < 256 * 64; idx += NTHREADS) {
            const int key = idx >> 6, d = idx & 63, t = t0 - 128 + key;
            float kvv = 0.f, vvv = 0.f;
            if (t >= 0) { const bf16* pr = C.PROJ + (size_t)(b * SEQ + t) * NPROJ; kvv = bf2f(pr[PK + kv * 64 + d]); vvv = bf2f(pr[PV + kv * 64 + d]); }
            Ks[key * 68 + d] = kvv; Vs[key * 68 + d] = vvv;
        }
        __syncthreads();
        for (int pr2 = 0; pr2 < 2; ++pr2) {
            const int pair = pr2 * 512 + C.tid, r = pair >> 7, qi = pair & 127, hq = kv * 8 + r;
            const bf16* qp = C.PROJ + (size_t)(b * SEQ + t0 + qi) * NPROJ + PQ + hq * 64;
            unsigned qw[32]; float o[64];
#pragma unroll
            for (int d = 0; d < 32; ++d) { qw[d] = *(const unsigned*)(qp + 2 * d); }
#pragma unroll
            for (int d = 0; d < 64; ++d) o[d] = 0.f;
            float m = C.sinks[hq], l = 1.0f;
            for (int j = 1; j <= 128; ++j) {
                const int key = qi + j;
                if (t0 - 128 + key < 0) continue;
                const float* kr = Ks + key * 68; const float* vr = Vs + key * 68;
                float s = 0.f;
#pragma unroll
                for (int d = 0; d < 64; d += 4) { const f32x4 k4 = *(const f32x4*)(kr + d); s += bf2f(qw[d >> 1]) * k4[0] + bf2f(qw[d >> 1] >> 16) * k4[1] + bf2f(qw[(d >> 1) + 1]) * k4[2] + bf2f(qw[(d >> 1) + 1] >> 16) * k4[3]; }
                s *= 0.125f;
                if (s > m) { const float al = expf(m - s); l *= al;
#pragma unroll
                    for (int d = 0; d < 64; ++d) o[d] *= al;
                    m = s; }
                const float p = expf(s - m); l += p;
#pragma unroll
                for (int d = 0; d < 64; d += 4) { const f32x4 v4 = *(const f32x4*)(vr + d); o[d] += p * v4[0]; o[d + 1] += p * v4[1]; o[d + 2] += p * v4[2]; o[d + 3] += p * v4[3]; }
            }
            const float inv = 1.0f / l; float sq = 0.f;
            bf16* op = C.MIX + (size_t)(b * SEQ + t0 + qi) * 2048 + 1024 + hq * 64;
#pragma unroll
            for (int d = 0; d < 64; d += 2) { const float a0 = o[d] * inv, a1 = o[d + 1] * inv; sq += a0 * a0 + a1 * a1; *(unsigned*)(op + d) = pk2(a0, a1); }
            atomicAdd(&ssq[qi], sq);
        }
    }
    __syncthreads();
    for (int idx = C.tid; idx < 128 * 512; idx += NTHREADS) {
        const int qi = idx >> 9, c2 = (idx & 511) * 2;
        const float rs = 1.0f / sqrtf(ssq[qi] * (1.0f / 1024.f) + EPS);
        unsigned* p = (unsigned*)(C.MIX + (size_t)(b * SEQ + t0 + qi) * 2048 + 1024 + c2);
        const unsigned w = *p;
        *p = pk2(bf2f(w) * rs * C.attn_norm[c2], bf2f(w >> 16) * rs * C.attn_norm[c2 + 1]);
    }
    __syncthreads();
}

__device__ __forceinline__ void phase_scan(Ctx& C) {
    const int total = NB * NH * HD * NST;
    for (int e = C.bid * NTHREADS + C.tid; e < total; e += C.G * NTHREADS) {
        const int pn = e & (HD * NST - 1), h = (e >> 13) & 15, b = e >> 17;
        float carry = 0.f;
        for (int c = 0; c < NCH; ++c) {
            bf16* p = C.ST + ((size_t)((b * NCH + c) * NH + h)) * (HD * NST) + pn;
            const float s = bf2f(*p), dec = C.CDEC[(b * NCH + c) * NH + h];
            *p = (bf16)f2bf(carry);
            carry = carry * dec + s;
        }
    }
}

__device__ __forceinline__ void ssd_out_unit(Ctx& C, int u) {
    const int g = u & 1, c = (u >> 1) & 31, b = u >> 6;
    bf16* Cs = (bf16*)C.lds;
    bf16* Bs = Cs + 128 * 130;
    float* xs = (float*)Bs;
    float* cb = (float*)(C.lds + 2 * 33280);
    bf16* pv = (bf16*)(C.lds + 2 * 33280 + 65536);
    float* dts = (float*)(C.lds + 2 * 33280 + 65536 + 16640);
    float* acs = dts + 128; float* ssl = acs + 128; float* rsl = ssl + 128;
    const int t0 = c * CHK;
    __syncthreads();
    for (int idx = C.tid; idx < 128 * 128; idx += NTHREADS) { const int l = idx >> 7, n = idx & 127;
        Bs[l * 130 + n] = (bf16)f2bf(conv_silu(C, b, t0 + l, 1024 + g * 128 + n));
        Cs[l * 130 + n] = (bf16)f2bf(conv_silu(C, b, t0 + l, 1280 + g * 128 + n)); }
    if (C.tid < 128) ssl[C.tid] = 0.f;
    __syncthreads();
    {
        const int s = C.tid & 127, lg = C.tid >> 7;
        float acc[32];
#pragma unroll
        for (int i = 0; i < 32; ++i) acc[i] = 0.f;
        for (int n = 0; n < 128; ++n) { const float bv = bf2f(Bs[s * 130 + n]);
#pragma unroll
            for (int i = 0; i < 32; ++i) acc[i] += bf2f(Cs[(lg * 32 + i) * 130 + n]) * bv; }
#pragma unroll
        for (int i = 0; i < 32; ++i) cb[(lg * 32 + i) * 128 + s] = acc[i];
    }
    for (int r = 0; r < 8; ++r) {
        const int h = g * 8 + r;
        __syncthreads();
        if (C.tid < 128) dts[C.tid] = C.DT[(size_t)(b * SEQ + t0 + C.tid) * 16 + h];
        __syncthreads();
        if (C.tid == 0) { const float A = -expf(C.a_log[h]); float run = 0.f; for (int l = 0; l < 128; ++l) { run += dts[l] * A; acs[l] = run; } }
        for (int idx = C.tid; idx < 128 * 64; idx += NTHREADS) { const int l = idx >> 6, p = idx & 63; xs[idx] = conv_silu(C, b, t0 + l, h * 64 + p); }
        { const bf16* st = C.ST + ((size_t)((b * NCH + c) * NH + h)) * (HD * NST);
          for (int idx = C.tid; idx < 64 * 128; idx += NTHREADS) { const int p = idx >> 7, n = idx & 127; pv[p * 130 + n] = st[idx]; } }
        __syncthreads();
        const int p = C.tid & 63, lg = C.tid >> 6;
        const float dsk = C.d_skip[h];
        for (int i = 0; i < 16; ++i) {
            const int l = lg * 16 + i;
            float acc = 0.f;
            for (int s = 0; s <= l; ++s) acc += cb[l * 128 + s] * __expf(acs[l] - acs[s]) * dts[s] * xs[s * 64 + p];
            float off = 0.f;
            for (int n = 0; n < 128; ++n) off += bf2f(Cs[l * 130 + n]) * bf2f(pv[p * 130 + n]);
            const float y = acc + __expf(acs[l]) * off + dsk * xs[l * 64 + p];
            const size_t row = (size_t)(b * SEQ + t0 + l);
            const float z = bf2f(C.PROJ[row * NPROJ + PZ + h * 64 + p]);
            const float uu = y * silu_f(z);
            C.MIX[row * 2048 + h * 64 + p] = (bf16)f2bf(uu);
            const float sq = wave_sum(uu * uu);
            if (C.lane == 0) ssl[l] += sq;
        }
    }
    __syncthreads();
    if (C.tid < 128) rsl[C.tid] = 1.0f / sqrtf(ssl[C.tid] * (1.0f / 512.f) + EPS);
    __syncthreads();
    for (int idx = C.tid; idx < 128 * 256; idx += NTHREADS) {
        const int l = idx >> 8, c2 = (idx & 255) * 2, col = g * 512 + c2;
        unsigned* p = (unsigned*)(C.MIX + (size_t)(b * SEQ + t0 + l) * 2048 + col);
        const unsigned w = *p;
        *p = pk2(bf2f(w) * rsl[l] * C.ssd_norm[col], bf2f(w >> 16) * rsl[l] * C.ssd_norm[col + 1]);
    }
    __syncthreads();
}

__device__ __forceinline__ void phase_gemm2(Ctx& C) {
    const int tx = C.tid & 31, ty = C.tid >> 5;
    for (int u = C.bid; u < (M / 128) * 8; u += C.G) {
        const int mt = u >> 3, nt = u & 7;
        float acc[8][4];
        const bf16* A = C.MIX + (size_t)mt * 128 * 2048;
        ngemm128(C, [&](int m) { return A + (size_t)m * 2048; }, C.w_out + nt * 128, DM, 2048, acc);
#pragma unroll
        for (int i = 0; i < 8; ++i) { const size_t off = (size_t)(mt * 128 + ty * 8 + i) * DM + nt * 128 + tx * 4;
            const f32x4 xv = *(const f32x4*)(C.x + off); f32x4 o; o[0] = xv[0] + acc[i][0]; o[1] = xv[1] + acc[i][1]; o[2] = xv[2] + acc[i][2]; o[3] = xv[3] + acc[i][3];
            *(f32x4*)(C.out + off) = o; }
    }
}

__device__ __forceinline__ void phase_router(Ctx& C) {
    float* T = (float*)C.lds + C.wave * 4096;
    const int gw = C.bid * NWAVES + C.wave, NGW = C.G * NWAVES;
    unsigned* cnt = C.ctl + CW_CNT;
    for (int r0 = gw * 4; r0 < M; r0 += NGW * 4) {
#pragma unroll
        for (int r = 0; r < 4; ++r) {
            const int row = r0 + r;
            const f32x4* hr = (const f32x4*)(C.out + (size_t)row * DM) + C.lane;
            f32x4 v[4]; float ss = 0.f;
#pragma unroll
            for (int j = 0; j < 4; ++j) { v[j] = hr[64 * j]; ss += v[j][0] * v[j][0] + v[j][1] * v[j][1] + v[j][2] * v[j][2] + v[j][3] * v[j][3]; }
            const float rstd = 1.0f / sqrtf(wave_sum(ss) * (1.0f / DM) + EPS);
            u32x2* o = (u32x2*)(C.XN + (size_t)row * DM) + C.lane;
#pragma unroll
            for (int j = 0; j < 4; ++j) { const f32x4 g = ((const f32x4*)C.norm_ffn)[C.lane + 64 * j]; v[j] = v[j] * rstd * g;
                u32x2 w; w.x = pk2(v[j][0], v[j][1]); w.y = pk2(v[j][2], v[j][3]); o[64 * j] = w;
                *(f32x4*)(T + r * 1024 + (C.lane + 64 * j) * 4) = v[j]; }
        }
        asm volatile("s_waitcnt lgkmcnt(0)" ::: "memory");
        float ae[4] = {0.f, 0.f, 0.f, 0.f}, ag[4] = {0.f, 0.f, 0.f, 0.f};
        for (int k = 0; k < DM; ++k) { const float w = C.w_re[k * 64 + C.lane];
#pragma unroll
            for (int r = 0; r < 4; ++r) ae[r] += T[r * 1024 + k] * w; }
        { const int col = C.lane & 7, ks = C.lane >> 3;
          for (int kk = 0; kk < 128; ++kk) { const int k = ks * 128 + kk; const float w = C.w_rg[k * 8 + col];
#pragma unroll
              for (int r = 0; r < 4; ++r) ag[r] += T[r * 1024 + k] * w; }
#pragma unroll
          for (int r = 0; r < 4; ++r) { ag[r] += __shfl_xor(ag[r], 8); ag[r] += __shfl_xor(ag[r], 16); ag[r] += __shfl_xor(ag[r], 32); } }
#pragma unroll
        for (int r = 0; r < 4; ++r) {
            const int row = r0 + r;
            float gl[8]; int gsel = 0; float gmax;
#pragma unroll
            for (int c2 = 0; c2 < 8; ++c2) gl[c2] = __shfl(ag[r], c2);
            gmax = gl[0];
#pragma unroll
            for (int c2 = 1; c2 < 8; ++c2) if (gl[c2] > gmax) { gmax = gl[c2]; gsel = c2; }
            float gsum = 0.f;
#pragma unroll
            for (int c2 = 0; c2 < 8; ++c2) gsum += expf(gl[c2] - gmax);
            const float pgrp = 1.0f / gsum;
            float el[8];
#pragma unroll
            for (int i = 0; i < 8; ++i) el[i] = __shfl(ae[r], gsel * 8 + i);
            int i0 = 0; float l0 = el[0];
#pragma unroll
            for (int i = 1; i < 8; ++i) if (el[i] > l0) { l0 = el[i]; i0 = i; }
            int i1 = -1; float l1 = -INFINITY;
#pragma unroll
            for (int i = 0; i < 8; ++i) if (i != i0 && el[i] > l1) { l1 = el[i]; i1 = i; }
            const float e1 = expf(l1 - l0), g0 = pgrp / (1.0f + e1), g1 = pgrp * e1 / (1.0f + e1);
            if (C.lane == 0) {
#pragma unroll
                for (int k = 0; k < 2; ++k) { const int e = gsel * 8 + (k == 0 ? i0 : i1);
                    const unsigned pos = atomicAdd(&cnt[e], 1u);
                    C.TE[row * 2 + k] = e; C.TP[row * 2 + k] = (int)pos; C.TG[row * 2 + k] = (k == 0 ? g0 : g1);
                    C.LIST[(size_t)e * LISTCAP + pos] = row * 2 + k; }
            }
        }
    }
}

struct MoeTab { int* cnt; int* pstart; int* tstart; };
__device__ __forceinline__ MoeTab moe_tables(Ctx& C, int off) {
    MoeTab T; T.cnt = (int*)(C.lds + off); T.pstart = T.cnt + 64; T.tstart = T.pstart + 65;
    __syncthreads();
    if (C.tid < 64) T.cnt[C.tid] = (int)__hip_atomic_load(C.ctl + CW_CNT + C.tid, __ATOMIC_RELAXED, __HIP_MEMORY_SCOPE_AGENT);
    __syncthreads();
    if (C.tid == 0) { int ps = 0, ts = 0; for (int e = 0; e < 64; ++e) { T.pstart[e] = ps; T.tstart[e] = ts; ps += ((T.cnt[e] + 255) >> 8) << 8; ts += (T.cnt[e] + 127) >> 7; } T.pstart[64] = ps; T.tstart[64] = ts; }
    __syncthreads();
    return T;
}

__device__ __forceinline__ void phase_moe_a(Ctx& C) {
    const MoeTab T = moe_tables(C, 2 * 32 * 132 * 4);
    const int tx = C.tid & 31, ty = C.tid >> 5, ntiles = T.tstart[64];
    for (int u = C.bid; u < ntiles * 4; u += C.G) {
        const int tile = u >> 2, nt = u & 3;
        int e = 0; while (T.tstart[e + 1] <= tile) ++e;
        const int mt = tile - T.tstart[e], ce = T.cnt[e];
        const int* lst = C.LIST + (size_t)e * LISTCAP;
        auto arow = [&](int m) { const int pos = mt * 128 + m; const int tok = pos < ce ? (lst[pos] >> 1) : 0; return C.XN + (size_t)tok * DM; };
        float ag[8][4], au[8][4];
        ngemm128(C, arow, C.w_gate + (size_t)e * DM * FF + nt * 128, FF, DM, ag);
        ngemm128(C, arow, C.w_up + (size_t)e * DM * FF + nt * 128, FF, DM, au);
#pragma unroll
        for (int i = 0; i < 8; ++i) { const size_t slot = (size_t)T.pstart[e] + mt * 128 + ty * 8 + i;
            u32x2 w; w.x = pk2(silu_f(ag[i][0]) * au[i][0], silu_f(ag[i][1]) * au[i][1]); w.y = pk2(silu_f(ag[i][2]) * au[i][2], silu_f(ag[i][3]) * au[i][3]);
            *(u32x2*)(C.HID + slot * FF + nt * 128 + tx * 4) = w; }
    }
}
__device__ __forceinline__ void phase_moe_b(Ctx& C) {
    const MoeTab T = moe_tables(C, 2 * 32 * 132 * 4);
    const int tx = C.tid & 31, ty = C.tid >> 5, ntiles = T.tstart[64];
    for (int u = C.bid; u < ntiles * 8; u += C.G) {
        const int tile = u >> 3, nt = u & 7;
        int e = 0; while (T.tstart[e + 1] <= tile) ++e;
        const int mt = tile - T.tstart[e], ce = T.cnt[e];
        const int* lst = C.LIST + (size_t)e * LISTCAP;
        const bf16* A = C.HID + ((size_t)T.pstart[e] + mt * 128) * FF;
        float acc[8][4];
        ngemm128(C, [&](int m) { return A + (size_t)m * FF; }, C.w_down + (size_t)e * FF * DM + nt * 128, DM, FF, acc);
#pragma unroll
        for (int i = 0; i < 8; ++i) { const int pos = mt * 128 + ty * 8 + i;
            if (pos < ce) { const float gt = C.TG[lst[pos]]; const size_t slot = (size_t)T.pstart[e] + pos;
                u32x2 w; w.x = pk2(acc[i][0] * gt, acc[i][1] * gt); w.y = pk2(acc[i][2] * gt, acc[i][3] * gt);
                *(u32x2*)(C.YB + slot * DM + nt * 128 + tx * 4) = w; } }
    }
}
__device__ __forceinline__ void phase_final(Ctx& C) {
    const MoeTab T = moe_tables(C, 0);
    const int gw = C.bid * NWAVES + C.wave, NGW = C.G * NWAVES;
    for (int row = gw; row < M; row += NGW) {
        const size_t s0 = (size_t)T.pstart[C.TE[row * 2]] + C.TP[row * 2], s1 = (size_t)T.pstart[C.TE[row * 2 + 1]] + C.TP[row * 2 + 1];
        f32x4* hr = (f32x4*)(C.out + (size_t)row * DM) + C.lane;
        const u32x2* y0 = (const u32x2*)(C.YB + s0 * DM) + C.lane; const u32x2* y1 = (const u32x2*)(C.YB + s1 * DM) + C.lane;
        f32x4 v[4]; float ss = 0.f;
#pragma unroll
        for (int j = 0; j < 4; ++j) { v[j] = hr[64 * j]; const u32x2 a = y0[64 * j], c = y1[64 * j];
            v[j][0] += bf2f(a.x) + bf2f(c.x); v[j][1] += bf2f(a.x >> 16) + bf2f(c.x >> 16); v[j][2] += bf2f(a.y) + bf2f(c.y); v[j][3] += bf2f(a.y >> 16) + bf2f(c.y >> 16);
            ss += v[j][0] * v[j][0] + v[j][1] * v[j][1] + v[j][2] * v[j][2] + v[j][3] * v[j][3]; }
        const float rstd = 1.0f / sqrtf(wave_sum(ss) * (1.0f / DM) + EPS);
#pragma unroll
        for (int j = 0; j < 4; ++j) { const f32x4 g = ((const f32x4*)C.norm_final)[C.lane + 64 * j]; hr[64 * j] = v[j] * rstd * g; }
    }
}

constexpr int NPHASE = 10;
__global__ void __launch_bounds__(NTHREADS, 2) fwd_kernel(Args args) {
    extern __shared__ __attribute__((aligned(16))) unsigned char lds[];
    Ctx C;
    C.lds = lds; C.tid = threadIdx.x; C.lane = C.tid & 63; C.wave = __builtin_amdgcn_readfirstlane(C.tid >> 6); C.G = gridDim.x; C.bid = blockIdx.x;
    C.x = args.in[0]; C.norm_mix = args.in[1]; C.w_in = args.in[2]; C.conv_w = args.in[3]; C.conv_b = args.in[4]; C.dt_bias = args.in[5]; C.a_log = args.in[6]; C.d_skip = args.in[7];
    C.ssd_norm = args.in[8]; C.sinks = args.in[9]; C.attn_norm = args.in[10]; C.w_out = args.in[11]; C.norm_ffn = args.in[12]; C.w_rg = args.in[13]; C.w_re = args.in[14];
    C.w_gate = args.in[15]; C.w_up = args.in[16]; C.w_down = args.in[17]; C.norm_final = args.in[18];
    C.out = args.out; C.ws = args.ws;
    unsigned char* ws = args.ws;
    C.ctl = (unsigned*)(ws + WS_CTL);
    C.XN = (bf16*)(ws + WS_XN); C.DT = (float*)(ws + WS_DT); C.PROJ = (bf16*)(ws + WS_PROJ); C.HID = (bf16*)(ws + WS_HID); C.YB = (bf16*)(ws + WS_YB);
    C.ST = (bf16*)(ws + WS_ST); C.MIX = (bf16*)(ws + WS_MIX); C.CDEC = (float*)(ws + WS_CDEC); C.TE = (int*)(ws + WS_TE); C.TP = (int*)(ws + WS_TP); C.TG = (float*)(ws + WS_TG);
    C.LIST = (int*)(ws + WS_LIST);
    volatile LAS unsigned* MISC = (volatile LAS unsigned*)((LAS unsigned char*)lds + MISC_OFF);
    if (C.tid < 64) MISC[C.tid] = 0u;
    __syncthreads();
    XcdBarrier bar; bar.bar = C.ctl + CW_BAR; bar.x = 0; bar.st = nullptr;
#if ONE_LAUNCH
    bar = xcd_barrier_post(C.ctl + CW_BAR, MISC + 8);
#define GRID_BAR() xcd_barrier(bar)
#else
#define GRID_BAR() do {} while (0)
#endif
    const int lo = args.ph_lo, hi = args.ph_hi;
#define IN(k) (lo <= (k) && (k) < hi)
#define SEAM(k) do { if (IN(k) && IN((k) + 1)) GRID_BAR(); } while (0)
    if (IN(0)) { phase_prologue(C); } SEAM(0);
    if (IN(1)) { phase_gemm1(C); } SEAM(1);
    if (IN(2)) { for (int u = C.bid; u < NB * NCH * 2; u += C.G) ssd_states_unit(C, u); for (int u = C.bid; u < NB * 32; u += C.G) attn_unit(C, u); } SEAM(2);
    if (IN(3)) { phase_scan(C); } SEAM(3);
    if (IN(4)) { for (int u = C.bid; u < NB * NCH * 2; u += C.G) ssd_out_unit(C, u); } SEAM(4);
    if (IN(5)) { phase_gemm2(C); } SEAM(5);
    if (IN(6)) { phase_router(C); } SEAM(6);
    if (IN(7)) { phase_moe_a(C); } SEAM(7);
    if (IN(8)) { phase_moe_b(C); } SEAM(8);
    if (IN(9)) { phase_final(C); }
}

extern "C" void kernel_launch(void* const* d_in, const int* in_sizes, int n_in, void* d_out, int out_size, void* d_ws, size_t ws_size, hipStream_t stream) {
    static int grid = 0;
    if (grid == 0) {
        if (n_in != 19 || in_sizes[0] != M * DM || out_size != M * DM || ws_size < WS_END) { fprintf(stderr, "kernel_launch: unexpected shapes (n_in %d, in0 %d, out %d, ws %zu)\n", n_in, n_in > 0 ? in_sizes[0] : -1, out_size, ws_size); grid = -1; return; }
        int dev = 0, cus = 0, per_cu = 0;
        if (hipGetDevice(&dev) != hipSuccess || hipDeviceGetAttribute(&cus, hipDeviceAttributeMultiprocessorCount, dev) != hipSuccess) { grid = -1; return; }
        if (hipFuncSetAttribute((const void*)fwd_kernel, hipFuncAttributeMaxDynamicSharedMemorySize, LDS_BYTES) != hipSuccess) { fprintf(stderr, "kernel_launch: hipFuncSetAttribute failed\n"); grid = -1; return; }
        if (hipOccupancyMaxActiveBlocksPerMultiprocessor(&per_cu, (const void*)fwd_kernel, NTHREADS, LDS_BYTES) != hipSuccess || per_cu < 1) { fprintf(stderr, "kernel_launch: occupancy query says %d\n", per_cu); (void)hipGetLastError(); per_cu = 1; }
        grid = cus;
    }
    if (grid < 0) return;
    (void)hipMemsetAsync((char*)d_ws + WS_CTL, 0, CTL_BYTES, stream);
    Args a{};
    for (int i = 0; i < 19; ++i) a.in[i] = (const float*)d_in[i];
    a.out = (float*)d_out; a.ws = (unsigned char*)d_ws;
#if ONE_LAUNCH
    a.ph_lo = 0; a.ph_hi = NPHASE;
    hipLaunchKernelGGL(fwd_kernel, dim3(grid), dim3(NTHREADS), LDS_BYTES, stream, a);
#else
    for (int p = 0; p < NPHASE; ++p) { a.ph_lo = p; a.ph_hi = p + 1; hipLaunchKernelGGL(fwd_kernel, dim3(grid), dim3(NTHREADS), LDS_BYTES, stream, a); }
#endif
}
```

```cpp
#include <hip/hip_runtime.h>
#include <cstdio>
#include <cstdint>

#ifndef ONE_LAUNCH
#define ONE_LAUNCH 1
#endif

#define LAS __attribute__((address_space(3)))
typedef unsigned short bf16;
typedef float f32x4 __attribute__((ext_vector_type(4)));
typedef unsigned u32x4 __attribute__((ext_vector_type(4)));
typedef unsigned u32x2 __attribute__((ext_vector_type(2)));

constexpr int NB = 8, SEQ = 4096, DM = 1024, M = NB * SEQ;
constexpr int INDIM = 3856;
constexpr int NPROJ = 3840;
constexpr int PZ = 0, PX = 1024, PQ = 2560, PK = 3584, PV = 3712;
constexpr int DT0 = 2560;
constexpr int CONVCH = 1536;
constexpr int NH = 16, HD = 64, NST = 128, CHK = 128, NCH = SEQ / CHK;
constexpr int NE = 64, FF = 512, LISTCAP = 32768;
constexpr int SLOT_MAX = 81920;
constexpr float EPS = 1e-6f;

constexpr size_t MiB = 1u << 20;
constexpr size_t WS_CTL = 0, CTL_BYTES = 1 * MiB;
constexpr size_t WS_XN = 1 * MiB;
constexpr size_t WS_DT = 65 * MiB;
constexpr size_t WS_PROJ = 67 * MiB;
constexpr size_t WS_HID = WS_PROJ;
constexpr size_t WS_YB = WS_PROJ + 80 * MiB;
constexpr size_t WS_ST = 307 * MiB;
constexpr size_t WS_MIX = 371 * MiB;
constexpr size_t WS_MISC = 511 * MiB;
constexpr size_t WS_CDEC = WS_MISC;
constexpr size_t WS_TE = WS_MISC + 1 * MiB;
constexpr size_t WS_TP = WS_TE + 256 * 1024;
constexpr size_t WS_TG = WS_TP + 256 * 1024;
constexpr size_t WS_LIST = WS_MISC + 2 * MiB;
constexpr size_t WS_END = WS_LIST + 8 * MiB;
constexpr int CW_BAR = 4096;
constexpr int CW_CNT = 8192;

constexpr int NTHREADS = 512, NWAVES = 8;
constexpr int LDS_BYTES = 159744;
constexpr int MISC_OFF = LDS_BYTES - 256;

__device__ __forceinline__ unsigned f2bf(float f) { unsigned u = __builtin_bit_cast(unsigned, f); return (u + 0x7fffu + ((u >> 16) & 1u)) >> 16; }
__device__ __forceinline__ float bf2f(unsigned b) { return __builtin_bit_cast(float, (b & 0xffffu) << 16); }
__device__ __forceinline__ unsigned pk2(float lo, float hi) { return f2bf(lo) | (f2bf(hi) << 16); }
__device__ __forceinline__ float wave_sum(float v) {
#pragma unroll
    for (int o = 1; o < 64; o <<= 1) v += __shfl_xor(v, o);
    return v;
}
__device__ __forceinline__ float silu_f(float x) { return x / (1.0f + __expf(-x)); }
__device__ __forceinline__ float softplus_f(float x) { return x > 20.f ? x : log1pf(expf(x)); }

#define XB_TMO      128
#define XB_XCNT(j)  (256  + 64 * (j))
#define XB_XSUB(j)  (1280 + 64 * (j))
#define XB_XGEN(j)  (2304 + 64 * (j))
#define XB_TOP      3328
#define XB_TOPGEN   3392
#define XCD_BAR_WORDS 3456
#define XB_SPIN_CAP (1u << 27)
__device__ __forceinline__ unsigned xb_ld(unsigned* p)              { return __hip_atomic_load(p, __ATOMIC_RELAXED, __HIP_MEMORY_SCOPE_AGENT); }
__device__ __forceinline__ unsigned xb_add(unsigned* p, unsigned v) { return __hip_atomic_fetch_add(p, v, __ATOMIC_RELAXED, __HIP_MEMORY_SCOPE_AGENT); }
__device__ __forceinline__ unsigned xb_xcc_id() { return (unsigned)__builtin_amdgcn_s_getreg((3 << 11) | 20) & 0xFu; }
#define XB_SPIN(cond, bar) do { unsigned _sp = 0; while (cond) { __builtin_amdgcn_s_sleep(1); \
    if ((++_sp & 255u) == 0u) { if (xb_ld(&(bar)[XB_TMO])) break; if (_sp > XB_SPIN_CAP) { atomicAdd(&(bar)[XB_TMO], 1u); break; } } } } while (0)
struct XcdBarrier { unsigned* bar; unsigned x; volatile LAS unsigned* st; };
__device__ __forceinline__ XcdBarrier xcd_barrier_post(unsigned* bar, volatile LAS unsigned* st) {
    XcdBarrier b; b.bar = bar; b.x = xb_xcc_id(); b.st = st;
    if (threadIdx.x == 0) (void)xb_add(&bar[XB_XCNT(b.x)], 1u);
    return b;
}
__device__ __forceinline__ void xcd_barrier_complete(unsigned* bar, unsigned x, unsigned& nloc, unsigned& nx) {
    const unsigned G = gridDim.x * gridDim.y * gridDim.z;
    unsigned sum, cnt, mine, sp = 0u;
    for (;;) {
        sum = 0u; cnt = 0u; mine = 0u;
#pragma unroll
        for (unsigned j = 0; j < 16; ++j) { const unsigned c = xb_ld(&bar[XB_XCNT(j)]); sum += c; cnt += (c > 0u) ? 1u : 0u; mine = (j == x) ? c : mine; }
        if (sum == G) break;
        __builtin_amdgcn_s_sleep(1);
        if ((++sp & 255u) == 0u) { if (xb_ld(&bar[XB_TMO])) break; if (sp > XB_SPIN_CAP) { atomicAdd(&bar[XB_TMO], 1u); break; } }
    }
    nloc = mine > 0u ? mine : 1u; nx = cnt > 0u ? cnt : 1u;
}
__device__ __forceinline__ void xcd_barrier(const XcdBarrier& b) {
    asm volatile("s_waitcnt vmcnt(0)" ::: "memory");
    __syncthreads();
    if (threadIdx.x == 0) {
        unsigned* bar = b.bar;
        __builtin_amdgcn_s_waitcnt(0);
        unsigned nloc = b.st[0], nx = b.st[1];
        if (nloc == 0u) { xcd_barrier_complete(bar, b.x, nloc, nx); b.st[0] = nloc; b.st[1] = nx; }
        const unsigned old = xb_add(&bar[XB_XSUB(b.x)], 1u);
        const unsigned gen = old / nloc;
        if (old + 1u == (gen + 1u) * nloc) {
            __builtin_amdgcn_fence(__ATOMIC_RELEASE, "agent");
            asm volatile("s_waitcnt vmcnt(0)" ::: "memory");
            const unsigned og = xb_add(&bar[XB_TOP], 1u);
            const unsigned tg = og / nx;
            if (og + 1u == (tg + 1u) * nx) xb_add(&bar[XB_TOPGEN], 1u);
            else XB_SPIN(xb_ld(&bar[XB_TOPGEN]) == tg, bar);
            __builtin_amdgcn_fence(__ATOMIC_ACQUIRE, "agent");
            xb_add(&bar[XB_XGEN(b.x)], 1u);
            asm volatile("s_waitcnt vmcnt(0)" ::: "memory");
        } else {
            XB_SPIN(xb_ld(&bar[XB_XGEN(b.x)]) == gen, bar);
            __builtin_amdgcn_fence(__ATOMIC_ACQUIRE, "agent");
            asm volatile("s_waitcnt vmcnt(0)" ::: "memory");
        }
    }
    __syncthreads();
}

struct Args { const float* in[19]; float* out; unsigned char* ws; int ph_lo, ph_hi; };
struct Ctx {
    unsigned char* lds; int tid, lane, wave, G, bid;
    const float *x, *norm_mix, *w_in, *conv_w, *conv_b, *dt_bias, *a_log, *d_skip, *ssd_norm, *sinks, *attn_norm, *w_out, *norm_ffn, *w_rg, *w_re, *w_gate, *w_up, *w_down, *norm_final;
    float* out; unsigned char* ws;
    bf16 *XN, *PROJ, *HID, *YB, *ST, *MIX; float *DT, *CDEC, *TG; int *TE, *TP, *LIST; unsigned* ctl;
};

template <class RowPtr>
__device__ __forceinline__ void ngemm128(Ctx& C, RowPtr arow, const float* Bm, int ldb, int K, float (&acc)[8][4]) {
    float* As = (float*)C.lds;
    float* Bs = As + 32 * 132;
    const int tid = C.tid, tx = tid & 31, ty = tid >> 5;
#pragma unroll
    for (int i = 0; i < 8; ++i)
#pragma unroll
        for (int j = 0; j < 4; ++j) acc[i][j] = 0.f;
    const int am = tid >> 2, akc = (tid & 3) * 8;
    const bf16* ap = arow(am) + akc;
    const int bk = tid >> 4, bn = (tid & 15) * 8;
    for (int k0 = 0; k0 < K; k0 += 32) {
        const u32x4 av = *(const u32x4*)(ap + k0);
        const f32x4 b0 = *(const f32x4*)(Bm + (size_t)(k0 + bk) * ldb + bn);
        const f32x4 b1 = *(const f32x4*)(Bm + (size_t)(k0 + bk) * ldb + bn + 4);
        __syncthreads();
#pragma unroll
        for (int i = 0; i < 4; ++i) { As[(akc + 2 * i) * 132 + am] = bf2f(av[i]); As[(akc + 2 * i + 1) * 132 + am] = bf2f(av[i] >> 16); }
        *(f32x4*)(Bs + bk * 132 + bn) = b0; *(f32x4*)(Bs + bk * 132 + bn + 4) = b1;
        __syncthreads();
#pragma unroll 8
        for (int kk = 0; kk < 32; ++kk) {
            const f32x4 a0 = *(const f32x4*)(As + kk * 132 + ty * 8), a1 = *(const f32x4*)(As + kk * 132 + ty * 8 + 4);
            const f32x4 b = *(const f32x4*)(Bs + kk * 132 + tx * 4);
#pragma unroll
            for (int j = 0; j < 4; ++j) {
                acc[0][j] += a0[0] * b[j]; acc[1][j] += a0[1] * b[j]; acc[2][j] += a0[2] * b[j]; acc[3][j] += a0[3] * b[j];
                acc[4][j] += a1[0] * b[j]; acc[5][j] += a1[1] * b[j]; acc[6][j] += a1[2] * b[j]; acc[7][j] += a1[3] * b[j];
            }
        }
    }
    __syncthreads();
}

__device__ __forceinline__ float conv_silu(const Ctx& C, int b, int t, int ch) {
    float acc = C.conv_b[ch];
#pragma unroll
    for (int j = 0; j < 4; ++j) { const int tt = t - 3 + j; if (tt >= 0) acc += C.conv_w[j * CONVCH + ch] * bf2f(C.PROJ[(size_t)(b * SEQ + tt) * NPROJ + PX + ch]); }
    return silu_f(acc);
}

__device__ __forceinline__ void phase_prologue(Ctx& C) {
    float* W = (float*)C.lds;
    for (int idx = C.tid; idx < 16 * 1024; idx += NTHREADS) { const int k = idx >> 4, j = idx & 15; W[j * 1024 + k] = C.w_in[(size_t)k * INDIM + DT0 + j]; }
    __syncthreads();
    const int gw = C.bid * NWAVES + C.wave, NGW = C.G * NWAVES;
    for (int row = gw; row < M; row += NGW) {
        const f32x4* xr = (const f32x4*)(C.x + (size_t)row * DM) + C.lane;
        f32x4 v[4]; float ss = 0.f;
#pragma unroll
        for (int j = 0; j < 4; ++j) { v[j] = xr[64 * j]; ss += v[j][0] * v[j][0] + v[j][1] * v[j][1] + v[j][2] * v[j][2] + v[j][3] * v[j][3]; }
        const float rstd = 1.0f / sqrtf(wave_sum(ss) * (1.0f / DM) + EPS);
        u32x2* o = (u32x2*)(C.XN + (size_t)row * DM) + C.lane;
#pragma unroll
        for (int j = 0; j < 4; ++j) { const f32x4 g = ((const f32x4*)C.norm_mix)[C.lane + 64 * j]; v[j] = v[j] * rstd * g; u32x2 w; w.x = pk2(v[j][0], v[j][1]); w.y = pk2(v[j][2], v[j][3]); o[64 * j] = w; }
        float mine = 0.f;
#pragma unroll 2
        for (int jj = 0; jj < 16; ++jj) {
            float p = 0.f;
#pragma unroll
            for (int j = 0; j < 4; ++j) { const f32x4 w4 = *(const f32x4*)(W + jj * 1024 + (C.lane + 64 * j) * 4); p += v[j][0] * w4[0] + v[j][1] * w4[1] + v[j][2] * w4[2] + v[j][3] * w4[3]; }
            p = wave_sum(p);
            if (C.lane == jj) mine = p;
        }
        if (C.lane < 16) C.DT[(size_t)row * 16 + C.lane] = softplus_f(mine + C.dt_bias[C.lane]);
    }
}

__device__ __forceinline__ void phase_gemm1(Ctx& C) {
    constexpr int NT = NPROJ / 128;
    const int tx = C.tid & 31, ty = C.tid >> 5;
    for (int u = C.bid; u < (M / 128) * NT; u += C.G) {
        const int mt = u / NT, nt = u % NT, n0 = nt * 128, bcol0 = n0 < DT0 ? n0 : n0 + 16;
        float acc[8][4];
        const bf16* A = C.XN + (size_t)mt * 128 * DM;
        ngemm128(C, [&](int m) { return A + (size_t)m * DM; }, C.w_in + bcol0, INDIM, DM, acc);
#pragma unroll
        for (int i = 0; i < 8; ++i) { u32x2 w; w.x = pk2(acc[i][0], acc[i][1]); w.y = pk2(acc[i][2], acc[i][3]);
            *(u32x2*)(C.PROJ + (size_t)(mt * 128 + ty * 8 + i) * NPROJ + n0 + tx * 4) = w; }
    }
}

__device__ __forceinline__ void ssd_states_unit(Ctx& C, int u) {
    const int g = u & 1, c = (u >> 1) & 31, b = u >> 6;
    float* Bs = (float*)C.lds;
    float* xs = Bs + 128 * 128;
    float* dtl = xs + 128 * 64;
    float* acs = dtl + 128;
    float* wl = acs + 128;
    const int t0 = c * CHK;
    __syncthreads();
    for (int idx = C.tid; idx < 128 * 128; idx += NTHREADS) { const int l = idx >> 7, n = idx & 127; Bs[idx] = conv_silu(C, b, t0 + l, 1024 + g * 128 + n); }
    for (int r = 0; r < 8; ++r) {
        const int h = g * 8 + r;
        __syncthreads();
        if (C.tid < 128) dtl[C.tid] = C.DT[(size_t)(b * SEQ + t0 + C.tid) * 16 + h];
        __syncthreads();
        if (C.tid == 0) { const float A = -expf(C.a_log[h]); float run = 0.f; for (int l = 0; l < 128; ++l) { run += dtl[l] * A; acs[l] = run; } }
        __syncthreads();
        if (C.tid < 128) wl[C.tid] = dtl[C.tid] * expf(acs[127] - acs[C.tid]);
        for (int idx = C.tid; idx < 128 * 64; idx += NTHREADS) { const int l = idx >> 6, p = idx & 63; xs[idx] = conv_silu(C, b, t0 + l, h * 64 + p); }
        __syncthreads();
        const int n = C.tid & 127, pg = C.tid >> 7;
        float acc[16];
#pragma unroll
        for (int i = 0; i < 16; ++i) acc[i] = 0.f;
        for (int l = 0; l < 128; ++l) {
            const float bv = Bs[l * 128 + n] * wl[l];
#pragma unroll
            for (int i = 0; i < 16; ++i) acc[i] += xs[l * 64 + pg * 16 + i] * bv;
        }
        bf16* st = C.ST + ((size_t)((b * NCH + c) * NH + h)) * (HD * NST);
#pragma unroll
        for (int i = 0; i < 16; ++i) st[(pg * 16 + i) * NST + n] = (bf16)f2bf(acc[i]);
        if (C.tid == 0) C.CDEC[(b * NCH + c) * NH + h] = expf(acs[127]);
    }
    __syncthreads();
}

__device__ __forceinline__ void attn_unit(Ctx& C, int u) {
    const int blk = u & 31, b = u >> 5;
    float* Ks = (float*)C.lds;
    float* Vs = Ks + 256 * 68;
    float* ssq = Vs + 256 * 68;
    const int t0 = blk * 128;
    __syncthreads();
    if (C.tid < 128) ssq[C.tid] = 0.f;
    for (int kv = 0; kv < 2; ++kv) {
        __syncthreads();
        for (int idx = C.tid; idx < 256 * 64; idx += NTHREADS) {
            const int key = idx >> 6, d = idx & 63, t = t0 - 128 + key;
            float kvv = 0.f, vvv = 0.f;
            if (t >= 0) { const bf16* pr = C.PROJ + (size_t)(b * SEQ + t) * NPROJ; kvv = bf2f(pr[PK + kv * 64 + d]); vvv = bf2f(pr[PV + kv * 64 + d]); }
            Ks[key * 68 + d] = kvv; Vs[key * 68 + d] = vvv;
        }
        __syncthreads();
        for (int pr2 = 0; pr2 < 2; ++pr2) {
            const int pair = pr2 * 512 + C.tid, r = pair >> 7, qi = pair & 127, hq = kv * 8 + r;
            const bf16* qp = C.PROJ + (size_t)(b * SEQ + t0 + qi) * NPROJ + PQ + hq * 64;
            unsigned qw[32]; float o[64];
#pragma unroll
            for (int d = 0; d < 32; ++d) { qw[d] = *(const unsigned*)(qp + 2 * d); }
#pragma unroll
            for (int d = 0; d < 64; ++d) o[d] = 0.f;
            float m = C.sinks[hq], l = 1.0f;
            for (int j = 1; j <= 128; ++j) {
                const int key = qi + j;
                if (t0 - 128 + key < 0) continue;
                const float* kr = Ks + key * 68; const float* vr = Vs + key * 68;
                float s = 0.f;
#pragma unroll
                for (int d = 0; d < 64; d += 4) { const f32x4 k4 = *(const f32x4*)(kr + d); s += bf2f(qw[d >> 1]) * k4[0] + bf2f(qw[d >> 1] >> 16) * k4[1] + bf2f(qw[(d >> 1) + 1]) * k4[2] + bf2f(qw[(d >> 1) + 1] >> 16) * k4[3]; }
                s *= 0.125f;
                if (s > m) { const float al = expf(m - s); l *= al;
#pragma unroll
                    for (int d = 0; d < 64; ++d) o[d] *= al;
                    m = s; }
                const float p = expf(s - m); l += p;
#pragma unroll
                for (int d = 0; d < 64; d += 4) { const f32x4 v4 = *(const f32x4*)(vr + d); o[d] += p * v4[0]; o[d + 1] += p * v4[1]; o[d + 2] += p * v4[2]; o[d + 3] += p * v4[3]; }
            }
            const float inv = 1.0f / l; float sq = 0.f;
            bf16* op = C.MIX + (size_t)(b * SEQ + t0 + qi) * 2048 + 1024 + hq * 64;
#pragma unroll
            for (int d = 0; d < 64; d += 2) { const float a0 = o[d] * inv, a1 = o[d + 1] * inv; sq += a0 * a0 + a1 * a1; *(unsigned*)(op + d) = pk2(a0, a1); }
            atomicAdd(&ssq[qi], sq);
        }
    }
    __syncthreads();
    for (int idx = C.tid; idx < 128 * 512; idx += NTHREADS) {
        const int qi = idx >> 9, c2 = (idx & 511) * 2;
        const float rs = 1.0f / sqrtf(ssq[qi] * (1.0f / 1024.f) + EPS);
        unsigned* p = (unsigned*)(C.MIX + (size_t)(b * SEQ + t0 + qi) * 2048 + 1024 + c2);
        const unsigned w = *p;
        *p = pk2(bf2f(w) * rs * C.attn_norm[c2], bf2f(w >> 16) * rs * C.attn_norm[c2 + 1]);
    }
    __syncthreads();
}

__device__ __forceinline__ void phase_scan(Ctx& C) {
    const int total = NB * NH * HD * NST;
    for (int e = C.bid * NTHREADS + C.tid; e < total; e += C.G * NTHREADS) {
        const int pn = e & (HD * NST - 1), h = (e >> 13) & 15, b = e >> 17;
        float carry = 0.f;
        for (int c = 0; c < NCH; ++c) {
            bf16* p = C.ST + ((size_t)((b * NCH + c) * NH + h)) * (HD * NST) + pn;
            const float s = bf2f(*p), dec = C.CDEC[(b * NCH + c) * NH + h];
            *p = (bf16)f2bf(carry);
            carry = carry * dec + s;
        }
    }
}

__device__ __forceinline__ void ssd_out_unit(Ctx& C, int u) {
    const int g = u & 1, c = (u >> 1) & 31, b = u >> 6;
    bf16* Cs = (bf16*)C.lds;
    bf16* Bs = Cs + 128 * 130;
    float* xs = (float*)Bs;
    float* cb = (float*)(C.lds + 2 * 33280);
    bf16* pv = (bf16*)(C.lds + 2 * 33280 + 65536);
    float* dts = (float*)(C.lds + 2 * 33280 + 65536 + 16640);
    float* acs = dts + 128; float* ssl = acs + 128; float* rsl = ssl + 128;
    const int t0 = c * CHK;
    __syncthreads();
    for (int idx = C.tid; idx < 128 * 128; idx += NTHREADS) { const int l = idx >> 7, n = idx & 127;
        Bs[l * 130 + n] = (bf16)f2bf(conv_silu(C, b, t0 + l, 1024 + g * 128 + n));
        Cs[l * 130 + n] = (bf16)f2bf(conv_silu(C, b, t0 + l, 1280 + g * 128 + n)); }
    if (C.tid < 128) ssl[C.tid] = 0.f;
    __syncthreads();
    {
        const int s = C.tid & 127, lg = C.tid >> 7;
        float acc[32];
#pragma unroll
        for (int i = 0; i < 32; ++i) acc[i] = 0.f;
        for (int n = 0; n < 128; ++n) { const float bv = bf2f(Bs[s * 130 + n]);
#pragma unroll
            for (int i = 0; i < 32; ++i) acc[i] += bf2f(Cs[(lg * 32 + i) * 130 + n]) * bv; }
#pragma unroll
        for (int i = 0; i < 32; ++i) cb[(lg * 32 + i) * 128 + s] = acc[i];
    }
    for (int r = 0; r < 8; ++r) {
        const int h = g * 8 + r;
        __syncthreads();
        if (C.tid < 128) dts[C.tid] = C.DT[(size_t)(b * SEQ + t0 + C.tid) * 16 + h];
        __syncthreads();
        if (C.tid == 0) { const float A = -expf(C.a_log[h]); float run = 0.f; for (int l = 0; l < 128; ++l) { run += dts[l] * A; acs[l] = run; } }
        for (int idx = C.tid; idx < 128 * 64; idx += NTHREADS) { const int l = idx >> 6, p = idx & 63; xs[idx] = conv_silu(C, b, t0 + l, h * 64 + p); }
        { const bf16* st = C.ST + ((size_t)((b * NCH + c) * NH + h)) * (HD * NST);
          for (int idx = C.tid; idx < 64 * 128; idx += NTHREADS) { const int p = idx >> 7, n = idx & 127; pv[p * 130 + n] = st[idx]; } }
        __syncthreads();
        const int p = C.tid & 63, lg = C.tid >> 6;
        const float dsk = C.d_skip[h];
        for (int i = 0; i < 16; ++i) {
            const int l = lg * 16 + i;
            float acc = 0.f;
            for (int s = 0; s <= l; ++s) acc += cb[l * 128 + s] * __expf(acs[l] - acs[s]) * dts[s] * xs[s * 64 + p];
            float off = 0.f;
            for (int n = 0; n < 128; ++n) off += bf2f(Cs[l * 130 + n]) * bf2f(pv[p * 130 + n]);
            const float y = acc + __expf(acs[l]) * off + dsk * xs[l * 64 + p];
            const size_t row = (size_t)(b * SEQ + t0 + l);
            const float z = bf2f(C.PROJ[row * NPROJ + PZ + h * 64 + p]);
            const float uu = y * silu_f(z);
            C.MIX[row * 2048 + h * 64 + p] = (bf16)f2bf(uu);
            const float sq = wave_sum(uu * uu);
            if (C.lane == 0) ssl[l] += sq;
        }
    }
    __syncthreads();
    if (C.tid < 128) rsl[C.tid] = 1.0f / sqrtf(ssl[C.tid] * (1.0f / 512.f) + EPS);
    __syncthreads();
    for (int idx = C.tid; idx < 128 * 256; idx += NTHREADS) {
        const int l = idx >> 8, c2 = (idx & 255) * 2, col = g * 512 + c2;
        unsigned* p = (unsigned*)(C.MIX + (size_t)(b * SEQ + t0 + l) * 2048 + col);
        const unsigned w = *p;
        *p = pk2(bf2f(w) * rsl[l] * C.ssd_norm[col], bf2f(w >> 16) * rsl[l] * C.ssd_norm[col + 1]);
    }
    __syncthreads();
}

__device__ __forceinline__ void phase_gemm2(Ctx& C) {
    const int tx = C.tid & 31, ty = C.tid >> 5;
    for (int u = C.bid; u < (M / 128) * 8; u += C.G) {
        const int mt = u >> 3, nt = u & 7;
        float acc[8][4];
        const bf16* A = C.MIX + (size_t)mt * 128 * 2048;
        ngemm128(C, [&](int m) { return A + (size_t)m * 2048; }, C.w_out + nt * 128, DM, 2048, acc);
#pragma unroll
        for (int i = 0; i < 8; ++i) { const size_t off = (size_t)(mt * 128 + ty * 8 + i) * DM + nt * 128 + tx * 4;
            const f32x4 xv = *(const f32x4*)(C.x + off); f32x4 o; o[0] = xv[0] + acc[i][0]; o[1] = xv[1] + acc[i][1]; o[2] = xv[2] + acc[i][2]; o[3] = xv[3] + acc[i][3];
            *(f32x4*)(C.out + off) = o; }
    }
}

__device__ __forceinline__ void phase_router(Ctx& C) {
    float* T = (float*)C.lds + C.wave * 4096;
    const int gw = C.bid * NWAVES + C.wave, NGW = C.G * NWAVES;
    unsigned* cnt = C.ctl + CW_CNT;
    for (int r0 = gw * 4; r0 < M; r0 += NGW * 4) {
#pragma unroll
        for (int r = 0; r < 4; ++r) {
            const int row = r0 + r;
            const f32x4* hr = (const f32x4*)(C.out + (size_t)row * DM) + C.lane;
            f32x4 v[4]; float ss = 0.f;
#pragma unroll
            for (int j = 0; j < 4; ++j) { v[j] = hr[64 * j]; ss += v[j][0] * v[j][0] + v[j][1] * v[j][1] + v[j][2] * v[j][2] + v[j][3] * v[j][3]; }
            const float rstd = 1.0f / sqrtf(wave_sum(ss) * (1.0f / DM) + EPS);
            u32x2* o = (u32x2*)(C.XN + (size_t)row * DM) + C.lane;
#pragma unroll
            for (int j = 0; j < 4; ++j) { const f32x4 g = ((const f32x4*)C.norm_ffn)[C.lane + 64 * j]; v[j] = v[j] * rstd * g;
                u32x2 w; w.x = pk2(v[j][0], v[j][1]); w.y = pk2(v[j][2], v[j][3]); o[64 * j] = w;
                *(f32x4*)(T + r * 1024 + (C.lane + 64 * j) * 4) = v[j]; }
        }
        asm volatile("s_waitcnt lgkmcnt(0)" ::: "memory");
        float ae[4] = {0.f, 0.f, 0.f, 0.f}, ag[4] = {0.f, 0.f, 0.f, 0.f};
        for (int k = 0; k < DM; ++k) { const float w = C.w_re[k * 64 + C.lane];
#pragma unroll
            for (int r = 0; r < 4; ++r) ae[r] += T[r * 1024 + k] * w; }
        { const int col = C.lane & 7, ks = C.lane >> 3;
          for (int kk = 0; kk < 128; ++kk) { const int k = ks * 128 + kk; const float w = C.w_rg[k * 8 + col];
#pragma unroll
              for (int r = 0; r < 4; ++r) ag[r] += T[r * 1024 + k] * w; }
#pragma unroll
          for (int r = 0; r < 4; ++r) { ag[r] += __shfl_xor(ag[r], 8); ag[r] += __shfl_xor(ag[r], 16); ag[r] += __shfl_xor(ag[r], 32); } }
#pragma unroll
        for (int r = 0; r < 4; ++r) {
            const int row = r0 + r;
            float gl[8]; int gsel = 0; float gmax;
#pragma unroll
            for (int c2 = 0; c2 < 8; ++c2) gl[c2] = __shfl(ag[r], c2);
            gmax = gl[0];
#pragma unroll
            for (int c2 = 1; c2 < 8; ++c2) if (gl[c2] > gmax) { gmax = gl[c2]; gsel = c2; }
            float gsum = 0.f;
#pragma unroll
            for (int c2 = 0; c2 < 8; ++c2) gsum += expf(gl[c2] - gmax);
            const float pgrp = 1.0f / gsum;
            float el[8];
#pragma unroll
            for (int i = 0; i < 8; ++i) el[i] = __shfl(ae[r], gsel * 8 + i);
            int i0 = 0; float l0 = el[0];
#pragma unroll
            for (int i = 1; i < 8; ++i) if (el[i] > l0) { l0 = el[i]; i0 = i; }
            int i1 = -1; float l1 = -INFINITY;
#pragma unroll
            for (int i = 0; i < 8; ++i) if (i != i0 && el[i] > l1) { l1 = el[i]; i1 = i; }
            const float e1 = expf(l1 - l0), g0 = pgrp / (1.0f + e1), g1 = pgrp * e1 / (1.0f + e1);
            if (C.lane == 0) {
#pragma unroll
                for (int k = 0; k < 2; ++k) { const int e = gsel * 8 + (k == 0 ? i0 : i1);
                    const unsigned pos = atomicAdd(&cnt[e], 1u);
                    C.TE[row * 2 + k] = e; C.TP[row * 2 + k] = (int)pos; C.TG[row * 2 + k] = (k == 0 ? g0 : g1);
                    C.LIST[(size_t)e * LISTCAP + pos] = row * 2 + k; }
            }
        }
    }
}

struct MoeTab { int* cnt; int* pstart; int* tstart; };
__device__ __forceinline__ MoeTab moe_tables(Ctx& C, int off) {
    MoeTab T; T.cnt = (int*)(C.lds + off); T.pstart = T.cnt + 64; T.tstart = T.pstart + 65;
    __syncthreads();
    if (C.tid < 64) T.cnt[C.tid] = (int)__hip_atomic_load(C.ctl + CW_CNT + C.tid, __ATOMIC_RELAXED, __HIP_MEMORY_SCOPE_AGENT);
    __syncthreads();
    if (C.tid == 0) { int ps = 0, ts = 0; for (int e = 0; e < 64; ++e) { T.pstart[e] = ps; T.tstart[e] = ts; ps += ((T.cnt[e] + 255) >> 8) << 8; ts += (T.cnt[e] + 127) >> 7; } T.pstart[64] = ps; T.tstart[64] = ts; }
    __syncthreads();
    return T;
}

__device__ __forceinline__ void phase_moe_a(Ctx& C) {
    const MoeTab T = moe_tables(C, 2 * 32 * 132 * 4);
    const int tx = C.tid & 31, ty = C.tid >> 5, ntiles = T.tstart[64];
    for (int u = C.bid; u < ntiles * 4; u += C.G) {
        const int tile = u >> 2, nt = u & 3;
        int e = 0; while (T.tstart[e + 1] <= tile) ++e;
        const int mt = tile - T.tstart[e], ce = T.cnt[e];
        const int* lst = C.LIST + (size_t)e * LISTCAP;
        auto arow = [&](int m) { const int pos = mt * 128 + m; const int tok = pos < ce ? (lst[pos] >> 1) : 0; return C.XN + (size_t)tok * DM; };
        float ag[8][4], au[8][4];
        ngemm128(C, arow, C.w_gate + (size_t)e * DM * FF + nt * 128, FF, DM, ag);
        ngemm128(C, arow, C.w_up + (size_t)e * DM * FF + nt * 128, FF, DM, au);
#pragma unroll
        for (int i = 0; i < 8; ++i) { const size_t slot = (size_t)T.pstart[e] + mt * 128 + ty * 8 + i;
            u32x2 w; w.x = pk2(silu_f(ag[i][0]) * au[i][0], silu_f(ag[i][1]) * au[i][1]); w.y = pk2(silu_f(ag[i][2]) * au[i][2], silu_f(ag[i][3]) * au[i][3]);
            *(u32x2*)(C.HID + slot * FF + nt * 128 + tx * 4) = w; }
    }
}
__device__ __forceinline__ void phase_moe_b(Ctx& C) {
    const MoeTab T = moe_tables(C, 2 * 32 * 132 * 4);
    const int tx = C.tid & 31, ty = C.tid >> 5, ntiles = T.tstart[64];
    for (int u = C.bid; u < ntiles * 8; u += C.G) {
        const int tile = u >> 3, nt = u & 7;
        int e = 0; while (T.tstart[e + 1] <= tile) ++e;
        const int mt = tile - T.tstart[e], ce = T.cnt[e];
        const int* lst = C.LIST + (size_t)e * LISTCAP;
        const bf16* A = C.HID + ((size_t)T.pstart[e] + mt * 128) * FF;
        float acc[8][4];
        ngemm128(C, [&](int m) { return A + (size_t)m * FF; }, C.w_down + (size_t)e * FF * DM + nt * 128, DM, FF, acc);
#pragma unroll
        for (int i = 0; i < 8; ++i) { const int pos = mt * 128 + ty * 8 + i;
            if (pos < ce) { const float gt = C.TG[lst[pos]]; const size_t slot = (size_t)T.pstart[e] + pos;
                u32x2 w; w.x = pk2(acc[i][0] * gt, acc[i][1] * gt); w.y = pk2(acc[i][2] * gt, acc[i][3] * gt);
                *(u32x2*)(C.YB + slot * DM + nt * 128 + tx * 4) = w; } }
    }
}
__device__ __forceinline__ void phase_final(Ctx& C) {
    const MoeTab T = moe_tables(C, 0);
    const int gw = C.bid * NWAVES + C.wave, NGW = C.G * NWAVES;
    for (int row = gw; row < M; row += NGW) {
        const size_t s0 = (size_t)T.pstart[C.TE[row * 2]] + C.TP[row * 2], s1 = (size_t)T.pstart[C.TE[row * 2 + 1]] + C.TP[row * 2 + 1];
        f32x4* hr = (f32x4*)(C.out + (size_t)row * DM) + C.lane;
        const u32x2* y0 = (const u32x2*)(C.YB + s0 * DM) + C.lane; const u32x2* y1 = (const u32x2*)(C.YB + s1 * DM) + C.lane;
        f32x4 v[4]; float ss = 0.f;
#pragma unroll
        for (int j = 0; j < 4; ++j) { v[j] = hr[64 * j]; const u32x2 a = y0[64 * j], c = y1[64 * j];
            v[j][0] += bf2f(a.x) + bf2f(c.x); v[j][1] += bf2f(a.x >> 16) + bf2f(c.x >> 16); v[j][2] += bf2f(a.y) + bf2f(c.y); v[j][3] += bf2f(a.y >> 16) + bf2f(c.y >> 16);
            ss += v[j][0] * v[j][0] + v[j][1] * v[j][1] + v[j][2] * v[j][2] + v[j][3] * v[j][3]; }
        const float rstd = 1.0f / sqrtf(wave_sum(ss) * (1.0f / DM) + EPS);
#pragma unroll
        for (int j = 0; j < 4; ++j) { const f32x4 g = ((const f32x4*)C.norm_final)[C.lane + 64 * j]; hr[64 * j] = v[j] * rstd * g; }
    }
}

constexpr int NPHASE = 10;
__global__ void __launch_bounds__(NTHREADS, 2) fwd_kernel(Args args) {
    extern __shared__ __attribute__((aligned(16))) unsigned char lds[];
    Ctx C;
    C.lds = lds; C.tid = threadIdx.x; C.lane = C.tid & 63; C.wave = __builtin_amdgcn_readfirstlane(C.tid >> 6); C.G = gridDim.x; C.bid = blockIdx.x;
    C.x = args.in[0]; C.norm_mix = args.in[1]; C.w_in = args.in[2]; C.conv_w = args.in[3]; C.conv_b = args.in[4]; C.dt_bias = args.in[5]; C.a_log = args.in[6]; C.d_skip = args.in[7];
    C.ssd_norm = args.in[8]; C.sinks = args.in[9]; C.attn_norm = args.in[10]; C.w_out = args.in[11]; C.norm_ffn = args.in[12]; C.w_rg = args.in[13]; C.w_re = args.in[14];
    C.w_gate = args.in[15]; C.w_up = args.in[16]; C.w_down = args.in[17]; C.norm_final = args.in[18];
    C.out = args.out; C.ws = args.ws;
    unsigned char* ws = args.ws;
    C.ctl = (unsigned*)(ws + WS_CTL);
    C.XN = (bf16*)(ws + WS_XN); C.DT = (float*)(ws + WS_DT); C.PROJ = (bf16*)(ws + WS_PROJ); C.HID = (bf16*)(ws + WS_HID); C.YB = (bf16*)(ws + WS_YB);
    C.ST = (bf16*)(ws + WS_ST); C.MIX = (bf16*)(ws + WS_MIX); C.CDEC = (float*)(ws + WS_CDEC); C.TE = (int*)(ws + WS_TE); C.TP = (int*)(ws + WS_TP); C.TG = (float*)(ws + WS_TG);
    C.LIST = (int*)(ws + WS_LIST);
    volatile LAS unsigned* MISC = (volatile LAS unsigned*)((LAS unsigned char*)lds + MISC_OFF);
    if (C.tid < 64) MISC[C.tid] = 0u;
    __syncthreads();
    XcdBarrier bar; bar.bar = C.ctl + CW_BAR; bar.x = 0; bar.st = nullptr;
#if ONE_LAUNCH
    bar = xcd_barrier_post(C.ctl + CW_BAR, MISC + 8);
#define GRID_BAR() xcd_barrier(bar)
#else
#define GRID_BAR() do {} while (0)
#endif
    const int lo = args.ph_lo, hi = args.ph_hi;
#define IN(k) (lo <= (k) && (k) < hi)
#define SEAM(k) do { if (IN(k) && IN((k) + 1)) GRID_BAR(); } while (0)
    if (IN(0)) { phase_prologue(C); } SEAM(0);
    if (IN(1)) { phase_gemm1(C); } SEAM(1);
    if (IN(2)) { for (int u = C.bid; u < NB * NCH * 2; u += C.G) ssd_states_unit(C, u); for (int u = C.bid; u < NB * 32; u += C.G) attn_unit(C, u); } SEAM(2);
    if (IN(3)) { phase_scan(C); } SEAM(3);
    if (IN(4)) { for (int u = C.bid; u < NB * NCH * 2; u += C.G) ssd_out_unit(C, u); } SEAM(4);
    if (IN(5)) { phase_gemm2(C); } SEAM(5);
    if (IN(6)) { phase_router(C); } SEAM(6);
    if (IN(7)) { phase_moe_a(C); } SEAM(7);
    if (IN(8)) { phase_moe_b(C); } SEAM(8);
    if (IN(9)) { phase_final(C); }
}

extern "C" void kernel_launch(void* const* d_in, const int* in_sizes, int n_in, void* d_out, int out_size, void* d_ws, size_t ws_size, hipStream_t stream) {
    static int grid = 0;
    if (grid == 0) {
        if (n_in != 19 || in_sizes[0] != M * DM || out_size != M * DM || ws_size < WS_END) { fprintf(stderr, "kernel_launch: unexpected shapes (n_in %d, in0 %d, out %d, ws %zu)\n", n_in, n_in > 0 ? in_sizes[0] : -1, out_size, ws_size); grid = -1; return; }
        int dev = 0, cus = 0, per_cu = 0;
        if (hipGetDevice(&dev) != hipSuccess || hipDeviceGetAttribute(&cus, hipDeviceAttributeMultiprocessorCount, dev) != hipSuccess) { grid = -1; return; }
        if (hipFuncSetAttribute((const void*)fwd_kernel, hipFuncAttributeMaxDynamicSharedMemorySize, LDS_BYTES) != hipSuccess) { fprintf(stderr, "kernel_launch: hipFuncSetAttribute failed\n"); grid = -1; return; }
        if (hipOccupancyMaxActiveBlocksPerMultiprocessor(&per_cu, (const void*)fwd_kernel, NTHREADS, LDS_BYTES) != hipSuccess || per_cu < 1) { fprintf(stderr, "kernel_launch: occupancy query says %d\n", per_cu); (void)hipGetLastError(); per_cu = 1; }
        grid = cus;
    }
    if (grid < 0) return;
    (void)hipMemsetAsync((char*)d_ws + WS_CTL, 0, CTL_BYTES, stream);
    Args a{};
    for (int i = 0; i < 19; ++i) a.in[i] = (const float*)d_in[i];
    a.out = (float*)d_out; a.ws = (unsigned char*)d_ws;
#if ONE_LAUNCH
    a.ph_lo = 0; a.ph_hi = NPHASE;
    hipLaunchKernelGGL(fwd_kernel, dim3(grid), dim3(NTHREADS), LDS_BYTES, stream, a);
#else
    for (int p = 0; p < NPHASE; ++p) { a.ph_lo = p; a.ph_hi = p + 1; hipLaunchKernelGGL(fwd_kernel, dim3(grid), dim3(NTHREADS), LDS_BYTES, stream, a); }
#endif
}
```

```cpp
#include <hip/hip_runtime.h>
#include <cstdio>
#include <cstdint>

#ifndef ONE_LAUNCH
#define ONE_LAUNCH 1
#endif

#define LAS __attribute__((address_space(3)))
typedef unsigned short bf16;
typedef float f32x4 __attribute__((ext_vector_type(4)));
typedef unsigned u32x4 __attribute__((ext_vector_type(4)));
typedef unsigned u32x2 __attribute__((ext_vector_type(2)));

constexpr int NB = 8, SEQ = 4096, DM = 1024, M = NB * SEQ;
constexpr int INDIM = 3856;
constexpr int NPROJ = 3840;
constexpr int PZ = 0, PX = 1024, PQ = 2560, PK = 3584, PV = 3712;
constexpr int DT0 = 2560;
constexpr int CONVCH = 1536;
constexpr int NH = 16, HD = 64, NST = 128, CHK = 128, NCH = SEQ / CHK;
constexpr int NE = 64, FF = 512, LISTCAP = 32768;
constexpr int SLOT_MAX = 81920;
constexpr float EPS = 1e-6f;

constexpr size_t MiB = 1u << 20;
constexpr size_t WS_CTL = 0, CTL_BYTES = 1 * MiB;
constexpr size_t WS_XN = 1 * MiB;
constexpr size_t WS_DT = 65 * MiB;
constexpr size_t WS_PROJ = 67 * MiB;
constexpr size_t WS_HID = WS_PROJ;
constexpr size_t WS_YB = WS_PROJ + 80 * MiB;
constexpr size_t WS_ST = 307 * MiB;
constexpr size_t WS_MIX = 371 * MiB;
constexpr size_t WS_WGU = 307 * MiB;
constexpr size_t WS_WD = 435 * MiB;
constexpr size_t WS_WIN = 499 * MiB;
constexpr size_t WS_WOUT = 507 * MiB;
constexpr size_t WS_MISC = 511 * MiB;
constexpr size_t WS_CDEC = WS_MISC;
constexpr size_t WS_TE = WS_MISC + 1 * MiB;
constexpr size_t WS_TP = WS_TE + 256 * 1024;
constexpr size_t WS_TG = WS_TP + 256 * 1024;
constexpr size_t WS_LIST = WS_MISC + 2 * MiB;
constexpr size_t WS_END = WS_LIST + 8 * MiB;
constexpr int CW_BAR = 4096;
constexpr int CW_CNT = 8192;

constexpr int NTHREADS = 512, NWAVES = 8;
constexpr int LDS_BYTES = 159744;
constexpr int MISC_OFF = LDS_BYTES - 256;

__device__ __forceinline__ unsigned f2bf(float f) { unsigned u = __builtin_bit_cast(unsigned, f); return (u + 0x7fffu + ((u >> 16) & 1u)) >> 16; }
__device__ __forceinline__ float bf2f(unsigned b) { return __builtin_bit_cast(float, (b & 0xffffu) << 16); }
__device__ __forceinline__ unsigned pk2(float lo, float hi) { return f2bf(lo) | (f2bf(hi) << 16); }
__device__ __forceinline__ float wave_sum(float v) {
#pragma unroll
    for (int o = 1; o < 64; o <<= 1) v += __shfl_xor(v, o);
    return v;
}
__device__ __forceinline__ float silu_f(float x) { return x / (1.0f + __expf(-x)); }
__device__ __forceinline__ float softplus_f(float x) { return x > 20.f ? x : log1pf(expf(x)); }

#define XB_TMO      128
#define XB_XCNT(j)  (256  + 64 * (j))
#define XB_XSUB(j)  (1280 + 64 * (j))
#define XB_XGEN(j)  (2304 + 64 * (j))
#define XB_TOP      3328
#define XB_TOPGEN   3392
#define XCD_BAR_WORDS 3456
#define XB_SPIN_CAP (1u << 27)
__device__ __forceinline__ unsigned xb_ld(unsigned* p)              { return __hip_atomic_load(p, __ATOMIC_RELAXED, __HIP_MEMORY_SCOPE_AGENT); }
__device__ __forceinline__ unsigned xb_add(unsigned* p, unsigned v) { return __hip_atomic_fetch_add(p, v, __ATOMIC_RELAXED, __HIP_MEMORY_SCOPE_AGENT); }
__device__ __forceinline__ unsigned xb_xcc_id() { return (unsigned)__builtin_amdgcn_s_getreg((3 << 11) | 20) & 0xFu; }
#define XB_SPIN(cond, bar) do { unsigned _sp = 0; while (cond) { __builtin_amdgcn_s_sleep(1); \
    if ((++_sp & 255u) == 0u) { if (xb_ld(&(bar)[XB_TMO])) break; if (_sp > XB_SPIN_CAP) { atomicAdd(&(bar)[XB_TMO], 1u); break; } } } } while (0)
struct XcdBarrier { unsigned* bar; unsigned x; volatile LAS unsigned* st; };
__device__ __forceinline__ XcdBarrier xcd_barrier_post(unsigned* bar, volatile LAS unsigned* st) {
    XcdBarrier b; b.bar = bar; b.x = xb_xcc_id(); b.st = st;
    if (threadIdx.x == 0) (void)xb_add(&bar[XB_XCNT(b.x)], 1u);
    return b;
}
__device__ __forceinline__ void xcd_barrier_complete(unsigned* bar, unsigned x, unsigned& nloc, unsigned& nx) {
    const unsigned G = gridDim.x * gridDim.y * gridDim.z;
    unsigned sum, cnt, mine, sp = 0u;
    for (;;) {
        sum = 0u; cnt = 0u; mine = 0u;
#pragma unroll
        for (unsigned j = 0; j < 16; ++j) { const unsigned c = xb_ld(&bar[XB_XCNT(j)]); sum += c; cnt += (c > 0u) ? 1u : 0u; mine = (j == x) ? c : mine; }
        if (sum == G) break;
        __builtin_amdgcn_s_sleep(1);
        if ((++sp & 255u) == 0u) { if (xb_ld(&bar[XB_TMO])) break; if (sp > XB_SPIN_CAP) { atomicAdd(&bar[XB_TMO], 1u); break; } }
    }
    nloc = mine > 0u ? mine : 1u; nx = cnt > 0u ? cnt : 1u;
}
__device__ __forceinline__ void xcd_barrier(const XcdBarrier& b) {
    asm volatile("s_waitcnt vmcnt(0)" ::: "memory");
    __syncthreads();
    if (threadIdx.x == 0) {
        unsigned* bar = b.bar;
        __builtin_amdgcn_s_waitcnt(0);
        unsigned nloc = b.st[0], nx = b.st[1];
        if (nloc == 0u) { xcd_barrier_complete(bar, b.x, nloc, nx); b.st[0] = nloc; b.st[1] = nx; }
        const unsigned old = xb_add(&bar[XB_XSUB(b.x)], 1u);
        const unsigned gen = old / nloc;
        if (old + 1u == (gen + 1u) * nloc) {
            __builtin_amdgcn_fence(__ATOMIC_RELEASE, "agent");
            asm volatile("s_waitcnt vmcnt(0)" ::: "memory");
            const unsigned og = xb_add(&bar[XB_TOP], 1u);
            const unsigned tg = og / nx;
            if (og + 1u == (tg + 1u) * nx) xb_add(&bar[XB_TOPGEN], 1u);
            else XB_SPIN(xb_ld(&bar[XB_TOPGEN]) == tg, bar);
            __builtin_amdgcn_fence(__ATOMIC_ACQUIRE, "agent");
            xb_add(&bar[XB_XGEN(b.x)], 1u);
            asm volatile("s_waitcnt vmcnt(0)" ::: "memory");
        } else {
            XB_SPIN(xb_ld(&bar[XB_XGEN(b.x)]) == gen, bar);
            __builtin_amdgcn_fence(__ATOMIC_ACQUIRE, "agent");
            asm volatile("s_waitcnt vmcnt(0)" ::: "memory");
        }
    }
    __syncthreads();
}

struct Args { const float* in[19]; float* out; unsigned char* ws; int ph_lo, ph_hi; };
struct Ctx {
    unsigned char* lds; int tid, lane, wave, G, bid;
    const float *x, *norm_mix, *w_in, *conv_w, *conv_b, *dt_bias, *a_log, *d_skip, *ssd_norm, *sinks, *attn_norm, *w_out, *norm_ffn, *w_rg, *w_re, *w_gate, *w_up, *w_down, *norm_final;
    float* out; unsigned char* ws;
    bf16 *XN, *PROJ, *HID, *YB, *ST, *MIX, *WIN, *WOUT, *WGU, *WD; int vcu; float *DT, *CDEC, *TG; int *TE, *TP, *LIST; unsigned* ctl;
};

namespace pg8 {
typedef short bf16x8 __attribute__((ext_vector_type(8)));
constexpr int BM = 256, BK = 64, HALF = 128, HTB = HALF * BK * 2, STAGE_BYTES = 8 * HTB, NXCD = 8, WGM = 8;
__device__ __forceinline__ int lds_byte(int r, int c) { const int st = (r >> 4) * 2 + (c >> 5), rr = r & 15, cc = c & 31, ob = rr * 64 + cc * 2; return st * 1024 + (ob ^ (((ob >> 9) & 1) << 5)); }
__device__ __forceinline__ void stage_rc(int b, int& R, int& C) { const int st = b / 1024, sb = b % 1024, swz = sb ^ (((sb >> 9) & 1) << 5); R = (st >> 1) * 16 + swz / 64; C = (st & 1) * 32 + (swz % 64) / 2; }
__device__ __forceinline__ int perm32(int rho) { const int n = rho >> 4, i = rho & 15; return 8 * (i >> 2) + 4 * n + (i & 3); }
__device__ __forceinline__ unsigned cvt_pk_bf16(float lo, float hi) { unsigned r; asm volatile("v_cvt_pk_bf16_f32 %0, %1, %2" : "=v"(r) : "v"(lo), "v"(hi)); return r; }

struct Unit { int pm, pn, e, mt, rowbase, cnt; const char* bt; };

struct DenseOrder {
    int nM, nN, nwg, G, c, K; const char* Bt;
    __device__ void init(int M, int N, int K_, const bf16* Bt_, int G_, int c_) { nM = M / BM; nN = N / BM; nwg = nM * nN; G = G_; c = c_; K = K_; Bt = (const char*)Bt_; }
    __device__ __forceinline__ bool next(int i, Unit& u) const {
        const long L = (long)i * G + c; if (L >= nwg) return false;
        int wgid = (int)L; { const int q = nwg / NXCD, r = nwg % NXCD, xcd = wgid % NXCD, off = wgid / NXCD; wgid = (xcd < r ? xcd * (q + 1) : r * (q + 1) + (xcd - r) * q) + off; }
        const int nig = WGM * nN, gid = wgid / nig, fm = gid * WGM, gsz = (nM - fm) < WGM ? (nM - fm) : WGM;
        u.pm = fm + ((wgid % nig) % gsz); u.pn = (wgid % nig) / gsz; u.e = 0; u.mt = 0; u.rowbase = u.pm * BM; u.cnt = BM;
        u.bt = Bt + (size_t)u.pn * BM * K * 2; return true;
    }
    __device__ __forceinline__ unsigned arow(const Unit& u, int R) const { return (unsigned)(u.rowbase + R); }
};
template <bool GATHER> struct MoeOrder {
    const int *cnt, *pstart, *tstart; const int* LIST; const char* W; size_t wstride; int K, npn, ntiles, G, c;
    __device__ __forceinline__ bool next(int i, Unit& u) const {
        const long L = (long)i * G + c; if (L >= (long)ntiles * npn) return false;
        const int tile = (int)(L / npn); u.pn = (int)(L % npn); u.pm = tile;
        int e = 0; while (tstart[e + 1] <= tile) ++e;
        u.e = e; u.mt = tile - tstart[e]; u.rowbase = pstart[e] + u.mt * BM; u.cnt = cnt[e];
        u.bt = W + (size_t)e * wstride + (size_t)u.pn * BM * K * 2; return true;
    }
    __device__ __forceinline__ unsigned arow(const Unit& u, int R) const {
        if (GATHER) { const int pos = u.mt * BM + R; return pos < u.cnt ? (unsigned)(LIST[(size_t)u.e * LISTCAP + pos] >> 1) : 0u; }
        return (unsigned)(u.rowbase + R);
    }
};

struct EpiProj {
    static constexpr bool PERM = true; bf16* O; int ldc;
    __device__ __forceinline__ void operator()(const f32x4 (&acc)[2][2][4][2], const Unit& u, int wr, int wc, int fr, int fq) const {
        bf16* base = O + (size_t)(u.pm * BM + wr * 64 + fr) * ldc + u.pn * BM + wc * 32 + 8 * fq;
#pragma unroll
        for (int ai = 0; ai < 2; ++ai)
#pragma unroll
            for (int m = 0; m < 4; ++m) { bf16* rowp = base + (size_t)(ai * HALF + m * 16) * ldc;
#pragma unroll
                for (int bj = 0; bj < 2; ++bj) { const f32x4 v0 = acc[ai][bj][m][0], v1 = acc[ai][bj][m][1];
                    u32x4 w; w.x = cvt_pk_bf16(v0[0], v0[1]); w.y = cvt_pk_bf16(v0[2], v0[3]); w.z = cvt_pk_bf16(v1[0], v1[1]); w.w = cvt_pk_bf16(v1[2], v1[3]);
                    *(u32x4*)(rowp + bj * HALF) = w; } }
    }
};
struct EpiResid {
    static constexpr bool PERM = false; const float* base; float* out;
    __device__ __forceinline__ void operator()(const f32x4 (&acc)[2][2][4][2], const Unit& u, int wr, int wc, int fr, int fq) const {
        const size_t o0 = (size_t)(u.pm * BM + wr * 64 + fr) * DM + u.pn * BM + wc * 32 + 4 * fq;
#pragma unroll
        for (int ai = 0; ai < 2; ++ai)
#pragma unroll
            for (int m = 0; m < 4; ++m)
#pragma unroll
                for (int bj = 0; bj < 2; ++bj)
#pragma unroll
                    for (int n = 0; n < 2; ++n) { const size_t off = o0 + (size_t)(ai * HALF + m * 16) * DM + bj * HALF + n * 16;
                        const f32x4 b = *(const f32x4*)(base + off); *(f32x4*)(out + off) = b + acc[ai][bj][m][n]; }
    }
};
struct EpiHid {
    static constexpr bool PERM = true; bf16* HID;
    __device__ __forceinline__ void operator()(const f32x4 (&acc)[2][2][4][2], const Unit& u, int wr, int wc, int fr, int fq) const {
        bf16* base = HID + (size_t)(u.rowbase + wr * 64 + fr) * FF + u.pn * 128 + wc * 32 + 8 * fq;
#pragma unroll
        for (int ai = 0; ai < 2; ++ai)
#pragma unroll
            for (int m = 0; m < 4; ++m) { f32x4 h0, h1;
#pragma unroll
                for (int i = 0; i < 4; ++i) { h0[i] = silu_f(acc[ai][0][m][0][i]) * acc[ai][1][m][0][i]; h1[i] = silu_f(acc[ai][0][m][1][i]) * acc[ai][1][m][1][i]; }
                u32x4 w; w.x = cvt_pk_bf16(h0[0], h0[1]); w.y = cvt_pk_bf16(h0[2], h0[3]); w.z = cvt_pk_bf16(h1[0], h1[1]); w.w = cvt_pk_bf16(h1[2], h1[3]);
                *(u32x4*)(base + (size_t)(ai * HALF + m * 16) * FF) = w; }
    }
};
struct EpiYb {
    static constexpr bool PERM = true; bf16* YB; const int* LIST; const float* TG;
    __device__ __forceinline__ void operator()(const f32x4 (&acc)[2][2][4][2], const Unit& u, int wr, int wc, int fr, int fq) const {
        bf16* base = YB + (size_t)(u.rowbase + wr * 64 + fr) * DM + u.pn * BM + wc * 32 + 8 * fq;
#pragma unroll
        for (int ai = 0; ai < 2; ++ai)
#pragma unroll
            for (int m = 0; m < 4; ++m) { const int pos = u.mt * BM + ai * HALF + wr * 64 + m * 16 + fr;
                float gt = 0.f; if (pos < u.cnt) gt = TG[LIST[(size_t)u.e * LISTCAP + pos]];
#pragma unroll
                for (int bj = 0; bj < 2; ++bj) { const f32x4 v0 = acc[ai][bj][m][0] * gt, v1 = acc[ai][bj][m][1] * gt;
                    u32x4 w; w.x = cvt_pk_bf16(v0[0], v0[1]); w.y = cvt_pk_bf16(v0[2], v0[3]); w.z = cvt_pk_bf16(v1[0], v1[1]); w.w = cvt_pk_bf16(v1[2], v1[3]);
                    *(u32x4*)(base + (size_t)(ai * HALF + m * 16) * DM + bj * HALF) = w; } }
    }
};

template <class Epi, class Sched, bool ALIGN_EPI>
__device__ __forceinline__ void gemm_phase(LAS unsigned char* lds, const char* Abase, const int K, const Sched& S, const Epi& E) {
    const int tid = threadIdx.x, wid = __builtin_amdgcn_readfirstlane(tid >> 6), lane = tid & 63, wr = wid >> 2, wc = wid & 3, fr = lane & 15, fq = lane >> 4;
    const int nt = K / BK;
    int Rp[2], Cp[2]; unsigned voffB[2];
#pragma unroll
    for (int i = 0; i < 2; ++i) { int R, C; stage_rc(tid * 16 + i * 8192, R, C); Rp[i] = R; Cp[i] = C; const int Rb = Epi::PERM ? ((R & ~31) + perm32(R & 31)) : R; voffB[i] = (unsigned)(Rb * K + C) * 2u; }
    const size_t kstep = (size_t)(BK * 2);
    const size_t hstep = (size_t)HALF * K * 2;
    const unsigned ldsw = (unsigned)wid * 1024u;
    const int aoff = lds_byte(wr * 64 + fr, fq * 8), boff = lds_byte(wc * 32 + fr, fq * 8);
#define PG8_SA(b, h) (((b) * 2 + (h)) * HTB)
#define PG8_SB(b, h) ((4 + (b) * 2 + (h)) * HTB)
#define PG8_STAGE(bufoff, gbase, voff) do { _Pragma("unroll") for (int _i = 0; _i < 2; ++_i) \
        __builtin_amdgcn_global_load_lds((const unsigned*)((const char*)(gbase) + (voff)[_i]), (LAS unsigned*)(lds + (bufoff) + ldsw + _i * 8192), 16, 0, 0); } while (0)
#define PG8_LDA(dst, b, h) do { _Pragma("unroll") for (int m = 0; m < 4; ++m) _Pragma("unroll") for (int k = 0; k < 2; ++k) dst[m][k] = *(const LAS bf16x8*)(lds + PG8_SA(b, h) + aoff + m * 2048 + k * 1024); } while (0)
#define PG8_LDB(dst, b, h) do { _Pragma("unroll") for (int n = 0; n < 2; ++n) _Pragma("unroll") for (int k = 0; k < 2; ++k) dst[n][k] = *(const LAS bf16x8*)(lds + PG8_SB(b, h) + boff + n * 2048 + k * 1024); } while (0)
#define PG8_MMA(ai, bj, At, Bt) do { __builtin_amdgcn_s_setprio(1); _Pragma("unroll") for (int m = 0; m < 4; ++m) _Pragma("unroll") for (int n = 0; n < 2; ++n) _Pragma("unroll") for (int k = 0; k < 2; ++k) \
        acc[ai][bj][m][n] = __builtin_amdgcn_mfma_f32_16x16x32_bf16(Bt[n][k], At[m][k], acc[ai][bj][m][n], 0, 0, 0); __builtin_amdgcn_s_setprio(0); } while (0)
#define PG8_WAIT_V(n) asm volatile("s_waitcnt vmcnt(" #n ")" ::: "memory")
#define PG8_WAIT_L(n) asm volatile("s_waitcnt lgkmcnt(" #n ")" ::: "memory")
#define PG8_BAR __builtin_amdgcn_s_barrier()
#define PG8_SCHED __builtin_amdgcn_sched_barrier(0)
#define PG8_OFFS(dst, un) do { _Pragma("unroll") for (int _h = 0; _h < 2; ++_h) _Pragma("unroll") for (int _i = 0; _i < 2; ++_i) \
        dst[_h][_i] = (S.arow(un, _h * HALF + Rp[_i]) * (unsigned)K + (unsigned)Cp[_i]) * 2u; } while (0)
    Unit cur, nxt; int ui = 0;
    if (!S.next(0, cur)) return;
    f32x4 acc[2][2][4][2];
#pragma unroll
    for (int a = 0; a < 2; ++a)
#pragma unroll
        for (int b = 0; b < 2; ++b)
#pragma unroll
            for (int m = 0; m < 4; ++m)
#pragma unroll
                for (int n = 0; n < 2; ++n) acc[a][b][m][n] = (f32x4){0.f, 0.f, 0.f, 0.f};
    bf16x8 At[4][2], B0[2][2], B1[2][2];
    unsigned co[2][2], no[2][2];
    PG8_OFFS(co, cur);
    const char* cB = cur.bt;
    PG8_STAGE(PG8_SB(0, 0), cB, voffB); PG8_STAGE(PG8_SB(0, 1), cB + hstep, voffB); PG8_STAGE(PG8_SA(0, 0), Abase, co[0]); PG8_STAGE(PG8_SA(0, 1), Abase, co[1]);
    if (wr == 1) PG8_BAR;
    PG8_WAIT_V(2); PG8_BAR;
    PG8_STAGE(PG8_SB(1, 0), cB + kstep, voffB); PG8_STAGE(PG8_SA(1, 0), Abase + kstep, co[0]); PG8_STAGE(PG8_SB(1, 1), cB + hstep + kstep, voffB);
    PG8_WAIT_V(6); PG8_BAR;
    for (;;) {
        const bool has_next = S.next(ui + 1, nxt);
        if (has_next) { PG8_OFFS(no, nxt); } else {
#pragma unroll
            for (int h = 0; h < 2; ++h) { no[h][0] = co[h][0]; no[h][1] = co[h][1]; } }
        const char* nB = has_next ? nxt.bt : cB;
        for (int t = 0; t < nt; t += 2) {
            const bool last = (t == nt - 2);
            const char* a1 = Abase + (size_t)(t + 1) * kstep;
            const char* a2 = last ? Abase : Abase + (size_t)(t + 2) * kstep; const char* b2 = last ? nB : cB + (size_t)(t + 2) * kstep;
            const char* a3 = a2 + kstep; const char* b3 = b2 + kstep;
            unsigned s2[2][2];
#pragma unroll
            for (int h = 0; h < 2; ++h) { s2[h][0] = last ? no[h][0] : co[h][0]; s2[h][1] = last ? no[h][1] : co[h][1]; }
            PG8_LDB(B0, 0, 0); PG8_LDB(B1, 0, 1); PG8_SCHED; PG8_LDA(At, 0, 0); PG8_STAGE(PG8_SA(1, 1), a1, co[1]);
            PG8_WAIT_V(8); PG8_WAIT_L(0); PG8_BAR; PG8_MMA(0, 0, At, B0); PG8_MMA(0, 1, At, B1); PG8_BAR; PG8_SCHED;
            PG8_LDA(At, 0, 1); PG8_STAGE(PG8_SB(0, 0), b2, voffB); PG8_STAGE(PG8_SB(0, 1), b2 + hstep, voffB); PG8_STAGE(PG8_SA(0, 0), a2, s2[0]);
            PG8_WAIT_V(8); PG8_WAIT_L(0); PG8_BAR; PG8_MMA(1, 0, At, B0); PG8_MMA(1, 1, At, B1); PG8_BAR; PG8_SCHED;
            PG8_LDB(B0, 1, 0); PG8_LDB(B1, 1, 1); PG8_SCHED; PG8_LDA(At, 1, 0); PG8_STAGE(PG8_SA(0, 1), a2, s2[1]);
            PG8_WAIT_V(8); PG8_WAIT_L(0); PG8_BAR; PG8_MMA(0, 0, At, B0); PG8_MMA(0, 1, At, B1); PG8_BAR; PG8_SCHED;
            PG8_LDA(At, 1, 1); PG8_STAGE(PG8_SB(1, 0), b3, voffB); PG8_STAGE(PG8_SB(1, 1), b3 + hstep, voffB); PG8_STAGE(PG8_SA(1, 0), a3, s2[0]);
            PG8_WAIT_V(8); PG8_WAIT_L(0); PG8_BAR; PG8_MMA(1, 0, At, B0); PG8_MMA(1, 1, At, B1); PG8_BAR; PG8_SCHED;
        }
        if constexpr (ALIGN_EPI) { if (wr == 0) PG8_BAR; }
        E(acc, cur, wr, wc, fr, fq);
        if (!has_next) break;
#pragma unroll
        for (int a = 0; a < 2; ++a)
#pragma unroll
            for (int b = 0; b < 2; ++b)
#pragma unroll
                for (int m = 0; m < 4; ++m)
#pragma unroll
                    for (int n = 0; n < 2; ++n) acc[a][b][m][n] = (f32x4){0.f, 0.f, 0.f, 0.f};
        cur = nxt; cB = nB; ++ui;
#pragma unroll
        for (int h = 0; h < 2; ++h) { co[h][0] = no[h][0]; co[h][1] = no[h][1]; }
        if constexpr (ALIGN_EPI) { if (wr == 1) PG8_BAR; }
    }
    PG8_WAIT_V(0);
    if constexpr (!ALIGN_EPI) { if (wr == 0) PG8_BAR; }
    PG8_BAR;
#undef PG8_SA
#undef PG8_SB
#undef PG8_STAGE
#undef PG8_LDA
#undef PG8_LDB
#undef PG8_MMA
#undef PG8_WAIT_V
#undef PG8_WAIT_L
#undef PG8_BAR
#undef PG8_SCHED
#undef PG8_OFFS
}
}

__device__ __forceinline__ void transpose_item(const float* W, int ldw, int k0, int n0, bf16* WT, int K, int drow0, LAS float* scr, int lane) {
#pragma unroll 8
    for (int i = 0; i < 32; ++i) { const int kk = 2 * i + (lane >> 5); scr[kk * 33 + (lane & 31)] = W[(size_t)(k0 + kk) * ldw + n0 + (lane & 31)]; }
    asm volatile("s_waitcnt lgkmcnt(0)" ::: "memory");
    const int c = lane & 7;
#pragma unroll
    for (int j = 0; j < 4; ++j) { const int n = (lane >> 3) + 8 * j; const LAS float* s = scr + (8 * c) * 33 + n;
        u32x4 o; o.x = pk2(s[0 * 33], s[1 * 33]); o.y = pk2(s[2 * 33], s[3 * 33]); o.z = pk2(s[4 * 33], s[5 * 33]); o.w = pk2(s[6 * 33], s[7 * 33]);
        *(u32x4*)(WT + (size_t)(drow0 + n) * K + k0 + 8 * c) = o; }
    asm volatile("s_waitcnt lgkmcnt(0)" ::: "memory");
}

__device__ __forceinline__ float conv_silu(const Ctx& C, int b, int t, int ch) {
    float acc = C.conv_b[ch];
#pragma unroll
    for (int j = 0; j < 4; ++j) { const int tt = t - 3 + j; if (tt >= 0) acc += C.conv_w[j * CONVCH + ch] * bf2f(C.PROJ[(size_t)(b * SEQ + tt) * NPROJ + PX + ch]); }
    return silu_f(acc);
}

__device__ __forceinline__ void phase_prologue(Ctx& C) {
    float* W = (float*)C.lds;
    for (int idx = C.tid; idx < 16 * 1024; idx += NTHREADS) { const int k = idx >> 4, j = idx & 15; W[j * 1024 + k] = C.w_in[(size_t)k * INDIM + DT0 + j]; }
    __syncthreads();
    const int gw = C.bid * NWAVES + C.wave, NGW = C.G * NWAVES;
    for (int row = gw; row < M; row += NGW) {
        const f32x4* xr = (const f32x4*)(C.x + (size_t)row * DM) + C.lane;
        f32x4 v[4]; float ss = 0.f;
#pragma unroll
        for (int j = 0; j < 4; ++j) { v[j] = xr[64 * j]; ss += v[j][0] * v[j][0] + v[j][1] * v[j][1] + v[j][2] * v[j][2] + v[j][3] * v[j][3]; }
        const float rstd = 1.0f / sqrtf(wave_sum(ss) * (1.0f / DM) + EPS);
        u32x2* o = (u32x2*)(C.XN + (size_t)row * DM) + C.lane;
#pragma unroll
        for (int j = 0; j < 4; ++j) { const f32x4 g = ((const f32x4*)C.norm_mix)[C.lane + 64 * j]; v[j] = v[j] * rstd * g; u32x2 w; w.x = pk2(v[j][0], v[j][1]); w.y = pk2(v[j][2], v[j][3]); o[64 * j] = w; }
        float mine = 0.f;
#pragma unroll 2
        for (int jj = 0; jj < 16; ++jj) {
            float p = 0.f;
#pragma unroll
            for (int j = 0; j < 4; ++j) { const f32x4 w4 = *(const f32x4*)(W + jj * 1024 + (C.lane + 64 * j) * 4); p += v[j][0] * w4[0] + v[j][1] * w4[1] + v[j][2] * w4[2] + v[j][3] * w4[3]; }
            p = wave_sum(p);
            if (C.lane == jj) mine = p;
        }
        if (C.lane < 16) C.DT[(size_t)row * 16 + C.lane] = softplus_f(mine + C.dt_bias[C.lane]);
    }
    __syncthreads();
    LAS float* scr = (LAS float*)((LAS unsigned char*)C.lds + C.wave * 8704);
    for (int it = gw; it < 1920 + 1024; it += NGW) {
        if (it < 1920) { const int kb = it / 120, nb = it % 120, n0 = nb * 32; transpose_item(C.w_in, INDIM, kb * 64, n0 < DT0 ? n0 : n0 + 16, C.WIN, DM, n0, scr, C.lane); }
        else { const int r = it - 1920, kb = r >> 5, nb = r & 31; transpose_item(C.w_out, DM, kb * 64, nb * 32, C.WOUT, 2048, nb * 32, scr, C.lane); }
    }
}

__device__ __forceinline__ void phase_gemm1(Ctx& C) {
    pg8::DenseOrder S; S.init(M, NPROJ, DM, C.WIN, C.G, C.bid);
    pg8::EpiProj E{C.PROJ, NPROJ};
    pg8::gemm_phase<pg8::EpiProj, pg8::DenseOrder, true>((LAS unsigned char*)C.lds, (const char*)C.XN, DM, S, E);
}

__device__ __forceinline__ void ssd_states_unit(Ctx& C, int u) {
    const int g = u & 1, c = (u >> 1) & 31, b = u >> 6;
    float* Bs = (float*)C.lds;
    float* xs = Bs + 128 * 128;
    float* dtl = xs + 128 * 64;
    float* acs = dtl + 128;
    float* wl = acs + 128;
    const int t0 = c * CHK;
    __syncthreads();
    for (int idx = C.tid; idx < 128 * 128; idx += NTHREADS) { const int l = idx >> 7, n = idx & 127; Bs[idx] = conv_silu(C, b, t0 + l, 1024 + g * 128 + n); }
    for (int r = 0; r < 8; ++r) {
        const int h = g * 8 + r;
        __syncthreads();
        if (C.tid < 128) dtl[C.tid] = C.DT[(size_t)(b * SEQ + t0 + C.tid) * 16 + h];
        __syncthreads();
        if (C.tid == 0) { const float A = -expf(C.a_log[h]); float run = 0.f; for (int l = 0; l < 128; ++l) { run += dtl[l] * A; acs[l] = run; } }
        __syncthreads();
        if (C.tid < 128) wl[C.tid] = dtl[C.tid] * expf(acs[127] - acs[C.tid]);
        for (int idx = C.tid; idx < 128 * 64; idx += NTHREADS) { const int l = idx >> 6, p = idx & 63; xs[idx] = conv_silu(C, b, t0 + l, h * 64 + p); }
        __syncthreads();
        const int n = C.tid & 127, pg = C.tid >> 7;
        float acc[16];
#pragma unroll
        for (int i = 0; i < 16; ++i) acc[i] = 0.f;
        for (int l = 0; l < 128; ++l) {
            const float bv = Bs[l * 128 + n] * wl[l];
#pragma unroll
            for (int i = 0; i < 16; ++i) acc[i] += xs[l * 64 + pg * 16 + i] * bv;
        }
        bf16* st = C.ST + ((size_t)((b * NCH + c) * NH + h)) * (HD * NST);
#pragma unroll
        for (int i = 0; i < 16; ++i) st[(pg * 16 + i) * NST + n] = (bf16)f2bf(acc[i]);
        if (C.tid == 0) C.CDEC[(b * NCH + c) * NH + h] = expf(acs[127]);
    }
    __syncthreads();
}

__device__ __forceinline__ void attn_unit(Ctx& C, int u) {
    const int blk = u & 31, b = u >> 5;
    float* Ks = (float*)C.lds;
    float* Vs = Ks + 256 * 68;
    float* ssq = Vs + 256 * 68;
    const int t0 = blk * 128;
    __syncthreads();
    if (C.tid < 128) ssq[C.tid] = 0.f;
    for (int kv = 0; kv < 2; ++kv) {
        __syncthreads();
        for (int idx = C.tid; idx < 256 * 64; idx += NTHREADS) {
            const int key = idx >> 6, d = idx & 63, t = t0 - 128 + key;
            float kvv = 0.f, vvv = 0.f;
            if (t >= 0) { const bf16* pr = C.PROJ + (size_t)(b * SEQ + t) * NPROJ; kvv = bf2f(pr[PK + kv * 64 + d]); vvv = bf2f(pr[PV + kv * 64 + d]); }
            Ks[key * 68 + d] = kvv; Vs[key * 68 + d] = vvv;
        }
        __syncthreads();
        for (int pr2 = 0; pr2 < 2; ++pr2) {
            const int pair = pr2 * 512 + C.tid, r = pair >> 7, qi = pair & 127, hq = kv * 8 + r;
            const bf16* qp = C.PROJ + (size_t)(b * SEQ + t0 + qi) * NPROJ + PQ + hq * 64;
            unsigned qw[32]; float o[64];
#pragma unroll
            for (int d = 0; d < 32; ++d) { qw[d] = *(const unsigned*)(qp + 2 * d); }
#pragma unroll
            for (int d = 0; d < 64; ++d) o[d] = 0.f;
            float m = C.sinks[hq], l = 1.0f;
            for (int j = 1; j <= 128; ++j) {
                const int key = qi + j;
                if (t0 - 128 + key < 0) continue;
                const float* kr = Ks + key * 68; const float* vr = Vs + key * 68;
                float s = 0.f;
#pragma unroll
                for (int d = 0; d < 64; d += 4) { const f32x4 k4 = *(const f32x4*)(kr + d); s += bf2f(qw[d >> 1]) * k4[0] + bf2f(qw[d >> 1] >> 16) * k4[1] + bf2f(qw[(d >> 1) + 1]) * k4[2] + bf2f(qw[(d >> 1) + 1] >> 16) * k4[3]; }
                s *= 0.125f;
                if (s > m) { const float al = expf(m - s); l *= al;
#pragma unroll
                    for (int d = 0; d < 64; ++d) o[d] *= al;
                    m = s; }
                const float p = expf(s - m); l += p;
#pragma unroll
                for (int d = 0; d < 64; d += 4) { const f32x4 v4 = *(const f32x4*)(vr + d); o[d] += p * v4[0]; o[d + 1] += p * v4[1]; o[d + 2] += p * v4[2]; o[d + 3] += p * v4[3]; }
            }
            const float inv = 1.0f / l; float sq = 0.f;
            bf16* op = C.MIX + (size_t)(b * SEQ + t0 + qi) * 2048 + 1024 + hq * 64;
#pragma unroll
            for (int d = 0; d < 64; d += 2) { const float a0 = o[d] * inv, a1 = o[d + 1] * inv; sq += a0 * a0 + a1 * a1; *(unsigned*)(op + d) = pk2(a0, a1); }
            atomicAdd(&ssq[qi], sq);
        }
    }
    __syncthreads();
    for (int idx = C.tid; idx < 128 * 512; idx += NTHREADS) {
        const int qi = idx >> 9, c2 = (idx & 511) * 2;
        const float rs = 1.0f / sqrtf(ssq[qi] * (1.0f / 1024.f) + EPS);
        unsigned* p = (unsigned*)(C.MIX + (size_t)(b * SEQ + t0 + qi) * 2048 + 1024 + c2);
        const unsigned w = *p;
        *p = pk2(bf2f(w) * rs * C.attn_norm[c2], bf2f(w >> 16) * rs * C.attn_norm[c2 + 1]);
    }
    __syncthreads();
}

__device__ __forceinline__ void phase_scan(Ctx& C) {
    const int total = NB * NH * HD * NST;
    for (int e = C.bid * NTHREADS + C.tid; e < total; e += C.G * NTHREADS) {
        const int pn = e & (HD * NST - 1), h = (e >> 13) & 15, b = e >> 17;
        float carry = 0.f;
        for (int c = 0; c < NCH; ++c) {
            bf16* p = C.ST + ((size_t)((b * NCH + c) * NH + h)) * (HD * NST) + pn;
            const float s = bf2f(*p), dec = C.CDEC[(b * NCH + c) * NH + h];
            *p = (bf16)f2bf(carry);
            carry = carry * dec + s;
        }
    }
}

__device__ __forceinline__ void ssd_out_unit(Ctx& C, int u) {
    const int g = u & 1, c = (u >> 1) & 31, b = u >> 6;
    bf16* Cs = (bf16*)C.lds;
    bf16* Bs = Cs + 128 * 130;
    float* xs = (float*)Bs;
    float* cb = (float*)(C.lds + 2 * 33280);
    bf16* pv = (bf16*)(C.lds + 2 * 33280 + 65536);
    float* dts = (float*)(C.lds + 2 * 33280 + 65536 + 16640);
    float* acs = dts + 128; float* ssl = acs + 128; float* rsl = ssl + 128;
    const int t0 = c * CHK;
    __syncthreads();
    for (int idx = C.tid; idx < 128 * 128; idx += NTHREADS) { const int l = idx >> 7, n = idx & 127;
        Bs[l * 130 + n] = (bf16)f2bf(conv_silu(C, b, t0 + l, 1024 + g * 128 + n));
        Cs[l * 130 + n] = (bf16)f2bf(conv_silu(C, b, t0 + l, 1280 + g * 128 + n)); }
    if (C.tid < 128) ssl[C.tid] = 0.f;
    __syncthreads();
    {
        const int s = C.tid & 127, lg = C.tid >> 7;
        float acc[32];
#pragma unroll
        for (int i = 0; i < 32; ++i) acc[i] = 0.f;
        for (int n = 0; n < 128; ++n) { const float bv = bf2f(Bs[s * 130 + n]);
#pragma unroll
            for (int i = 0; i < 32; ++i) acc[i] += bf2f(Cs[(lg * 32 + i) * 130 + n]) * bv; }
#pragma unroll
        for (int i = 0; i < 32; ++i) cb[(lg * 32 + i) * 128 + s] = acc[i];
    }
    for (int r = 0; r < 8; ++r) {
        const int h = g * 8 + r;
        __syncthreads();
        if (C.tid < 128) dts[C.tid] = C.DT[(size_t)(b * SEQ + t0 + C.tid) * 16 + h];
        __syncthreads();
        if (C.tid == 0) { const float A = -expf(C.a_log[h]); float run = 0.f; for (int l = 0; l < 128; ++l) { run += dts[l] * A; acs[l] = run; } }
        for (int idx = C.tid; idx < 128 * 64; idx += NTHREADS) { const int l = idx >> 6, p = idx & 63; xs[idx] = conv_silu(C, b, t0 + l, h * 64 + p); }
        { const bf16* st = C.ST + ((size_t)((b * NCH + c) * NH + h)) * (HD * NST);
          for (int idx = C.tid; idx < 64 * 128; idx += NTHREADS) { const int p = idx >> 7, n = idx & 127; pv[p * 130 + n] = st[idx]; } }
        __syncthreads();
        const int p = C.tid & 63, lg = C.tid >> 6;
        const float dsk = C.d_skip[h];
        for (int i = 0; i < 16; ++i) {
            const int l = lg * 16 + i;
            float acc = 0.f;
            for (int s = 0; s <= l; ++s) acc += cb[l * 128 + s] * __expf(acs[l] - acs[s]) * dts[s] * xs[s * 64 + p];
            float off = 0.f;
            for (int n = 0; n < 128; ++n) off += bf2f(Cs[l * 130 + n]) * bf2f(pv[p * 130 + n]);
            const float y = acc + __expf(acs[l]) * off + dsk * xs[l * 64 + p];
            const size_t row = (size_t)(b * SEQ + t0 + l);
            const float z = bf2f(C.PROJ[row * NPROJ + PZ + h * 64 + p]);
            const float uu = y * silu_f(z);
            C.MIX[row * 2048 + h * 64 + p] = (bf16)f2bf(uu);
            const float sq = wave_sum(uu * uu);
            if (C.lane == 0) ssl[l] += sq;
        }
    }
    __syncthreads();
    if (C.tid < 128) rsl[C.tid] = 1.0f / sqrtf(ssl[C.tid] * (1.0f / 512.f) + EPS);
    __syncthreads();
    for (int idx = C.tid; idx < 128 * 256; idx += NTHREADS) {
        const int l = idx >> 8, c2 = (idx & 255) * 2, col = g * 512 + c2;
        unsigned* p = (unsigned*)(C.MIX + (size_t)(b * SEQ + t0 + l) * 2048 + col);
        const unsigned w = *p;
        *p = pk2(bf2f(w) * rsl[l] * C.ssd_norm[col], bf2f(w >> 16) * rsl[l] * C.ssd_norm[col + 1]);
    }
    __syncthreads();
}

__device__ __forceinline__ void phase_gemm2(Ctx& C) {
    pg8::DenseOrder S; S.init(M, DM, 2048, C.WOUT, C.G, C.bid);
    pg8::EpiResid E{C.x, C.out};
    pg8::gemm_phase<pg8::EpiResid, pg8::DenseOrder, true>((LAS unsigned char*)C.lds, (const char*)C.MIX, 2048, S, E);
}

__device__ __forceinline__ void phase_router(Ctx& C) {
    float* T = (float*)C.lds + C.wave * 4096;
    const int gw = C.bid * NWAVES + C.wave, NGW = C.G * NWAVES;
    unsigned* cnt = C.ctl + CW_CNT;
    for (int r0 = gw * 4; r0 < M; r0 += NGW * 4) {
#pragma unroll
        for (int r = 0; r < 4; ++r) {
            const int row = r0 + r;
            const f32x4* hr = (const f32x4*)(C.out + (size_t)row * DM) + C.lane;
            f32x4 v[4]; float ss = 0.f;
#pragma unroll
            for (int j = 0; j < 4; ++j) { v[j] = hr[64 * j]; ss += v[j][0] * v[j][0] + v[j][1] * v[j][1] + v[j][2] * v[j][2] + v[j][3] * v[j][3]; }
            const float rstd = 1.0f / sqrtf(wave_sum(ss) * (1.0f / DM) + EPS);
            u32x2* o = (u32x2*)(C.XN + (size_t)row * DM) + C.lane;
#pragma unroll
            for (int j = 0; j < 4; ++j) { const f32x4 g = ((const f32x4*)C.norm_ffn)[C.lane + 64 * j]; v[j] = v[j] * rstd * g;
                u32x2 w; w.x = pk2(v[j][0], v[j][1]); w.y = pk2(v[j][2], v[j][3]); o[64 * j] = w;
                *(f32x4*)(T + r * 1024 + (C.lane + 64 * j) * 4) = v[j]; }
        }
        asm volatile("s_waitcnt lgkmcnt(0)" ::: "memory");
        float ae[4] = {0.f, 0.f, 0.f, 0.f}, ag[4] = {0.f, 0.f, 0.f, 0.f};
        for (int k = 0; k < DM; ++k) { const float w = C.w_re[k * 64 + C.lane];
#pragma unroll
            for (int r = 0; r < 4; ++r) ae[r] += T[r * 1024 + k] * w; }
        { const int col = C.lane & 7, ks = C.lane >> 3;
          for (int kk = 0; kk < 128; ++kk) { const int k = ks * 128 + kk; const float w = C.w_rg[k * 8 + col];
#pragma unroll
              for (int r = 0; r < 4; ++r) ag[r] += T[r * 1024 + k] * w; }
#pragma unroll
          for (int r = 0; r < 4; ++r) { ag[r] += __shfl_xor(ag[r], 8); ag[r] += __shfl_xor(ag[r], 16); ag[r] += __shfl_xor(ag[r], 32); } }
#pragma unroll
        for (int r = 0; r < 4; ++r) {
            const int row = r0 + r;
            float gl[8]; int gsel = 0; float gmax;
#pragma unroll
            for (int c2 = 0; c2 < 8; ++c2) gl[c2] = __shfl(ag[r], c2);
            gmax = gl[0];
#pragma unroll
            for (int c2 = 1; c2 < 8; ++c2) if (gl[c2] > gmax) { gmax = gl[c2]; gsel = c2; }
            float gsum = 0.f;
#pragma unroll
            for (int c2 = 0; c2 < 8; ++c2) gsum += expf(gl[c2] - gmax);
            const float pgrp = 1.0f / gsum;
            float el[8];
#pragma unroll
            for (int i = 0; i < 8; ++i) el[i] = __shfl(ae[r], gsel * 8 + i);
            int i0 = 0; float l0 = el[0];
#pragma unroll
            for (int i = 1; i < 8; ++i) if (el[i] > l0) { l0 = el[i]; i0 = i; }
            int i1 = -1; float l1 = -INFINITY;
#pragma unroll
            for (int i = 0; i < 8; ++i) if (i != i0 && el[i] > l1) { l1 = el[i]; i1 = i; }
            const float e1 = expf(l1 - l0), g0 = pgrp / (1.0f + e1), g1 = pgrp * e1 / (1.0f + e1);
            if (C.lane == 0) {
#pragma unroll
                for (int k = 0; k < 2; ++k) { const int e = gsel * 8 + (k == 0 ? i0 : i1);
                    const unsigned pos = atomicAdd(&cnt[e], 1u);
                    C.TE[row * 2 + k] = e; C.TP[row * 2 + k] = (int)pos; C.TG[row * 2 + k] = (k == 0 ? g0 : g1);
                    C.LIST[(size_t)e * LISTCAP + pos] = row * 2 + k; }
            }
        }
    }
    __syncthreads();
    LAS float* scr = (LAS float*)((LAS unsigned char*)C.lds + C.wave * 8704);
    for (int it = gw; it < NE * 768; it += NGW) {
        const int e = it / 768; int r = it % 768;
        if (r < 512) { const bool up = r >= 256; r &= 255; const int kb = r >> 4, nb = r & 15, n0 = nb * 32;
            transpose_item((up ? C.w_up : C.w_gate) + (size_t)e * DM * FF, FF, kb * 64, n0, C.WGU + (size_t)e * 1024 * 1024, DM, (n0 >> 7) * 256 + (n0 & 127) + (up ? 128 : 0), scr, C.lane); }
        else { r -= 512; const int kb = r >> 5, nb = r & 31; transpose_item(C.w_down + (size_t)e * FF * DM, DM, kb * 64, nb * 32, C.WD + (size_t)e * 1024 * FF, FF, nb * 32, scr, C.lane); }
    }
}

struct MoeTab { int* cnt; int* pstart; int* tstart; };
__device__ __forceinline__ MoeTab moe_tables(Ctx& C, int off) {
    MoeTab T; T.cnt = (int*)(C.lds + off); T.pstart = T.cnt + 64; T.tstart = T.pstart + 65;
    __syncthreads();
    if (C.tid < 64) T.cnt[C.tid] = (int)__hip_atomic_load(C.ctl + CW_CNT + C.tid, __ATOMIC_RELAXED, __HIP_MEMORY_SCOPE_AGENT);
    __syncthreads();
    if (C.tid == 0) { int ps = 0, ts = 0; for (int e = 0; e < 64; ++e) { T.pstart[e] = ps; T.tstart[e] = ts; ps += ((T.cnt[e] + 255) >> 8) << 8; ts += (T.cnt[e] + 255) >> 8; } T.pstart[64] = ps; T.tstart[64] = ts; }
    __syncthreads();
    return T;
}

constexpr int MOE_TAB_OFF = 132096;
__device__ __forceinline__ void phase_moe_a(Ctx& C) {
    const MoeTab T = moe_tables(C, MOE_TAB_OFF);
    pg8::MoeOrder<true> S{T.cnt, T.pstart, T.tstart, C.LIST, (const char*)C.WGU, (size_t)1024 * 1024 * 2, DM, 4, T.tstart[64], C.G, C.vcu};
    pg8::EpiHid E{C.HID};
    pg8::gemm_phase<pg8::EpiHid, pg8::MoeOrder<true>, true>((LAS unsigned char*)C.lds, (const char*)C.XN, DM, S, E);
}
__device__ __forceinline__ void phase_moe_b(Ctx& C) {
    const MoeTab T = moe_tables(C, MOE_TAB_OFF);
    pg8::MoeOrder<false> S{T.cnt, T.pstart, T.tstart, C.LIST, (const char*)C.WD, (size_t)1024 * FF * 2, FF, 4, T.tstart[64], C.G, C.vcu};
    pg8::EpiYb E{C.YB, C.LIST, C.TG};
    pg8::gemm_phase<pg8::EpiYb, pg8::MoeOrder<false>, true>((LAS unsigned char*)C.lds, (const char*)C.HID, FF, S, E);
}
__device__ __forceinline__ void phase_final(Ctx& C) {
    const MoeTab T = moe_tables(C, 0);
    const int gw = C.bid * NWAVES + C.wave, NGW = C.G * NWAVES;
    for (int row = gw; row < M; row += NGW) {
        const size_t s0 = (size_t)T.pstart[C.TE[row * 2]] + C.TP[row * 2], s1 = (size_t)T.pstart[C.TE[row * 2 + 1]] + C.TP[row * 2 + 1];
        f32x4* hr = (f32x4*)(C.out + (size_t)row * DM) + C.lane;
        const u32x2* y0 = (const u32x2*)(C.YB + s0 * DM) + C.lane; const u32x2* y1 = (const u32x2*)(C.YB + s1 * DM) + C.lane;
        f32x4 v[4]; float ss = 0.f;
#pragma unroll
        for (int j = 0; j < 4; ++j) { v[j] = hr[64 * j]; const u32x2 a = y0[64 * j], c = y1[64 * j];
            v[j][0] += bf2f(a.x) + bf2f(c.x); v[j][1] += bf2f(a.x >> 16) + bf2f(c.x >> 16); v[j][2] += bf2f(a.y) + bf2f(c.y); v[j][3] += bf2f(a.y >> 16) + bf2f(c.y >> 16);
            ss += v[j][0] * v[j][0] + v[j][1] * v[j][1] + v[j][2] * v[j][2] + v[j][3] * v[j][3]; }
        const float rstd = 1.0f / sqrtf(wave_sum(ss) * (1.0f / DM) + EPS);
#pragma unroll
        for (int j = 0; j < 4; ++j) { const f32x4 g = ((const f32x4*)C.norm_final)[C.lane + 64 * j]; hr[64 * j] = v[j] * rstd * g; }
    }
}

constexpr int NPHASE = 10;
__global__ void __launch_bounds__(NTHREADS, 2) fwd_kernel(Args args) {
    extern __shared__ __attribute__((aligned(16))) unsigned char lds[];
    Ctx C;
    C.lds = lds; C.tid = threadIdx.x; C.lane = C.tid & 63; C.wave = __builtin_amdgcn_readfirstlane(C.tid >> 6); C.G = gridDim.x; C.bid = blockIdx.x;
    C.x = args.in[0]; C.norm_mix = args.in[1]; C.w_in = args.in[2]; C.conv_w = args.in[3]; C.conv_b = args.in[4]; C.dt_bias = args.in[5]; C.a_log = args.in[6]; C.d_skip = args.in[7];
    C.ssd_norm = args.in[8]; C.sinks = args.in[9]; C.attn_norm = args.in[10]; C.w_out = args.in[11]; C.norm_ffn = args.in[12]; C.w_rg = args.in[13]; C.w_re = args.in[14];
    C.w_gate = args.in[15]; C.w_up = args.in[16]; C.w_down = args.in[17]; C.norm_final = args.in[18];
    C.out = args.out; C.ws = args.ws;
    unsigned char* ws = args.ws;
    C.ctl = (unsigned*)(ws + WS_CTL);
    C.XN = (bf16*)(ws + WS_XN); C.DT = (float*)(ws + WS_DT); C.PROJ = (bf16*)(ws + WS_PROJ); C.HID = (bf16*)(ws + WS_HID); C.YB = (bf16*)(ws + WS_YB);
    C.ST = (bf16*)(ws + WS_ST); C.MIX = (bf16*)(ws + WS_MIX); C.CDEC = (float*)(ws + WS_CDEC); C.TE = (int*)(ws + WS_TE); C.TP = (int*)(ws + WS_TP); C.TG = (float*)(ws + WS_TG);
    C.LIST = (int*)(ws + WS_LIST); C.WIN = (bf16*)(ws + WS_WIN); C.WOUT = (bf16*)(ws + WS_WOUT); C.WGU = (bf16*)(ws + WS_WGU); C.WD = (bf16*)(ws + WS_WD);
    C.vcu = (C.G % 8 == 0) ? (C.bid % 8) * (C.G / 8) + C.bid / 8 : C.bid;
    volatile LAS unsigned* MISC = (volatile LAS unsigned*)((LAS unsigned char*)lds + MISC_OFF);
    if (C.tid < 64) MISC[C.tid] = 0u;
    __syncthreads();
    XcdBarrier bar; bar.bar = C.ctl + CW_BAR; bar.x = 0; bar.st = nullptr;
#if ONE_LAUNCH
    bar = xcd_barrier_post(C.ctl + CW_BAR, MISC + 8);
#define GRID_BAR() xcd_barrier(bar)
#else
#define GRID_BAR() do {} while (0)
#endif
    const int lo = args.ph_lo, hi = args.ph_hi;
#define IN(k) (lo <= (k) && (k) < hi)
#define SEAM(k) do { if (IN(k) && IN((k) + 1)) GRID_BAR(); } while (0)
    if (IN(0)) { phase_prologue(C); } SEAM(0);
    if (IN(1)) { phase_gemm1(C); } SEAM(1);
    if (IN(2)) { for (int u = C.bid; u < NB * NCH * 2; u += C.G) ssd_states_unit(C, u); for (int u = C.bid; u < NB * 32; u += C.G) attn_unit(C, u); } SEAM(2);
    if (IN(3)) { phase_scan(C); } SEAM(3);
    if (IN(4)) { for (int u = C.bid; u < NB * NCH * 2; u += C.G) ssd_out_unit(C, u); } SEAM(4);
    if (IN(5)) { phase_gemm2(C); } SEAM(5);
    if (IN(6)) { phase_router(C); } SEAM(6);
    if (IN(7)) { phase_moe_a(C); } SEAM(7);
    if (IN(8)) { phase_moe_b(C); } SEAM(8);
    if (IN(9)) { phase_final(C); }
}

extern "C" void kernel_launch(void* const* d_in, const int* in_sizes, int n_in, void* d_out, int out_size, void* d_ws, size_t ws_size, hipStream_t stream) {
    static int grid = 0;
    if (grid == 0) {
        if (n_in != 19 || in_sizes[0] != M * DM || out_size != M * DM || ws_size < WS_END) { fprintf(stderr, "kernel_launch: unexpected shapes (n_in %d, in0 %d, out %d, ws %zu)\n", n_in, n_in > 0 ? in_sizes[0] : -1, out_size, ws_size); grid = -1; return; }
        int dev = 0, cus = 0, per_cu = 0;
        if (hipGetDevice(&dev) != hipSuccess || hipDeviceGetAttribute(&cus, hipDeviceAttributeMultiprocessorCount, dev) != hipSuccess) { grid = -1; return; }
        if (hipFuncSetAttribute((const void*)fwd_kernel, hipFuncAttributeMaxDynamicSharedMemorySize, LDS_BYTES) != hipSuccess) { fprintf(stderr, "kernel_launch: hipFuncSetAttribute failed\n"); grid = -1; return; }
        if (hipOccupancyMaxActiveBlocksPerMultiprocessor(&per_cu, (const void*)fwd_kernel, NTHREADS, LDS_BYTES) != hipSuccess || per_cu < 1) { fprintf(stderr, "kernel_launch: occupancy query says %d\n", per_cu); (void)hipGetLastError(); per_cu = 1; }
        grid = cus;
    }
    if (grid < 0) return;
    (void)hipMemsetAsync((char*)d_ws + WS_CTL, 0, CTL_BYTES, stream);
    Args a{};
    for (int i = 0; i < 19; ++i) a.in[i] = (const float*)d_in[i];
    a.out = (float*)d_out; a.ws = (unsigned char*)d_ws;
#if ONE_LAUNCH
    a.ph_lo = 0; a.ph_hi = NPHASE;
    hipLaunchKernelGGL(fwd_kernel, dim3(grid), dim3(NTHREADS), LDS_BYTES, stream, a);
#else
    for (int p = 0; p < NPHASE; ++p) { a.ph_lo = p; a.ph_hi = p + 1; hipLaunchKernelGGL(fwd_kernel, dim3(grid), dim3(NTHREADS), LDS_BYTES, stream, a); }
#endif
}
```

```cpp
#include <hip/hip_runtime.h>
#include <cstdio>
#include <cstdint>

#ifndef ONE_LAUNCH
#define ONE_LAUNCH 1
#endif

#define LAS __attribute__((address_space(3)))
typedef unsigned short bf16;
typedef float f32x4 __attribute__((ext_vector_type(4)));
typedef unsigned u32x4 __attribute__((ext_vector_type(4)));
typedef unsigned u32x2 __attribute__((ext_vector_type(2)));

constexpr int NB = 8, SEQ = 4096, DM = 1024, M = NB * SEQ;
constexpr int INDIM = 3856;
constexpr int NPROJ = 3840;
constexpr int PZ = 0, PX = 1024, PQ = 2560, PK = 3584, PV = 3712;
constexpr int DT0 = 2560;
constexpr int CONVCH = 1536;
constexpr int NH = 16, HD = 64, NST = 128, CHK = 128, NCH = SEQ / CHK;
constexpr int NE = 64, FF = 512, LISTCAP = 32768;
constexpr int SLOT_MAX = 81920;
constexpr float EPS = 1e-6f;

constexpr size_t MiB = 1u << 20;
constexpr size_t WS_CTL = 0, CTL_BYTES = 1 * MiB;
constexpr size_t WS_XN = 1 * MiB;
constexpr size_t WS_DT = 65 * MiB;
constexpr size_t WS_PROJ = 67 * MiB;
constexpr size_t WS_HID = WS_PROJ;
constexpr size_t WS_YB = WS_PROJ + 80 * MiB;
constexpr size_t WS_ST = 307 * MiB;
constexpr size_t WS_MIX = 371 * MiB;
constexpr size_t WS_WGU = 307 * MiB;
constexpr size_t WS_WD = 435 * MiB;
constexpr size_t WS_WIN = 499 * MiB;
constexpr size_t WS_WOUT = 507 * MiB;
constexpr size_t WS_MISC = 511 * MiB;
constexpr size_t WS_CDEC = WS_MISC;
constexpr size_t WS_TE = WS_MISC + 1 * MiB;
constexpr size_t WS_TP = WS_TE + 256 * 1024;
constexpr size_t WS_TG = WS_TP + 256 * 1024;
constexpr size_t WS_LIST = WS_MISC + 2 * MiB;
constexpr size_t WS_HALO = WS_LIST + 8 * MiB;
constexpr size_t WS_END = WS_HALO + 3 * MiB;
constexpr int CW_BAR = 4096;
constexpr int CW_CNT = 8192;

constexpr int NTHREADS = 512, NWAVES = 8;
constexpr int LDS_BYTES = 159744;
constexpr int MISC_OFF = LDS_BYTES - 256;

__device__ __forceinline__ unsigned f2bf(float f) { unsigned u = __builtin_bit_cast(unsigned, f); return (u + 0x7fffu + ((u >> 16) & 1u)) >> 16; }
__device__ __forceinline__ float bf2f(unsigned b) { return __builtin_bit_cast(float, (b & 0xffffu) << 16); }
__device__ __forceinline__ unsigned pk2(float lo, float hi) { return f2bf(lo) | (f2bf(hi) << 16); }
__device__ __forceinline__ float wave_sum(float v) {
#pragma unroll
    for (int o = 1; o < 64; o <<= 1) v += __shfl_xor(v, o);
    return v;
}
__device__ __forceinline__ float silu_f(float x) { return x / (1.0f + __expf(-x)); }
__device__ __forceinline__ float softplus_f(float x) { return x > 20.f ? x : log1pf(expf(x)); }

#define XB_TMO      128
#define XB_XCNT(j)  (256  + 64 * (j))
#define XB_XSUB(j)  (1280 + 64 * (j))
#define XB_XGEN(j)  (2304 + 64 * (j))
#define XB_TOP      3328
#define XB_TOPGEN   3392
#define XCD_BAR_WORDS 3456
#define XB_SPIN_CAP (1u << 27)
__device__ __forceinline__ unsigned xb_ld(unsigned* p)              { return __hip_atomic_load(p, __ATOMIC_RELAXED, __HIP_MEMORY_SCOPE_AGENT); }
__device__ __forceinline__ unsigned xb_add(unsigned* p, unsigned v) { return __hip_atomic_fetch_add(p, v, __ATOMIC_RELAXED, __HIP_MEMORY_SCOPE_AGENT); }
__device__ __forceinline__ unsigned xb_xcc_id() { return (unsigned)__builtin_amdgcn_s_getreg((3 << 11) | 20) & 0xFu; }
#define XB_SPIN(cond, bar) do { unsigned _sp = 0; while (cond) { __builtin_amdgcn_s_sleep(1); \
    if ((++_sp & 255u) == 0u) { if (xb_ld(&(bar)[XB_TMO])) break; if (_sp > XB_SPIN_CAP) { atomicAdd(&(bar)[XB_TMO], 1u); break; } } } } while (0)
struct XcdBarrier { unsigned* bar; unsigned x; volatile LAS unsigned* st; };
__device__ __forceinline__ XcdBarrier xcd_barrier_post(unsigned* bar, volatile LAS unsigned* st) {
    XcdBarrier b; b.bar = bar; b.x = xb_xcc_id(); b.st = st;
    if (threadIdx.x == 0) (void)xb_add(&bar[XB_XCNT(b.x)], 1u);
    return b;
}
__device__ __forceinline__ void xcd_barrier_complete(unsigned* bar, unsigned x, unsigned& nloc, unsigned& nx) {
    const unsigned G = gridDim.x * gridDim.y * gridDim.z;
    unsigned sum, cnt, mine, sp = 0u;
    for (;;) {
        sum = 0u; cnt = 0u; mine = 0u;
#pragma unroll
        for (unsigned j = 0; j < 16; ++j) { const unsigned c = xb_ld(&bar[XB_XCNT(j)]); sum += c; cnt += (c > 0u) ? 1u : 0u; mine = (j == x) ? c : mine; }
        if (sum == G) break;
        __builtin_amdgcn_s_sleep(1);
        if ((++sp & 255u) == 0u) { if (xb_ld(&bar[XB_TMO])) break; if (sp > XB_SPIN_CAP) { atomicAdd(&bar[XB_TMO], 1u); break; } }
    }
    nloc = mine > 0u ? mine : 1u; nx = cnt > 0u ? cnt : 1u;
}
__device__ __forceinline__ void xcd_barrier(const XcdBarrier& b) {
    asm volatile("s_waitcnt vmcnt(0)" ::: "memory");
    __syncthreads();
    if (threadIdx.x == 0) {
        unsigned* bar = b.bar;
        __builtin_amdgcn_s_waitcnt(0);
        unsigned nloc = b.st[0], nx = b.st[1];
        if (nloc == 0u) { xcd_barrier_complete(bar, b.x, nloc, nx); b.st[0] = nloc; b.st[1] = nx; }
        const unsigned old = xb_add(&bar[XB_XSUB(b.x)], 1u);
        const unsigned gen = old / nloc;
        if (old + 1u == (gen + 1u) * nloc) {
            __builtin_amdgcn_fence(__ATOMIC_RELEASE, "agent");
            asm volatile("s_waitcnt vmcnt(0)" ::: "memory");
            const unsigned og = xb_add(&bar[XB_TOP], 1u);
            const unsigned tg = og / nx;
            if (og + 1u == (tg + 1u) * nx) xb_add(&bar[XB_TOPGEN], 1u);
            else XB_SPIN(xb_ld(&bar[XB_TOPGEN]) == tg, bar);
            __builtin_amdgcn_fence(__ATOMIC_ACQUIRE, "agent");
            xb_add(&bar[XB_XGEN(b.x)], 1u);
            asm volatile("s_waitcnt vmcnt(0)" ::: "memory");
        } else {
            XB_SPIN(xb_ld(&bar[XB_XGEN(b.x)]) == gen, bar);
            __builtin_amdgcn_fence(__ATOMIC_ACQUIRE, "agent");
            asm volatile("s_waitcnt vmcnt(0)" ::: "memory");
        }
    }
    __syncthreads();
}

struct Args { const float* in[19]; float* out; unsigned char* ws; int ph_lo, ph_hi; };
struct Ctx {
    unsigned char* lds; int tid, lane, wave, G, bid;
    const float *x, *norm_mix, *w_in, *conv_w, *conv_b, *dt_bias, *a_log, *d_skip, *ssd_norm, *sinks, *attn_norm, *w_out, *norm_ffn, *w_rg, *w_re, *w_gate, *w_up, *w_down, *norm_final;
    float* out; unsigned char* ws;
    bf16 *XN, *PROJ, *HID, *YB, *ST, *MIX, *WIN, *WOUT, *WGU, *WD, *HALO; int vcu; float *DT, *CDEC, *TG; int *TE, *TP, *LIST; unsigned* ctl;
};

namespace pg8 {
typedef short bf16x8 __attribute__((ext_vector_type(8)));
constexpr int BM = 256, BK = 64, HALF = 128, HTB = HALF * BK * 2, STAGE_BYTES = 8 * HTB, NXCD = 8, WGM = 8;
__device__ __forceinline__ int lds_byte(int r, int c) { const int st = (r >> 4) * 2 + (c >> 5), rr = r & 15, cc = c & 31, ob = rr * 64 + cc * 2; return st * 1024 + (ob ^ (((ob >> 9) & 1) << 5)); }
__device__ __forceinline__ void stage_rc(int b, int& R, int& C) { const int st = b / 1024, sb = b % 1024, swz = sb ^ (((sb >> 9) & 1) << 5); R = (st >> 1) * 16 + swz / 64; C = (st & 1) * 32 + (swz % 64) / 2; }
__device__ __forceinline__ int perm32(int rho) { const int n = rho >> 4, i = rho & 15; return 8 * (i >> 2) + 4 * n + (i & 3); }
__device__ __forceinline__ unsigned cvt_pk_bf16(float lo, float hi) { unsigned r; asm volatile("v_cvt_pk_bf16_f32 %0, %1, %2" : "=v"(r) : "v"(lo), "v"(hi)); return r; }

struct Unit { int pm, pn, e, mt, rowbase, cnt; const char* bt; };

struct DenseOrder {
    int nM, nN, nwg, G, c, K; const char* Bt;
    __device__ void init(int M, int N, int K_, const bf16* Bt_, int G_, int c_) { nM = M / BM; nN = N / BM; nwg = nM * nN; G = G_; c = c_; K = K_; Bt = (const char*)Bt_; }
    __device__ __forceinline__ bool next(int i, Unit& u) const {
        const long L = (long)i * G + c; if (L >= nwg) return false;
        int wgid = (int)L; { const int q = nwg / NXCD, r = nwg % NXCD, xcd = wgid % NXCD, off = wgid / NXCD; wgid = (xcd < r ? xcd * (q + 1) : r * (q + 1) + (xcd - r) * q) + off; }
        const int nig = WGM * nN, gid = wgid / nig, fm = gid * WGM, gsz = (nM - fm) < WGM ? (nM - fm) : WGM;
        u.pm = fm + ((wgid % nig) % gsz); u.pn = (wgid % nig) / gsz; u.e = 0; u.mt = 0; u.rowbase = u.pm * BM; u.cnt = BM;
        u.bt = Bt + (size_t)u.pn * BM * K * 2; return true;
    }
    __device__ __forceinline__ unsigned arow(const Unit& u, int R) const { return (unsigned)(u.rowbase + R); }
};
template <bool GATHER> struct MoeOrder {
    const int *cnt, *pstart, *tstart; const int* LIST; const char* W; size_t wstride; int K, npn, ntiles, G, c;
    __device__ __forceinline__ bool next(int i, Unit& u) const {
        const long L = (long)i * G + c; if (L >= (long)ntiles * npn) return false;
        const int tile = (int)(L / npn); u.pn = (int)(L % npn); u.pm = tile;
        int e = 0; while (tstart[e + 1] <= tile) ++e;
        u.e = e; u.mt = tile - tstart[e]; u.rowbase = pstart[e] + u.mt * BM; u.cnt = cnt[e];
        u.bt = W + (size_t)e * wstride + (size_t)u.pn * BM * K * 2; return true;
    }
    __device__ __forceinline__ unsigned arow(const Unit& u, int R) const {
        if (GATHER) { const int pos = u.mt * BM + R; return pos < u.cnt ? (unsigned)(LIST[(size_t)u.e * LISTCAP + pos] >> 1) : 0u; }
        return (unsigned)(u.rowbase + R);
    }
};

struct EpiProj {
    static constexpr bool PERM = true; bf16* O; int ldc; bf16* HALO;
    __device__ __forceinline__ void operator()(const f32x4 (&acc)[2][2][4][2], const Unit& u, int wr, int wc, int fr, int fq) const {
        bf16* base = O + (size_t)(u.pm * BM + wr * 64 + fr) * ldc + u.pn * BM + wc * 32 + 8 * fq;
#pragma unroll
        for (int ai = 0; ai < 2; ++ai)
#pragma unroll
            for (int m = 0; m < 4; ++m) { bf16* rowp = base + (size_t)(ai * HALF + m * 16) * ldc;
#pragma unroll
                for (int bj = 0; bj < 2; ++bj) { const f32x4 v0 = acc[ai][bj][m][0], v1 = acc[ai][bj][m][1];
                    u32x4 w; w.x = cvt_pk_bf16(v0[0], v0[1]); w.y = cvt_pk_bf16(v0[2], v0[3]); w.z = cvt_pk_bf16(v1[0], v1[1]); w.w = cvt_pk_bf16(v1[2], v1[3]);
                    *(u32x4*)(rowp + bj * HALF) = w;
                    if (m == 3 && wr == 1 && fr >= 13 && u.pn >= 4 && u.pn < 10) {
                        const int row = u.pm * BM + ai * HALF + 125 + (fr - 13), col = u.pn * BM + bj * HALF + wc * 32 + 8 * fq - 1024;
                        *(u32x4*)(HALO + ((size_t)(row >> 7) * 3 + (fr - 13)) * CONVCH + col) = w; } } }
    }
};
struct EpiResid {
    static constexpr bool PERM = false; const float* base; float* out;
    __device__ __forceinline__ void operator()(const f32x4 (&acc)[2][2][4][2], const Unit& u, int wr, int wc, int fr, int fq) const {
        const size_t o0 = (size_t)(u.pm * BM + wr * 64 + fr) * DM + u.pn * BM + wc * 32 + 4 * fq;
#pragma unroll
        for (int ai = 0; ai < 2; ++ai)
#pragma unroll
            for (int m = 0; m < 4; ++m)
#pragma unroll
                for (int bj = 0; bj < 2; ++bj)
#pragma unroll
                    for (int n = 0; n < 2; ++n) { const size_t off = o0 + (size_t)(ai * HALF + m * 16) * DM + bj * HALF + n * 16;
                        const f32x4 b = *(const f32x4*)(base + off); *(f32x4*)(out + off) = b + acc[ai][bj][m][n]; }
    }
};
struct EpiHid {
    static constexpr bool PERM = true; bf16* HID;
    __device__ __forceinline__ void operator()(const f32x4 (&acc)[2][2][4][2], const Unit& u, int wr, int wc, int fr, int fq) const {
        bf16* base = HID + (size_t)(u.rowbase + wr * 64 + fr) * FF + u.pn * 128 + wc * 32 + 8 * fq;
#pragma unroll
        for (int ai = 0; ai < 2; ++ai)
#pragma unroll
            for (int m = 0; m < 4; ++m) { f32x4 h0, h1;
#pragma unroll
                for (int i = 0; i < 4; ++i) { h0[i] = silu_f(acc[ai][0][m][0][i]) * acc[ai][1][m][0][i]; h1[i] = silu_f(acc[ai][0][m][1][i]) * acc[ai][1][m][1][i]; }
                u32x4 w; w.x = cvt_pk_bf16(h0[0], h0[1]); w.y = cvt_pk_bf16(h0[2], h0[3]); w.z = cvt_pk_bf16(h1[0], h1[1]); w.w = cvt_pk_bf16(h1[2], h1[3]);
                *(u32x4*)(base + (size_t)(ai * HALF + m * 16) * FF) = w; }
    }
};
struct EpiYb {
    static constexpr bool PERM = true; bf16* YB; const int* LIST; const float* TG;
    __device__ __forceinline__ void operator()(const f32x4 (&acc)[2][2][4][2], const Unit& u, int wr, int wc, int fr, int fq) const {
        bf16* base = YB + (size_t)(u.rowbase + wr * 64 + fr) * DM + u.pn * BM + wc * 32 + 8 * fq;
#pragma unroll
        for (int ai = 0; ai < 2; ++ai)
#pragma unroll
            for (int m = 0; m < 4; ++m) { const int pos = u.mt * BM + ai * HALF + wr * 64 + m * 16 + fr;
                float gt = 0.f; if (pos < u.cnt) gt = TG[LIST[(size_t)u.e * LISTCAP + pos]];
#pragma unroll
                for (int bj = 0; bj < 2; ++bj) { const f32x4 v0 = acc[ai][bj][m][0] * gt, v1 = acc[ai][bj][m][1] * gt;
                    u32x4 w; w.x = cvt_pk_bf16(v0[0], v0[1]); w.y = cvt_pk_bf16(v0[2], v0[3]); w.z = cvt_pk_bf16(v1[0], v1[1]); w.w = cvt_pk_bf16(v1[2], v1[3]);
                    *(u32x4*)(base + (size_t)(ai * HALF + m * 16) * DM + bj * HALF) = w; } }
    }
};

template <class Epi, class Sched, bool ALIGN_EPI>
__device__ __forceinline__ void gemm_phase(LAS unsigned char* lds, const char* Abase, const int K, const Sched& S, const Epi& E) {
    const int tid = threadIdx.x, wid = __builtin_amdgcn_readfirstlane(tid >> 6), lane = tid & 63, wr = wid >> 2, wc = wid & 3, fr = lane & 15, fq = lane >> 4;
    const int nt = K / BK;
    int Rp[2], Cp[2]; unsigned voffB[2];
#pragma unroll
    for (int i = 0; i < 2; ++i) { int R, C; stage_rc(tid * 16 + i * 8192, R, C); Rp[i] = R; Cp[i] = C; const int Rb = Epi::PERM ? ((R & ~31) + perm32(R & 31)) : R; voffB[i] = (unsigned)(Rb * K + C) * 2u; }
    const size_t kstep = (size_t)(BK * 2);
    const size_t hstep = (size_t)HALF * K * 2;
    const unsigned ldsw = (unsigned)wid * 1024u;
    const int aoff = lds_byte(wr * 64 + fr, fq * 8), boff = lds_byte(wc * 32 + fr, fq * 8);
#define PG8_SA(b, h) (((b) * 2 + (h)) * HTB)
#define PG8_SB(b, h) ((4 + (b) * 2 + (h)) * HTB)
#define PG8_STAGE(bufoff, gbase, voff) do { _Pragma("unroll") for (int _i = 0; _i < 2; ++_i) \
        __builtin_amdgcn_global_load_lds((const unsigned*)((const char*)(gbase) + (voff)[_i]), (LAS unsigned*)(lds + (bufoff) + ldsw + _i * 8192), 16, 0, 0); } while (0)
#define PG8_LDA(dst, b, h) do { _Pragma("unroll") for (int m = 0; m < 4; ++m) _Pragma("unroll") for (int k = 0; k < 2; ++k) dst[m][k] = *(const LAS bf16x8*)(lds + PG8_SA(b, h) + aoff + m * 2048 + k * 1024); } while (0)
#define PG8_LDB(dst, b, h) do { _Pragma("unroll") for (int n = 0; n < 2; ++n) _Pragma("unroll") for (int k = 0; k < 2; ++k) dst[n][k] = *(const LAS bf16x8*)(lds + PG8_SB(b, h) + boff + n * 2048 + k * 1024); } while (0)
#define PG8_MMA(ai, bj, At, Bt) do { __builtin_amdgcn_s_setprio(1); _Pragma("unroll") for (int m = 0; m < 4; ++m) _Pragma("unroll") for (int n = 0; n < 2; ++n) _Pragma("unroll") for (int k = 0; k < 2; ++k) \
        acc[ai][bj][m][n] = __builtin_amdgcn_mfma_f32_16x16x32_bf16(Bt[n][k], At[m][k], acc[ai][bj][m][n], 0, 0, 0); __builtin_amdgcn_s_setprio(0); } while (0)
#define PG8_WAIT_V(n) asm volatile("s_waitcnt vmcnt(" #n ")" ::: "memory")
#define PG8_WAIT_L(n) asm volatile("s_waitcnt lgkmcnt(" #n ")" ::: "memory")
#define PG8_BAR __builtin_amdgcn_s_barrier()
#define PG8_SCHED __builtin_amdgcn_sched_barrier(0)
#define PG8_OFFS(dst, un) do { _Pragma("unroll") for (int _h = 0; _h < 2; ++_h) _Pragma("unroll") for (int _i = 0; _i < 2; ++_i) \
        dst[_h][_i] = (S.arow(un, _h * HALF + Rp[_i]) * (unsigned)K + (unsigned)Cp[_i]) * 2u; } while (0)
    Unit cur, nxt; int ui = 0;
    if (!S.next(0, cur)) return;
    f32x4 acc[2][2][4][2];
#pragma unroll
    for (int a = 0; a < 2; ++a)
#pragma unroll
        for (int b = 0; b < 2; ++b)
#pragma unroll
            for (int m = 0; m < 4; ++m)
#pragma unroll
                for (int n = 0; n < 2; ++n) acc[a][b][m][n] = (f32x4){0.f, 0.f, 0.f, 0.f};
    bf16x8 At[4][2], B0[2][2], B1[2][2];
    unsigned co[2][2], no[2][2];
    PG8_OFFS(co, cur);
    const char* cB = cur.bt;
    PG8_STAGE(PG8_SB(0, 0), cB, voffB); PG8_STAGE(PG8_SB(0, 1), cB + hstep, voffB); PG8_STAGE(PG8_SA(0, 0), Abase, co[0]); PG8_STAGE(PG8_SA(0, 1), Abase, co[1]);
    if (wr == 1) PG8_BAR;
    PG8_WAIT_V(2); PG8_BAR;
    PG8_STAGE(PG8_SB(1, 0), cB + kstep, voffB); PG8_STAGE(PG8_SA(1, 0), Abase + kstep, co[0]); PG8_STAGE(PG8_SB(1, 1), cB + hstep + kstep, voffB);
    PG8_WAIT_V(6); PG8_BAR;
    for (;;) {
        const bool has_next = S.next(ui + 1, nxt);
        if (has_next) { PG8_OFFS(no, nxt); } else {
#pragma unroll
            for (int h = 0; h < 2; ++h) { no[h][0] = co[h][0]; no[h][1] = co[h][1]; } }
        const char* nB = has_next ? nxt.bt : cB;
        for (int t = 0; t < nt; t += 2) {
            const bool last = (t == nt - 2);
            const char* a1 = Abase + (size_t)(t + 1) * kstep;
            const char* a2 = last ? Abase : Abase + (size_t)(t + 2) * kstep; const char* b2 = last ? nB : cB + (size_t)(t + 2) * kstep;
            const char* a3 = a2 + kstep; const char* b3 = b2 + kstep;
            unsigned s2[2][2];
#pragma unroll
            for (int h = 0; h < 2; ++h) { s2[h][0] = last ? no[h][0] : co[h][0]; s2[h][1] = last ? no[h][1] : co[h][1]; }
            PG8_LDB(B0, 0, 0); PG8_LDB(B1, 0, 1); PG8_SCHED; PG8_LDA(At, 0, 0); PG8_STAGE(PG8_SA(1, 1), a1, co[1]);
            PG8_WAIT_V(8); PG8_WAIT_L(0); PG8_BAR; PG8_MMA(0, 0, At, B0); PG8_MMA(0, 1, At, B1); PG8_BAR; PG8_SCHED;
            PG8_LDA(At, 0, 1); PG8_STAGE(PG8_SB(0, 0), b2, voffB); PG8_STAGE(PG8_SB(0, 1), b2 + hstep, voffB); PG8_STAGE(PG8_SA(0, 0), a2, s2[0]);
            PG8_WAIT_V(8); PG8_WAIT_L(0); PG8_BAR; PG8_MMA(1, 0, At, B0); PG8_MMA(1, 1, At, B1); PG8_BAR; PG8_SCHED;
            PG8_LDB(B0, 1, 0); PG8_LDB(B1, 1, 1); PG8_SCHED; PG8_LDA(At, 1, 0); PG8_STAGE(PG8_SA(0, 1), a2, s2[1]);
            PG8_WAIT_V(8); PG8_WAIT_L(0); PG8_BAR; PG8_MMA(0, 0, At, B0); PG8_MMA(0, 1, At, B1); PG8_BAR; PG8_SCHED;
            PG8_LDA(At, 1, 1); PG8_STAGE(PG8_SB(1, 0), b3, voffB); PG8_STAGE(PG8_SB(1, 1), b3 + hstep, voffB); PG8_STAGE(PG8_SA(1, 0), a3, s2[0]);
            PG8_WAIT_V(8); PG8_WAIT_L(0); PG8_BAR; PG8_MMA(1, 0, At, B0); PG8_MMA(1, 1, At, B1); PG8_BAR; PG8_SCHED;
        }
        if constexpr (ALIGN_EPI) { if (wr == 0) PG8_BAR; }
        E(acc, cur, wr, wc, fr, fq);
        if (!has_next) break;
#pragma unroll
        for (int a = 0; a < 2; ++a)
#pragma unroll
            for (int b = 0; b < 2; ++b)
#pragma unroll
                for (int m = 0; m < 4; ++m)
#pragma unroll
                    for (int n = 0; n < 2; ++n) acc[a][b][m][n] = (f32x4){0.f, 0.f, 0.f, 0.f};
        cur = nxt; cB = nB; ++ui;
#pragma unroll
        for (int h = 0; h < 2; ++h) { co[h][0] = no[h][0]; co[h][1] = no[h][1]; }
        if constexpr (ALIGN_EPI) { if (wr == 1) PG8_BAR; }
    }
    PG8_WAIT_V(0);
    if constexpr (!ALIGN_EPI) { if (wr == 0) PG8_BAR; }
    PG8_BAR;
#undef PG8_SA
#undef PG8_SB
#undef PG8_STAGE
#undef PG8_LDA
#undef PG8_LDB
#undef PG8_MMA
#undef PG8_WAIT_V
#undef PG8_WAIT_L
#undef PG8_BAR
#undef PG8_SCHED
#undef PG8_OFFS
}
}

__device__ __forceinline__ void transpose_item(const float* W, int ldw, int k0, int n0, bf16* WT, int K, int drow0, LAS float* scr, int lane) {
#pragma unroll 8
    for (int i = 0; i < 32; ++i) { const int kk = 2 * i + (lane >> 5); scr[kk * 33 + (lane & 31)] = W[(size_t)(k0 + kk) * ldw + n0 + (lane & 31)]; }
    asm volatile("s_waitcnt lgkmcnt(0)" ::: "memory");
    const int c = lane & 7;
#pragma unroll
    for (int j = 0; j < 4; ++j) { const int n = (lane >> 3) + 8 * j; const LAS float* s = scr + (8 * c) * 33 + n;
        u32x4 o; o.x = pk2(s[0 * 33], s[1 * 33]); o.y = pk2(s[2 * 33], s[3 * 33]); o.z = pk2(s[4 * 33], s[5 * 33]); o.w = pk2(s[6 * 33], s[7 * 33]);
        *(u32x4*)(WT + (size_t)(drow0 + n) * K + k0 + 8 * c) = o; }
    asm volatile("s_waitcnt lgkmcnt(0)" ::: "memory");
}

__device__ __forceinline__ float conv_silu(const Ctx& C, int b, int t, int ch) {
    float acc = C.conv_b[ch];
#pragma unroll
    for (int j = 0; j < 4; ++j) { const int tt = t - 3 + j; if (tt >= 0) acc += C.conv_w[j * CONVCH + ch] * bf2f(C.PROJ[(size_t)(b * SEQ + tt) * NPROJ + PX + ch]); }
    return silu_f(acc);
}

__device__ __forceinline__ void phase_prologue(Ctx& C) {
    float* W = (float*)C.lds;
    for (int idx = C.tid; idx < 16 * 1024; idx += NTHREADS) { const int k = idx >> 4, j = idx & 15; W[j * 1024 + k] = C.w_in[(size_t)k * INDIM + DT0 + j]; }
    __syncthreads();
    const int gw = C.bid * NWAVES + C.wave, NGW = C.G * NWAVES;
    for (int row = gw; row < M; row += NGW) {
        const f32x4* xr = (const f32x4*)(C.x + (size_t)row * DM) + C.lane;
        f32x4 v[4]; float ss = 0.f;
#pragma unroll
        for (int j = 0; j < 4; ++j) { v[j] = xr[64 * j]; ss += v[j][0] * v[j][0] + v[j][1] * v[j][1] + v[j][2] * v[j][2] + v[j][3] * v[j][3]; }
        const float rstd = 1.0f / sqrtf(wave_sum(ss) * (1.0f / DM) + EPS);
        u32x2* o = (u32x2*)(C.XN + (size_t)row * DM) + C.lane;
#pragma unroll
        for (int j = 0; j < 4; ++j) { const f32x4 g = ((const f32x4*)C.norm_mix)[C.lane + 64 * j]; v[j] = v[j] * rstd * g; u32x2 w; w.x = pk2(v[j][0], v[j][1]); w.y = pk2(v[j][2], v[j][3]); o[64 * j] = w; }
        float mine = 0.f;
#pragma unroll 2
        for (int jj = 0; jj < 16; ++jj) {
            float p = 0.f;
#pragma unroll
            for (int j = 0; j < 4; ++j) { const f32x4 w4 = *(const f32x4*)(W + jj * 1024 + (C.lane + 64 * j) * 4); p += v[j][0] * w4[0] + v[j][1] * w4[1] + v[j][2] * w4[2] + v[j][3] * w4[3]; }
            p = wave_sum(p);
            if (C.lane == jj) mine = p;
        }
        if (C.lane < 16) C.DT[(size_t)row * 16 + C.lane] = softplus_f(mine + C.dt_bias[C.lane]);
    }
    __syncthreads();
    LAS float* scr = (LAS float*)((LAS unsigned char*)C.lds + C.wave * 8704);
    for (int it = gw; it < 1920 + 1024; it += NGW) {
        if (it < 1920) { const int kb = it / 120, nb = it % 120, n0 = nb * 32; transpose_item(C.w_in, INDIM, kb * 64, n0 < DT0 ? n0 : n0 + 16, C.WIN, DM, n0, scr, C.lane); }
        else { const int r = it - 1920, kb = r >> 5, nb = r & 31; transpose_item(C.w_out, DM, kb * 64, nb * 32, C.WOUT, 2048, nb * 32, scr, C.lane); }
    }
}

__device__ __forceinline__ void phase_gemm1(Ctx& C) {
    pg8::DenseOrder S; S.init(M, NPROJ, DM, C.WIN, C.G, C.bid);
    pg8::EpiProj E{C.PROJ, NPROJ, C.HALO};
    pg8::gemm_phase<pg8::EpiProj, pg8::DenseOrder, true>((LAS unsigned char*)C.lds, (const char*)C.XN, DM, S, E);
}

__device__ __forceinline__ void ssd_states_unit(Ctx& C, int u) {
    const int g = u & 1, c = (u >> 1) & 31, b = u >> 6;
    float* Bs = (float*)C.lds;
    float* xs = Bs + 128 * 128;
    float* dtl = xs + 128 * 64;
    float* acs = dtl + 128;
    float* wl = acs + 128;
    const int t0 = c * CHK;
    __syncthreads();
    for (int idx = C.tid; idx < 128 * 128; idx += NTHREADS) { const int l = idx >> 7, n = idx & 127; Bs[idx] = conv_silu(C, b, t0 + l, 1024 + g * 128 + n); }
    for (int r = 0; r < 8; ++r) {
        const int h = g * 8 + r;
        __syncthreads();
        if (C.tid < 128) dtl[C.tid] = C.DT[(size_t)(b * SEQ + t0 + C.tid) * 16 + h];
        __syncthreads();
        if (C.tid == 0) { const float A = -expf(C.a_log[h]); float run = 0.f; for (int l = 0; l < 128; ++l) { run += dtl[l] * A; acs[l] = run; } }
        __syncthreads();
        if (C.tid < 128) wl[C.tid] = dtl[C.tid] * expf(acs[127] - acs[C.tid]);
        for (int idx = C.tid; idx < 128 * 64; idx += NTHREADS) { const int l = idx >> 6, p = idx & 63; xs[idx] = conv_silu(C, b, t0 + l, h * 64 + p); }
        __syncthreads();
        const int n = C.tid & 127, pg = C.tid >> 7;
        float acc[16];
#pragma unroll
        for (int i = 0; i < 16; ++i) acc[i] = 0.f;
        for (int l = 0; l < 128; ++l) {
            const float bv = Bs[l * 128 + n] * wl[l];
#pragma unroll
            for (int i = 0; i < 16; ++i) acc[i] += xs[l * 64 + pg * 16 + i] * bv;
        }
        bf16* st = C.ST + ((size_t)((b * NCH + c) * NH + h)) * (HD * NST);
#pragma unroll
        for (int i = 0; i < 16; ++i) st[(pg * 16 + i) * NST + n] = (bf16)f2bf(acc[i]);
        if (C.tid == 0) C.CDEC[(b * NCH + c) * NH + h] = expf(acs[127]);
    }
    __syncthreads();
}

__device__ __forceinline__ void attn_unit(Ctx& C, int u) {
    const int blk = u & 31, b = u >> 5;
    float* Ks = (float*)C.lds;
    float* Vs = Ks + 256 * 68;
    float* ssq = Vs + 256 * 68;
    const int t0 = blk * 128;
    __syncthreads();
    if (C.tid < 128) ssq[C.tid] = 0.f;
    for (int kv = 0; kv < 2; ++kv) {
        __syncthreads();
        for (int idx = C.tid; idx < 256 * 64; idx += NTHREADS) {
            const int key = idx >> 6, d = idx & 63, t = t0 - 128 + key;
            float kvv = 0.f, vvv = 0.f;
            if (t >= 0) { const bf16* pr = C.PROJ + (size_t)(b * SEQ + t) * NPROJ; kvv = bf2f(pr[PK + kv * 64 + d]); vvv = bf2f(pr[PV + kv * 64 + d]); }
            Ks[key * 68 + d] = kvv; Vs[key * 68 + d] = vvv;
        }
        __syncthreads();
        for (int pr2 = 0; pr2 < 2; ++pr2) {
            const int pair = pr2 * 512 + C.tid, r = pair >> 7, qi = pair & 127, hq = kv * 8 + r;
            const bf16* qp = C.PROJ + (size_t)(b * SEQ + t0 + qi) * NPROJ + PQ + hq * 64;
            unsigned qw[32]; float o[64];
#pragma unroll
            for (int d = 0; d < 32; ++d) { qw[d] = *(const unsigned*)(qp + 2 * d); }
#pragma unroll
            for (int d = 0; d < 64; ++d) o[d] = 0.f;
            float m = C.sinks[hq], l = 1.0f;
            for (int j = 1; j <= 128; ++j) {
                const int key = qi + j;
                if (t0 - 128 + key < 0) continue;
                const float* kr = Ks + key * 68; const float* vr = Vs + key * 68;
                float s = 0.f;
#pragma unroll
                for (int d = 0; d < 64; d += 4) { const f32x4 k4 = *(const f32x4*)(kr + d); s += bf2f(qw[d >> 1]) * k4[0] + bf2f(qw[d >> 1] >> 16) * k4[1] + bf2f(qw[(d >> 1) + 1]) * k4[2] + bf2f(qw[(d >> 1) + 1] >> 16) * k4[3]; }
                s *= 0.125f;
                if (s > m) { const float al = expf(m - s); l *= al;
#pragma unroll
                    for (int d = 0; d < 64; ++d) o[d] *= al;
                    m = s; }
                const float p = expf(s - m); l += p;
#pragma unroll
                for (int d = 0; d < 64; d += 4) { const f32x4 v4 = *(const f32x4*)(vr + d); o[d] += p * v4[0]; o[d + 1] += p * v4[1]; o[d + 2] += p * v4[2]; o[d + 3] += p * v4[3]; }
            }
            const float inv = 1.0f / l; float sq = 0.f;
            bf16* op = C.MIX + (size_t)(b * SEQ + t0 + qi) * 2048 + 1024 + hq * 64;
#pragma unroll
            for (int d = 0; d < 64; d += 2) { const float a0 = o[d] * inv, a1 = o[d + 1] * inv; sq += a0 * a0 + a1 * a1; *(unsigned*)(op + d) = pk2(a0, a1); }
            atomicAdd(&ssq[qi], sq);
        }
    }
    __syncthreads();
    for (int idx = C.tid; idx < 128 * 512; idx += NTHREADS) {
        const int qi = idx >> 9, c2 = (idx & 511) * 2;
        const float rs = 1.0f / sqrtf(ssq[qi] * (1.0f / 1024.f) + EPS);
        unsigned* p = (unsigned*)(C.MIX + (size_t)(b * SEQ + t0 + qi) * 2048 + 1024 + c2);
        const unsigned w = *p;
        *p = pk2(bf2f(w) * rs * C.attn_norm[c2], bf2f(w >> 16) * rs * C.attn_norm[c2 + 1]);
    }
    __syncthreads();
}

typedef short bf16x8 __attribute__((ext_vector_type(8)));
typedef short s16x4 __attribute__((ext_vector_type(4)));
typedef float f32x16 __attribute__((ext_vector_type(16)));
typedef float f32x2_t __attribute__((ext_vector_type(2)));
typedef __bf16 bf16x2_t __attribute__((ext_vector_type(2)));
#define MFMA32(a, b, c) __builtin_amdgcn_mfma_f32_32x32x16_bf16((a), (b), (c), 0, 0, 0)
__device__ __forceinline__ unsigned cvtpk(float lo, float hi) { f32x2_t v = {lo, hi}; bf16x2_t b = __builtin_convertvector(v, bf16x2_t); return __builtin_bit_cast(unsigned, b); }
__device__ __forceinline__ s16x4 tr16(LAS const unsigned char* p) { return __builtin_bit_cast(s16x4, __builtin_amdgcn_ds_read_tr16_b64_v4i16((LAS s16x4*)p)); }
__device__ __forceinline__ bf16x8 cat8(s16x4 lo, s16x4 hi) { return __builtin_shufflevector(lo, hi, 0, 1, 2, 3, 4, 5, 6, 7); }
#define PACK8(x, o) __builtin_bit_cast(bf16x8, (u32x4){cvtpk((x)[(o)], (x)[(o) + 1]), cvtpk((x)[(o) + 2], (x)[(o) + 3]), cvtpk((x)[(o) + 4], (x)[(o) + 5]), cvtpk((x)[(o) + 6], (x)[(o) + 7])})

constexpr int KRS = 144, VRS = 192;
__device__ __forceinline__ void attn_unit_fast(Ctx& C, int u) {
    const int blk = u & 31, b = u >> 5, t0 = blk * 128;
    LAS unsigned char* L = (LAS unsigned char*)C.lds;
    LAS unsigned char* Kimg = L;
    LAS unsigned char* Vimg = L + 36864;
    LAS float* ssq = (LAS float*)(L + 86016);
    LAS float* rsv = ssq + 16 * 128;
    const int lane = C.lane, r32 = lane & 31, h = lane >> 5, q4 = (lane & 15) >> 2, p4 = lane & 3, b16 = (lane >> 4) & 1;
    const float c2 = 0.125f * 1.4426950408889634f;
    for (int kv = 0; kv < 2; ++kv) {
        __syncthreads();
#pragma unroll
        for (int i = 0; i < 4; ++i) {
            const int idx = C.tid + NTHREADS * i, row = idx >> 3, ch = idx & 7, t = t0 - 128 + row;
            u32x4 kk = (u32x4){0u, 0u, 0u, 0u}, vv = (u32x4){0u, 0u, 0u, 0u};
            if (t >= 0) { const bf16* pr = C.PROJ + (size_t)(b * SEQ + t) * NPROJ; kk = *(const u32x4*)(pr + PK + kv * 64 + ch * 8); vv = *(const u32x4*)(pr + PV + kv * 64 + ch * 8); }
            *(LAS u32x4*)(Kimg + row * KRS + ch * 16) = kk; *(LAS u32x4*)(Vimg + row * VRS + ch * 16) = vv;
        }
        __syncthreads();
        const int hq = kv * 8 + C.wave;
        const float sink2 = C.sinks[hq] * 1.4426950408889634f;
        for (int rb = 0; rb < 4; ++rb) {
            const int qi = 32 * rb + r32;
            const bf16* qp = C.PROJ + (size_t)(b * SEQ + t0 + qi) * NPROJ + PQ + hq * 64 + 8 * h;
            bf16x8 qf[4];
#pragma unroll
            for (int d0 = 0; d0 < 4; ++d0) qf[d0] = *(const bf16x8*)(qp + 16 * d0);
            f32x16 o0, o1;
#pragma unroll
            for (int r = 0; r < 16; ++r) { o0[r] = 0.f; o1[r] = 0.f; }
            float m = sink2, l = (h == 0) ? 1.f : 0.f;
            const int kt0 = rb >> 1;
            for (int kt = kt0; kt < kt0 + 3; ++kt) {
                f32x16 p0, p1;
#pragma unroll
                for (int r = 0; r < 16; ++r) { p0[r] = 0.f; p1[r] = 0.f; }
                LAS const unsigned char* ka = Kimg + (kt * 64 + r32) * KRS + 16 * h;
#pragma unroll
                for (int d0 = 0; d0 < 4; ++d0) {
                    const bf16x8 a0 = *(LAS const bf16x8*)(ka + d0 * 32), a1 = *(LAS const bf16x8*)(ka + 32 * KRS + d0 * 32);
                    p0 = MFMA32(a0, qf[d0], p0); p1 = MFMA32(a1, qf[d0], p1);
                }
                const int kj0 = kt * 64 + 4 * h;
                float mt = -INFINITY;
#pragma unroll
                for (int r = 0; r < 16; ++r) {
                    const int kj = kj0 + (r & 3) + 8 * (r >> 2), kj1 = kj + 32;
                    const bool v0 = (kj > qi) && (kj <= qi + 128) && (blk > 0 || kj >= 128);
                    const bool v1 = (kj1 > qi) && (kj1 <= qi + 128) && (blk > 0 || kj1 >= 128);
                    const float x0 = v0 ? p0[r] * c2 : -INFINITY, x1 = v1 ? p1[r] * c2 : -INFINITY;
                    p0[r] = x0; p1[r] = x1; mt = fmaxf(mt, fmaxf(x0, x1));
                }
                mt = fmaxf(mt, __shfl_xor(mt, 32));
                const float mn = fmaxf(m, mt), alpha = __builtin_amdgcn_exp2f(m - mn);
                m = mn;
                float ls = 0.f;
#pragma unroll
                for (int r = 0; r < 16; ++r) { p0[r] = __builtin_amdgcn_exp2f(p0[r] - mn); p1[r] = __builtin_amdgcn_exp2f(p1[r] - mn); ls += p0[r] + p1[r]; }
                l = l * alpha + ls;
#pragma unroll
                for (int r = 0; r < 16; ++r) { o0[r] *= alpha; o1[r] *= alpha; }
                LAS const unsigned char* va = Vimg + (kt * 64 + 4 * h + q4) * VRS + 32 * b16 + 8 * p4;
#pragma unroll
                for (int s = 0; s < 4; ++s) {
                    const bf16x8 pf = (s < 2) ? PACK8(p0, (s & 1) * 8) : PACK8(p1, (s & 1) * 8);
                    const bf16x8 v0f = cat8(tr16(va + (16 * s) * VRS), tr16(va + (16 * s + 8) * VRS));
                    const bf16x8 v1f = cat8(tr16(va + (16 * s) * VRS + 64), tr16(va + (16 * s + 8) * VRS + 64));
                    o0 = MFMA32(v0f, pf, o0); o1 = MFMA32(v1f, pf, o1);
                }
            }
            const float ltot = l + __shfl_xor(l, 32), inv = 1.0f / ltot;
            float sq = 0.f;
#pragma unroll
            for (int r = 0; r < 16; ++r) { o0[r] *= inv; o1[r] *= inv; sq += o0[r] * o0[r] + o1[r] * o1[r]; }
            sq += __shfl_xor(sq, 32);
            if (h == 0) ssq[hq * 128 + qi] = sq;
            bf16* op = C.MIX + (size_t)(b * SEQ + t0 + qi) * 2048 + 1024 + hq * 64 + 4 * h;
#pragma unroll
            for (int g = 0; g < 4; ++g) {
                u32x2 w0; w0.x = cvtpk(o0[4 * g], o0[4 * g + 1]); w0.y = cvtpk(o0[4 * g + 2], o0[4 * g + 3]); *(u32x2*)(op + 8 * g) = w0;
                u32x2 w1; w1.x = cvtpk(o1[4 * g], o1[4 * g + 1]); w1.y = cvtpk(o1[4 * g + 2], o1[4 * g + 3]); *(u32x2*)(op + 32 + 8 * g) = w1;
            }
        }
    }
    __syncthreads();
    if (C.tid < 128) { float s = 0.f;
#pragma unroll
        for (int hh = 0; hh < 16; ++hh) s += ssq[hh * 128 + C.tid];
        rsv[C.tid] = 1.0f / sqrtf(s * (1.0f / 1024.f) + EPS); }
    __syncthreads();
    for (int i = 0; i < 32; ++i) {
        const int idx = C.tid + NTHREADS * i, row = idx >> 7, ch = idx & 127;
        u32x4* p = (u32x4*)(C.MIX + (size_t)(b * SEQ + t0 + row) * 2048 + 1024 + ch * 8);
        const u32x4 w = *p; const float rs = rsv[row];
        const f32x4 g0 = *(const f32x4*)(C.attn_norm + ch * 8), g1 = *(const f32x4*)(C.attn_norm + ch * 8 + 4);
        u32x4 o;
        o.x = cvtpk(bf2f(w.x) * rs * g0[0], bf2f(w.x >> 16) * rs * g0[1]); o.y = cvtpk(bf2f(w.y) * rs * g0[2], bf2f(w.y >> 16) * rs * g0[3]);
        o.z = cvtpk(bf2f(w.z) * rs * g1[0], bf2f(w.z >> 16) * rs * g1[1]); o.w = cvtpk(bf2f(w.w) * rs * g1[2], bf2f(w.w >> 16) * rs * g1[3]);
        *p = o;
    }
    __syncthreads();
}

__device__ __forceinline__ void phase_scan(Ctx& C) {
    const int total = NB * NH * HD * NST;
    for (int e = C.bid * NTHREADS + C.tid; e < total; e += C.G * NTHREADS) {
        const int pn = e & (HD * NST - 1), h = (e >> 13) & 15, b = e >> 17;
        float carry = 0.f;
        for (int c = 0; c < NCH; ++c) {
            bf16* p = C.ST + ((size_t)((b * NCH + c) * NH + h)) * (HD * NST) + pn;
            const float s = bf2f(*p), dec = C.CDEC[(b * NCH + c) * NH + h];
            *p = (bf16)f2bf(carry);
            carry = carry * dec + s;
        }
    }
}

__device__ __forceinline__ void ssd_out_unit(Ctx& C, int u) {
    const int g = u & 1, c = (u >> 1) & 31, b = u >> 6;
    bf16* Cs = (bf16*)C.lds;
    bf16* Bs = Cs + 128 * 130;
    float* xs = (float*)Bs;
    float* cb = (float*)(C.lds + 2 * 33280);
    bf16* pv = (bf16*)(C.lds + 2 * 33280 + 65536);
    float* dts = (float*)(C.lds + 2 * 33280 + 65536 + 16640);
    float* acs = dts + 128; float* ssl = acs + 128; float* rsl = ssl + 128;
    const int t0 = c * CHK;
    __syncthreads();
    for (int idx = C.tid; idx < 128 * 128; idx += NTHREADS) { const int l = idx >> 7, n = idx & 127;
        Bs[l * 130 + n] = (bf16)f2bf(conv_silu(C, b, t0 + l, 1024 + g * 128 + n));
        Cs[l * 130 + n] = (bf16)f2bf(conv_silu(C, b, t0 + l, 1280 + g * 128 + n)); }
    if (C.tid < 128) ssl[C.tid] = 0.f;
    __syncthreads();
    {
        const int s = C.tid & 127, lg = C.tid >> 7;
        float acc[32];
#pragma unroll
        for (int i = 0; i < 32; ++i) acc[i] = 0.f;
        for (int n = 0; n < 128; ++n) { const float bv = bf2f(Bs[s * 130 + n]);
#pragma unroll
            for (int i = 0; i < 32; ++i) acc[i] += bf2f(Cs[(lg * 32 + i) * 130 + n]) * bv; }
#pragma unroll
        for (int i = 0; i < 32; ++i) cb[(lg * 32 + i) * 128 + s] = acc[i];
    }
    for (int r = 0; r < 8; ++r) {
        const int h = g * 8 + r;
        __syncthreads();
        if (C.tid < 128) dts[C.tid] = C.DT[(size_t)(b * SEQ + t0 + C.tid) * 16 + h];
        __syncthreads();
        if (C.tid == 0) { const float A = -expf(C.a_log[h]); float run = 0.f; for (int l = 0; l < 128; ++l) { run += dts[l] * A; acs[l] = run; } }
        for (int idx = C.tid; idx < 128 * 64; idx += NTHREADS) { const int l = idx >> 6, p = idx & 63; xs[idx] = conv_silu(C, b, t0 + l, h * 64 + p); }
        { const bf16* st = C.ST + ((size_t)((b * NCH + c) * NH + h)) * (HD * NST);
          for (int idx = C.tid; idx < 64 * 128; idx += NTHREADS) { const int p = idx >> 7, n = idx & 127; pv[p * 130 + n] = st[idx]; } }
        __syncthreads();
        const int p = C.tid & 63, lg = C.tid >> 6;
        const float dsk = C.d_skip[h];
        for (int i = 0; i < 16; ++i) {
            const int l = lg * 16 + i;
            float acc = 0.f;
            for (int s = 0; s <= l; ++s) acc += cb[l * 128 + s] * __expf(acs[l] - acs[s]) * dts[s] * xs[s * 64 + p];
            float off = 0.f;
            for (int n = 0; n < 128; ++n) off += bf2f(Cs[l * 130 + n]) * bf2f(pv[p * 130 + n]);
            const float y = acc + __expf(acs[l]) * off + dsk * xs[l * 64 + p];
            const size_t row = (size_t)(b * SEQ + t0 + l);
            const float z = bf2f(C.PROJ[row * NPROJ + PZ + h * 64 + p]);
            const float uu = y * silu_f(z);
            C.MIX[row * 2048 + h * 64 + p] = (bf16)f2bf(uu);
            const float sq = wave_sum(uu * uu);
            if (C.lane == 0) ssl[l] += sq;
        }
    }
    __syncthreads();
    if (C.tid < 128) rsl[C.tid] = 1.0f / sqrtf(ssl[C.tid] * (1.0f / 512.f) + EPS);
    __syncthreads();
    for (int idx = C.tid; idx < 128 * 256; idx += NTHREADS) {
        const int l = idx >> 8, c2 = (idx & 255) * 2, col = g * 512 + c2;
        unsigned* p = (unsigned*)(C.MIX + (size_t)(b * SEQ + t0 + l) * 2048 + col);
        const unsigned w = *p;
        *p = pk2(bf2f(w) * rsl[l] * C.ssd_norm[col], bf2f(w >> 16) * rsl[l] * C.ssd_norm[col + 1]);
    }
    __syncthreads();
}

__device__ __forceinline__ void chunk_cumsum(const Ctx& C, int rowbase, int hd, float& d0, float& d1, float& c0, float& c1, float& total) {
    const float A = -expf(C.a_log[hd]);
    d0 = C.DT[(size_t)(rowbase + 2 * C.lane) * 16 + hd]; d1 = C.DT[(size_t)(rowbase + 2 * C.lane + 1) * 16 + hd];
    const float a0 = d0 * A, a1 = d1 * A;
    float v = a0 + a1;
#pragma unroll
    for (int o = 1; o < 64; o <<= 1) { const float t = __shfl_up(v, o); if (C.lane >= o) v += t; }
    c1 = v; c0 = v - a1; total = __shfl(v, 63);
}

constexpr int X4RS = 576, BRS = 320;
__device__ __forceinline__ void ssd_states_fast(Ctx& C, int u) {
    const int g = u & 1, c = (u >> 1) & 31, b = u >> 6, t0 = c * CHK, rowbase = b * SEQ + t0;
    LAS unsigned char* L = (LAS unsigned char*)C.lds;
    LAS unsigned char* XI = L;
    LAS unsigned char* BI = L + 73728;
    LAS float* WL = (LAS float*)(L + 114688);
    const int lane = C.lane, r32 = lane & 31, h = lane >> 5, q4 = (lane & 15) >> 2, p4 = lane & 3, b16 = (lane >> 4) & 1, w = C.wave;
    __syncthreads();
    {
        float d0, d1, c0, c1, tot; chunk_cumsum(C, rowbase, g * 8 + w, d0, d1, c0, c1, tot);
        WL[w * 128 + 2 * lane] = d0 * expf(tot - c0); WL[w * 128 + 2 * lane + 1] = d1 * expf(tot - c1);
        if (lane == 0) C.CDEC[(b * NCH + c) * NH + g * 8 + w] = expf(tot);
    }
    for (int ps = 0; ps < 2; ++ps) {
        const bool task = ps == 0 || C.tid < 256;
        const int cg = ps == 0 ? (C.tid & 63) : (C.tid & 31), run = ps == 0 ? (C.tid >> 6) : (C.tid >> 5);
        const int ch = ps == 1 ? g * 512 + 256 + cg * 8 : (cg < 32 ? g * 512 + cg * 8 : (cg < 48 ? 1024 + g * 128 + (cg - 32) * 8 : 1280 + g * 128 + (cg - 48) * 8));
        const int l0 = 16 * run;
        u32x4 raw[19];
#pragma unroll
        for (int i = 0; i < 19; ++i) raw[i] = (u32x4){0u, 0u, 0u, 0u};
        if (task) {
#pragma unroll
            for (int i = 0; i < 3; ++i) {
                if (l0 > 0) raw[i] = *(const u32x4*)(C.PROJ + (size_t)(rowbase + l0 + i - 3) * NPROJ + PX + ch);
                else if (c > 0) raw[i] = *(const u32x4*)(C.HALO + ((size_t)(b * NCH + c - 1) * 3 + i) * CONVCH + ch);
            }
#pragma unroll
            for (int i = 3; i < 19; ++i) raw[i] = *(const u32x4*)(C.PROJ + (size_t)(rowbase + l0 + i - 3) * NPROJ + PX + ch);
        }
        __syncthreads();
        if (task) {
            float cw[4][8], cbias[8];
#pragma unroll
            for (int j = 0; j < 4; ++j) { const f32x4 a = *(const f32x4*)(C.conv_w + j * CONVCH + ch), bq = *(const f32x4*)(C.conv_w + j * CONVCH + ch + 4);
                cw[j][0] = a[0]; cw[j][1] = a[1]; cw[j][2] = a[2]; cw[j][3] = a[3]; cw[j][4] = bq[0]; cw[j][5] = bq[1]; cw[j][6] = bq[2]; cw[j][7] = bq[3]; }
            { const f32x4 a = *(const f32x4*)(C.conv_b + ch), bq = *(const f32x4*)(C.conv_b + ch + 4);
              cbias[0] = a[0]; cbias[1] = a[1]; cbias[2] = a[2]; cbias[3] = a[3]; cbias[4] = bq[0]; cbias[5] = bq[1]; cbias[6] = bq[2]; cbias[7] = bq[3]; }
#pragma unroll
            for (int i = 0; i < 16; ++i) {
                float o[8];
#pragma unroll
                for (int k = 0; k < 8; ++k) o[k] = cbias[k];
#pragma unroll
                for (int j = 0; j < 4; ++j) { const u32x4 rv = raw[i + j];
                    o[0] += cw[j][0] * bf2f(rv.x); o[1] += cw[j][1] * bf2f(rv.x >> 16); o[2] += cw[j][2] * bf2f(rv.y); o[3] += cw[j][3] * bf2f(rv.y >> 16);
                    o[4] += cw[j][4] * bf2f(rv.z); o[5] += cw[j][5] * bf2f(rv.z >> 16); o[6] += cw[j][6] * bf2f(rv.w); o[7] += cw[j][7] * bf2f(rv.w >> 16); }
                u32x4 pk; pk.x = cvtpk(silu_f(o[0]), silu_f(o[1])); pk.y = cvtpk(silu_f(o[2]), silu_f(o[3])); pk.z = cvtpk(silu_f(o[4]), silu_f(o[5])); pk.w = cvtpk(silu_f(o[6]), silu_f(o[7]));
                *(u32x4*)(C.PROJ + (size_t)(rowbase + l0 + i) * NPROJ + PX + ch) = pk;
                if (ps == 1 || cg < 32) *(LAS u32x4*)(XI + (l0 + i) * X4RS + (cg & 31) * 16) = pk;
                else if (cg < 48) *(LAS u32x4*)(BI + (l0 + i) * BRS + (cg - 32) * 16) = pk;
            }
        }
        __syncthreads();
        const int hl = w & 3, hh = ps * 4 + hl, nt0 = 2 * (w >> 2);
        f32x16 acc[2][2];
#pragma unroll
        for (int i = 0; i < 2; ++i)
#pragma unroll
            for (int pt = 0; pt < 2; ++pt)
#pragma unroll
                for (int r = 0; r < 16; ++r) acc[i][pt][r] = 0.f;
#pragma unroll 2
        for (int ks = 0; ks < 8; ++ks) {
            const f32x4 w0 = *(LAS const f32x4*)(WL + hh * 128 + 16 * ks + 8 * h), w1 = *(LAS const f32x4*)(WL + hh * 128 + 16 * ks + 8 * h + 4);
            LAS const unsigned char* xa = XI + (16 * ks + 8 * h + q4) * X4RS + (hl * 64) * 2 + 32 * b16 + 8 * p4;
            LAS const unsigned char* ba = BI + (16 * ks + 8 * h + q4) * BRS + (nt0 * 32) * 2 + 32 * b16 + 8 * p4;
            bf16x8 xf[2];
#pragma unroll
            for (int pt = 0; pt < 2; ++pt) {
                const s16x4 lo = tr16(xa + pt * 64), hi = tr16(xa + 4 * X4RS + pt * 64);
                u32x4 sc;
                sc.x = cvtpk(bf2f((unsigned short)lo[0]) * w0[0], bf2f((unsigned short)lo[1]) * w0[1]); sc.y = cvtpk(bf2f((unsigned short)lo[2]) * w0[2], bf2f((unsigned short)lo[3]) * w0[3]);
                sc.z = cvtpk(bf2f((unsigned short)hi[0]) * w1[0], bf2f((unsigned short)hi[1]) * w1[1]); sc.w = cvtpk(bf2f((unsigned short)hi[2]) * w1[2], bf2f((unsigned short)hi[3]) * w1[3]);
                xf[pt] = __builtin_bit_cast(bf16x8, sc);
            }
#pragma unroll
            for (int i = 0; i < 2; ++i) {
                const bf16x8 bfr = cat8(tr16(ba + i * 64), tr16(ba + 4 * BRS + i * 64));
                acc[i][0] = MFMA32(bfr, xf[0], acc[i][0]); acc[i][1] = MFMA32(bfr, xf[1], acc[i][1]);
            }
        }
        bf16* st = C.ST + ((size_t)((b * NCH + c) * NH + g * 8 + hh)) * (HD * NST);
#pragma unroll
        for (int i = 0; i < 2; ++i)
#pragma unroll
            for (int pt = 0; pt < 2; ++pt)
#pragma unroll
                for (int gq = 0; gq < 4; ++gq) { u32x2 wv; wv.x = cvtpk(acc[i][pt][4 * gq], acc[i][pt][4 * gq + 1]); wv.y = cvtpk(acc[i][pt][4 * gq + 2], acc[i][pt][4 * gq + 3]);
                    *(u32x2*)(st + (32 * pt + r32) * NST + 32 * (nt0 + i) + 8 * gq + 4 * h) = wv; }
    }
    __syncthreads();
}

__device__ __forceinline__ void phase_scan_fast(Ctx& C) {
    const int total = NB * NH * HD * NST / 8;
    for (int e = C.bid * NTHREADS + C.tid; e < total; e += C.G * NTHREADS) {
        const int pn = e & 1023, hd = (e >> 10) & 15, b = e >> 14;
        float carry[8];
#pragma unroll
        for (int k = 0; k < 8; ++k) carry[k] = 0.f;
        u32x4* p = (u32x4*)(C.ST + ((size_t)(b * NCH * NH + hd)) * (HD * NST)) + pn;
        const float* dc = C.CDEC + b * NCH * NH + hd;
#pragma unroll 4
        for (int c = 0; c < NCH; ++c) {
            const u32x4 s = p[(size_t)c * NH * 1024]; const float dec = dc[c * NH];
            u32x4 o; o.x = cvtpk(carry[0], carry[1]); o.y = cvtpk(carry[2], carry[3]); o.z = cvtpk(carry[4], carry[5]); o.w = cvtpk(carry[6], carry[7]);
            p[(size_t)c * NH * 1024] = o;
            carry[0] = carry[0] * dec + bf2f(s.x); carry[1] = carry[1] * dec + bf2f(s.x >> 16); carry[2] = carry[2] * dec + bf2f(s.y); carry[3] = carry[3] * dec + bf2f(s.y >> 16);
            carry[4] = carry[4] * dec + bf2f(s.z); carry[5] = carry[5] * dec + bf2f(s.z >> 16); carry[6] = carry[6] * dec + bf2f(s.w); carry[7] = carry[7] * dec + bf2f(s.w >> 16);
        }
    }
}

constexpr int BCRS = 272;
__device__ __forceinline__ void ssd_out_fast(Ctx& C, int u) {
    const int g = u & 1, c = (u >> 1) & 31, b = u >> 6, t0 = c * CHK, rowbase = b * SEQ + t0;
    LAS unsigned char* L = (LAS unsigned char*)C.lds;
    LAS unsigned char* BI = L;
    LAS unsigned char* CI = L + 34816;
    LAS unsigned char* XI = L + 69632;
    LAS float* AC = (LAS float*)(L + 143360);
    LAS float* DL = AC + 1024;
    LAS float* ssl = DL + 1024;
    LAS float* rsl = ssl + 128;
    const int lane = C.lane, r32 = lane & 31, h = lane >> 5, q4 = (lane & 15) >> 2, p4 = lane & 3, b16 = (lane >> 4) & 1, w = C.wave;
    __syncthreads();
    {   float d0, d1, c0, c1, tot; chunk_cumsum(C, rowbase, g * 8 + w, d0, d1, c0, c1, tot);
        AC[w * 128 + 2 * lane] = c0 * 1.4426950408889634f; AC[w * 128 + 2 * lane + 1] = c1 * 1.4426950408889634f;
        DL[w * 128 + 2 * lane] = d0; DL[w * 128 + 2 * lane + 1] = d1; }
    if (C.tid < 128) ssl[C.tid] = 0.f;
#pragma unroll
    for (int i = 0; i < 8; ++i) { const int idx = C.tid + NTHREADS * i, row = idx >> 5, cc = idx & 31;
        const u32x4 v = *(const u32x4*)(C.PROJ + (size_t)(rowbase + row) * NPROJ + PX + 1024 + (cc >> 4) * 256 + g * 128 + (cc & 15) * 8);
        *(LAS u32x4*)((cc < 16 ? BI : CI) + row * BCRS + (cc & 15) * 16) = v; }
    for (int ps = 0; ps < 2; ++ps) {
        __syncthreads();
#pragma unroll
        for (int i = 0; i < 8; ++i) { const int idx = C.tid + NTHREADS * i, row = idx >> 5, cc = idx & 31;
            *(LAS u32x4*)(XI + row * X4RS + cc * 16) = *(const u32x4*)(C.PROJ + (size_t)(rowbase + row) * NPROJ + PX + g * 512 + ps * 256 + cc * 8); }
        __syncthreads();
        const int hl = w & 3, hh = ps * 4 + hl, hd = g * 8 + hh;
        const float dsk = C.d_skip[hd];
        const bf16* prev = C.ST + ((size_t)((b * NCH + c) * NH + hd)) * (HD * NST);
        for (int li = 0; li < 2; ++li) {
            const int lt = (w >> 2) ? (1 + li) : (3 * li);
            const int l = 32 * lt + r32;
            f32x16 acc[2];
#pragma unroll
            for (int r = 0; r < 16; ++r) { acc[0][r] = 0.f; acc[1][r] = 0.f; }
            bf16x8 cf[8];
#pragma unroll
            for (int ks = 0; ks < 8; ++ks) cf[ks] = *(LAS const bf16x8*)(CI + l * BCRS + (16 * ks + 8 * h) * 2);
#pragma unroll
            for (int pt = 0; pt < 2; ++pt)
#pragma unroll
                for (int ks = 0; ks < 8; ++ks) { const bf16x8 pf = *(const bf16x8*)(prev + (32 * pt + r32) * NST + 16 * ks + 8 * h); acc[pt] = MFMA32(pf, cf[ks], acc[pt]); }
            const float al = AC[hh * 128 + l], el = __builtin_amdgcn_exp2f(al);
#pragma unroll
            for (int r = 0; r < 16; ++r) { acc[0][r] *= el; acc[1][r] *= el; }
            for (int st = 0; st <= lt; ++st) {
                f32x16 X;
#pragma unroll
                for (int r = 0; r < 16; ++r) X[r] = 0.f;
#pragma unroll
                for (int ks = 0; ks < 8; ++ks) { const bf16x8 bfr = *(LAS const bf16x8*)(BI + (32 * st + r32) * BCRS + (16 * ks + 8 * h) * 2); X = MFMA32(bfr, cf[ks], X); }
#pragma unroll
                for (int gq = 0; gq < 4; ++gq) {
                    const int s0 = 32 * st + 8 * gq + 4 * h;
                    const f32x4 as = *(LAS const f32x4*)(AC + hh * 128 + s0), ds = *(LAS const f32x4*)(DL + hh * 128 + s0);
#pragma unroll
                    for (int i = 0; i < 4; ++i) { const float e = __builtin_amdgcn_exp2f(fminf(al - as[i], 0.f)) * ds[i]; X[4 * gq + i] = (s0 + i <= l) ? X[4 * gq + i] * e : 0.f; }
                }
                LAS const unsigned char* xa = XI + (32 * st + 4 * h + q4) * X4RS + (hl * 64) * 2 + 32 * b16 + 8 * p4;
#pragma unroll
                for (int tq = 0; tq < 2; ++tq) {
                    const bf16x8 mf = (tq == 0) ? PACK8(X, 0) : PACK8(X, 8);
#pragma unroll
                    for (int pt = 0; pt < 2; ++pt) { const bf16x8 xf = cat8(tr16(xa + (16 * tq) * X4RS + pt * 64), tr16(xa + (16 * tq + 8) * X4RS + pt * 64)); acc[pt] = MFMA32(xf, mf, acc[pt]); }
                }
            }
            float sq = 0.f;
            const size_t grow = (size_t)(rowbase + l);
#pragma unroll
            for (int pt = 0; pt < 2; ++pt)
#pragma unroll
                for (int gq = 0; gq < 4; ++gq) {
                    const int p0 = 32 * pt + 8 * gq + 4 * h;
                    const u32x2 xv = *(LAS const u32x2*)(XI + l * X4RS + (hl * 64 + p0) * 2);
                    const u32x2 zv = *(const u32x2*)(C.PROJ + grow * NPROJ + PZ + hd * 64 + p0);
                    const float y0 = (acc[pt][4 * gq] + dsk * bf2f(xv.x)) * silu_f(bf2f(zv.x)), y1 = (acc[pt][4 * gq + 1] + dsk * bf2f(xv.x >> 16)) * silu_f(bf2f(zv.x >> 16));
                    const float y2 = (acc[pt][4 * gq + 2] + dsk * bf2f(xv.y)) * silu_f(bf2f(zv.y)), y3 = (acc[pt][4 * gq + 3] + dsk * bf2f(xv.y >> 16)) * silu_f(bf2f(zv.y >> 16));
                    sq += y0 * y0 + y1 * y1 + y2 * y2 + y3 * y3;
                    u32x2 o; o.x = cvtpk(y0, y1); o.y = cvtpk(y2, y3);
                    *(u32x2*)(C.MIX + grow * 2048 + hd * 64 + p0) = o;
                }
            sq += __shfl_xor(sq, 32);
            if (h == 0) atomicAdd((float*)(ssl + l), sq);
        }
    }
    __syncthreads();
    if (C.tid < 128) rsl[C.tid] = 1.0f / sqrtf(ssl[C.tid] * (1.0f / 512.f) + EPS);
    __syncthreads();
    for (int i = 0; i < 16; ++i) {
        const int idx = C.tid + NTHREADS * i, row = idx >> 6, cc = idx & 63, col = g * 512 + cc * 8;
        u32x4* p = (u32x4*)(C.MIX + (size_t)(rowbase + row) * 2048 + col);
        const u32x4 wv = *p; const float rs = rsl[row];
        const f32x4 g0 = *(const f32x4*)(C.ssd_norm + col), g1 = *(const f32x4*)(C.ssd_norm + col + 4);
        u32x4 o;
        o.x = cvtpk(bf2f(wv.x) * rs * g0[0], bf2f(wv.x >> 16) * rs * g0[1]); o.y = cvtpk(bf2f(wv.y) * rs * g0[2], bf2f(wv.y >> 16) * rs * g0[3]);
        o.z = cvtpk(bf2f(wv.z) * rs * g1[0], bf2f(wv.z >> 16) * rs * g1[1]); o.w = cvtpk(bf2f(wv.w) * rs * g1[2], bf2f(wv.w >> 16) * rs * g1[3]);
        *p = o;
    }
    __syncthreads();
}

__device__ __forceinline__ void phase_gemm2(Ctx& C) {
    pg8::DenseOrder S; S.init(M, DM, 2048, C.WOUT, C.G, C.bid);
    pg8::EpiResid E{C.x, C.out};
    pg8::gemm_phase<pg8::EpiResid, pg8::DenseOrder, true>((LAS unsigned char*)C.lds, (const char*)C.MIX, 2048, S, E);
}

__device__ __forceinline__ void phase_router(Ctx& C) {
    float* T = (float*)C.lds + C.wave * 4096;
    const int gw = C.bid * NWAVES + C.wave, NGW = C.G * NWAVES;
    unsigned* cnt = C.ctl + CW_CNT;
    for (int r0 = gw * 4; r0 < M; r0 += NGW * 4) {
#pragma unroll
        for (int r = 0; r < 4; ++r) {
            const int row = r0 + r;
            const f32x4* hr = (const f32x4*)(C.out + (size_t)row * DM) + C.lane;
            f32x4 v[4]; float ss = 0.f;
#pragma unroll
            for (int j = 0; j < 4; ++j) { v[j] = hr[64 * j]; ss += v[j][0] * v[j][0] + v[j][1] * v[j][1] + v[j][2] * v[j][2] + v[j][3] * v[j][3]; }
            const float rstd = 1.0f / sqrtf(wave_sum(ss) * (1.0f / DM) + EPS);
            u32x2* o = (u32x2*)(C.XN + (size_t)row * DM) + C.lane;
#pragma unroll
            for (int j = 0; j < 4; ++j) { const f32x4 g = ((const f32x4*)C.norm_ffn)[C.lane + 64 * j]; v[j] = v[j] * rstd * g;
                u32x2 w; w.x = pk2(v[j][0], v[j][1]); w.y = pk2(v[j][2], v[j][3]); o[64 * j] = w;
                *(f32x4*)(T + r * 1024 + (C.lane + 64 * j) * 4) = v[j]; }
        }
        asm volatile("s_waitcnt lgkmcnt(0)" ::: "memory");
        float ae[4] = {0.f, 0.f, 0.f, 0.f}, ag[4] = {0.f, 0.f, 0.f, 0.f};
        for (int k = 0; k < DM; ++k) { const float w = C.w_re[k * 64 + C.lane];
#pragma unroll
            for (int r = 0; r < 4; ++r) ae[r] += T[r * 1024 + k] * w; }
        { const int col = C.lane & 7, ks = C.lane >> 3;
          for (int kk = 0; kk < 128; ++kk) { const int k = ks * 128 + kk; const float w = C.w_rg[k * 8 + col];
#pragma unroll
              for (int r = 0; r < 4; ++r) ag[r] += T[r * 1024 + k] * w; }
#pragma unroll
          for (int r = 0; r < 4; ++r) { ag[r] += __shfl_xor(ag[r], 8); ag[r] += __shfl_xor(ag[r], 16); ag[r] += __shfl_xor(ag[r], 32); } }
#pragma unroll
        for (int r = 0; r < 4; ++r) {
            const int row = r0 + r;
            float gl[8]; int gsel = 0; float gmax;
#pragma unroll
            for (int c2 = 0; c2 < 8; ++c2) gl[c2] = __shfl(ag[r], c2);
            gmax = gl[0];
#pragma unroll
            for (int c2 = 1; c2 < 8; ++c2) if (gl[c2] > gmax) { gmax = gl[c2]; gsel = c2; }
            float gsum = 0.f;
#pragma unroll
            for (int c2 = 0; c2 < 8; ++c2) gsum += expf(gl[c2] - gmax);
            const float pgrp = 1.0f / gsum;
            float el[8];
#pragma unroll
            for (int i = 0; i < 8; ++i) el[i] = __shfl(ae[r], gsel * 8 + i);
            int i0 = 0; float l0 = el[0];
#pragma unroll
            for (int i = 1; i < 8; ++i) if (el[i] > l0) { l0 = el[i]; i0 = i; }
            int i1 = -1; float l1 = -INFINITY;
#pragma unroll
            for (int i = 0; i < 8; ++i) if (i != i0 && el[i] > l1) { l1 = el[i]; i1 = i; }
            const float e1 = expf(l1 - l0), g0 = pgrp / (1.0f + e1), g1 = pgrp * e1 / (1.0f + e1);
            if (C.lane == 0) {
#pragma unroll
                for (int k = 0; k < 2; ++k) { const int e = gsel * 8 + (k == 0 ? i0 : i1);
                    const unsigned pos = atomicAdd(&cnt[e], 1u);
                    C.TE[row * 2 + k] = e; C.TP[row * 2 + k] = (int)pos; C.TG[row * 2 + k] = (k == 0 ? g0 : g1);
                    C.LIST[(size_t)e * LISTCAP + pos] = row * 2 + k; }
            }
        }
    }
    __syncthreads();
    LAS float* scr = (LAS float*)((LAS unsigned char*)C.lds + C.wave * 8704);
    for (int it = gw; it < NE * 768; it += NGW) {
        const int e = it / 768; int r = it % 768;
        if (r < 512) { const bool up = r >= 256; r &= 255; const int kb = r >> 4, nb = r & 15, n0 = nb * 32;
            transpose_item((up ? C.w_up : C.w_gate) + (size_t)e * DM * FF, FF, kb * 64, n0, C.WGU + (size_t)e * 1024 * 1024, DM, (n0 >> 7) * 256 + (n0 & 127) + (up ? 128 : 0), scr, C.lane); }
        else { r -= 512; const int kb = r >> 5, nb = r & 31; transpose_item(C.w_down + (size_t)e * FF * DM, DM, kb * 64, nb * 32, C.WD + (size_t)e * 1024 * FF, FF, nb * 32, scr, C.lane); }
    }
}

struct MoeTab { int* cnt; int* pstart; int* tstart; };
__device__ __forceinline__ MoeTab moe_tables(Ctx& C, int off) {
    MoeTab T; T.cnt = (int*)(C.lds + off); T.pstart = T.cnt + 64; T.tstart = T.pstart + 65;
    __syncthreads();
    if (C.tid < 64) T.cnt[C.tid] = (int)__hip_atomic_load(C.ctl + CW_CNT + C.tid, __ATOMIC_RELAXED, __HIP_MEMORY_SCOPE_AGENT);
    __syncthreads();
    if (C.tid == 0) { int ps = 0, ts = 0; for (int e = 0; e < 64; ++e) { T.pstart[e] = ps; T.tstart[e] = ts; ps += ((T.cnt[e] + 255) >> 8) << 8; ts += (T.cnt[e] + 255) >> 8; } T.pstart[64] = ps; T.tstart[64] = ts; }
    __syncthreads();
    return T;
}

constexpr int MOE_TAB_OFF = 132096;
__device__ __forceinline__ void phase_moe_a(Ctx& C) {
    const MoeTab T = moe_tables(C, MOE_TAB_OFF);
    pg8::MoeOrder<true> S{T.cnt, T.pstart, T.tstart, C.LIST, (const char*)C.WGU, (size_t)1024 * 1024 * 2, DM, 4, T.tstart[64], C.G, C.vcu};
    pg8::EpiHid E{C.HID};
    pg8::gemm_phase<pg8::EpiHid, pg8::MoeOrder<true>, true>((LAS unsigned char*)C.lds, (const char*)C.XN, DM, S, E);
}
__device__ __forceinline__ void phase_moe_b(Ctx& C) {
    const MoeTab T = moe_tables(C, MOE_TAB_OFF);
    pg8::MoeOrder<false> S{T.cnt, T.pstart, T.tstart, C.LIST, (const char*)C.WD, (size_t)1024 * FF * 2, FF, 4, T.tstart[64], C.G, C.vcu};
    pg8::EpiYb E{C.YB, C.LIST, C.TG};
    pg8::gemm_phase<pg8::EpiYb, pg8::MoeOrder<false>, true>((LAS unsigned char*)C.lds, (const char*)C.HID, FF, S, E);
}
__device__ __forceinline__ void phase_final(Ctx& C) {
    const MoeTab T = moe_tables(C, 0);
    const int gw = C.bid * NWAVES + C.wave, NGW = C.G * NWAVES;
    for (int row = gw; row < M; row += NGW) {
        const size_t s0 = (size_t)T.pstart[C.TE[row * 2]] + C.TP[row * 2], s1 = (size_t)T.pstart[C.TE[row * 2 + 1]] + C.TP[row * 2 + 1];
        f32x4* hr = (f32x4*)(C.out + (size_t)row * DM) + C.lane;
        const u32x2* y0 = (const u32x2*)(C.YB + s0 * DM) + C.lane; const u32x2* y1 = (const u32x2*)(C.YB + s1 * DM) + C.lane;
        f32x4 v[4]; float ss = 0.f;
#pragma unroll
        for (int j = 0; j < 4; ++j) { v[j] = hr[64 * j]; const u32x2 a = y0[64 * j], c = y1[64 * j];
            v[j][0] += bf2f(a.x) + bf2f(c.x); v[j][1] += bf2f(a.x >> 16) + bf2f(c.x >> 16); v[j][2] += bf2f(a.y) + bf2f(c.y); v[j][3] += bf2f(a.y >> 16) + bf2f(c.y >> 16);
            ss += v[j][0] * v[j][0] + v[j][1] * v[j][1] + v[j][2] * v[j][2] + v[j][3] * v[j][3]; }
        const float rstd = 1.0f / sqrtf(wave_sum(ss) * (1.0f / DM) + EPS);
#pragma unroll
        for (int j = 0; j < 4; ++j) { const f32x4 g = ((const f32x4*)C.norm_final)[C.lane + 64 * j]; hr[64 * j] = v[j] * rstd * g; }
    }
}

constexpr int NPHASE = 10;
__global__ void __launch_bounds__(NTHREADS, 2) fwd_kernel(Args args) {
    extern __shared__ __attribute__((aligned(16))) unsigned char lds[];
    Ctx C;
    C.lds = lds; C.tid = threadIdx.x; C.lane = C.tid & 63; C.wave = __builtin_amdgcn_readfirstlane(C.tid >> 6); C.G = gridDim.x; C.bid = blockIdx.x;
    C.x = args.in[0]; C.norm_mix = args.in[1]; C.w_in = args.in[2]; C.conv_w = args.in[3]; C.conv_b = args.in[4]; C.dt_bias = args.in[5]; C.a_log = args.in[6]; C.d_skip = args.in[7];
    C.ssd_norm = args.in[8]; C.sinks = args.in[9]; C.attn_norm = args.in[10]; C.w_out = args.in[11]; C.norm_ffn = args.in[12]; C.w_rg = args.in[13]; C.w_re = args.in[14];
    C.w_gate = args.in[15]; C.w_up = args.in[16]; C.w_down = args.in[17]; C.norm_final = args.in[18];
    C.out = args.out; C.ws = args.ws;
    unsigned char* ws = args.ws;
    C.ctl = (unsigned*)(ws + WS_CTL);
    C.XN = (bf16*)(ws + WS_XN); C.DT = (float*)(ws + WS_DT); C.PROJ = (bf16*)(ws + WS_PROJ); C.HID = (bf16*)(ws + WS_HID); C.YB = (bf16*)(ws + WS_YB);
    C.ST = (bf16*)(ws + WS_ST); C.MIX = (bf16*)(ws + WS_MIX); C.CDEC = (float*)(ws + WS_CDEC); C.TE = (int*)(ws + WS_TE); C.TP = (int*)(ws + WS_TP); C.TG = (float*)(ws + WS_TG);
    C.LIST = (int*)(ws + WS_LIST); C.WIN = (bf16*)(ws + WS_WIN); C.WOUT = (bf16*)(ws + WS_WOUT); C.WGU = (bf16*)(ws + WS_WGU); C.WD = (bf16*)(ws + WS_WD); C.HALO = (bf16*)(ws + WS_HALO);
    C.vcu = (C.G % 8 == 0) ? (C.bid % 8) * (C.G / 8) + C.bid / 8 : C.bid;
    volatile LAS unsigned* MISC = (volatile LAS unsigned*)((LAS unsigned char*)lds + MISC_OFF);
    if (C.tid < 64) MISC[C.tid] = 0u;
    __syncthreads();
    XcdBarrier bar; bar.bar = C.ctl + CW_BAR; bar.x = 0; bar.st = nullptr;
#if ONE_LAUNCH
    bar = xcd_barrier_post(C.ctl + CW_BAR, MISC + 8);
#define GRID_BAR() xcd_barrier(bar)
#else
#define GRID_BAR() do {} while (0)
#endif
    const int lo = args.ph_lo, hi = args.ph_hi;
#define IN(k) (lo <= (k) && (k) < hi)
#define SEAM(k) do { if (IN(k) && IN((k) + 1)) GRID_BAR(); } while (0)
    if (IN(0)) { phase_prologue(C); } SEAM(0);
    if (IN(1)) { phase_gemm1(C); } SEAM(1);
    if (IN(2)) { for (int u = C.bid; u < NB * NCH * 2; u += C.G) ssd_states_fast(C, u); for (int u = C.bid; u < NB * 32; u += C.G) attn_unit_fast(C, u); } SEAM(2);
    if (IN(3)) { phase_scan_fast(C); } SEAM(3);
    if (IN(4)) { for (int u = C.bid; u < NB * NCH * 2; u += C.G) ssd_out_fast(C, u); } SEAM(4);
    if (IN(5)) { phase_gemm2(C); } SEAM(5);
    if (IN(6)) { phase_router(C); } SEAM(6);
    if (IN(7)) { phase_moe_a(C); } SEAM(7);
    if (IN(8)) { phase_moe_b(C); } SEAM(8);
    if (IN(9)) { phase_final(C); }
}

extern "C" void kernel_launch(void* const* d_in, const int* in_sizes, int n_in, void* d_out, int out_size, void* d_ws, size_t ws_size, hipStream_t stream) {
    static int grid = 0;
    if (grid == 0) {
        if (n_in != 19 || in_sizes[0] != M * DM || out_size != M * DM || ws_size < WS_END) { fprintf(stderr, "kernel_launch: unexpected shapes (n_in %d, in0 %d, out %d, ws %zu)\n", n_in, n_in > 0 ? in_sizes[0] : -1, out_size, ws_size); grid = -1; return; }
        int dev = 0, cus = 0, per_cu = 0;
        if (hipGetDevice(&dev) != hipSuccess || hipDeviceGetAttribute(&cus, hipDeviceAttributeMultiprocessorCount, dev) != hipSuccess) { grid = -1; return; }
        if (hipFuncSetAttribute((const void*)fwd_kernel, hipFuncAttributeMaxDynamicSharedMemorySize, LDS_BYTES) != hipSuccess) { fprintf(stderr, "kernel_launch: hipFuncSetAttribute failed\n"); grid = -1; return; }
        if (hipOccupancyMaxActiveBlocksPerMultiprocessor(&per_cu, (const void*)fwd_kernel, NTHREADS, LDS_BYTES) != hipSuccess || per_cu < 1) { fprintf(stderr, "kernel_launch: occupancy query says %d\n", per_cu); (void)hipGetLastError(); per_cu = 1; }
        grid = cus;
    }
    if (grid < 0) return;
    (void)hipMemsetAsync((char*)d_ws + WS_CTL, 0, CTL_BYTES, stream);
    Args a{};
    for (int i = 0; i < 19; ++i) a.in[i] = (const float*)d_in[i];
    a.out = (float*)d_out; a.ws = (unsigned char*)d_ws;
#if ONE_LAUNCH
    a.ph_lo = 0; a.ph_hi = NPHASE;
    hipLaunchKernelGGL(fwd_kernel, dim3(grid), dim3(NTHREADS), LDS_BYTES, stream, a);
#else
    for (int p = 0; p < NPHASE; ++p) { a.ph_lo = p; a.ph_hi = p + 1; hipLaunchKernelGGL(fwd_kernel, dim3(grid), dim3(NTHREADS), LDS_BYTES, stream, a); }
#endif
}
```

```cpp
#include <hip/hip_runtime.h>
#include <cstdio>
#include <cstdint>

#ifndef RPH
#define RPH -1
#endif
#ifndef ONE_LAUNCH
#define ONE_LAUNCH 1
#endif

#define LAS __attribute__((address_space(3)))
typedef unsigned short bf16;
typedef float f32x4 __attribute__((ext_vector_type(4)));
typedef unsigned u32x4 __attribute__((ext_vector_type(4)));
typedef unsigned u32x2 __attribute__((ext_vector_type(2)));

constexpr int NB = 8, SEQ = 4096, DM = 1024, M = NB * SEQ;
constexpr int INDIM = 3856;
constexpr int NPROJ = 3840;
constexpr int PZ = 0, PX = 1024, PQ = 2560, PK = 3584, PV = 3712;
constexpr int DT0 = 2560;
constexpr int CONVCH = 1536;
constexpr int NH = 16, HD = 64, NST = 128, CHK = 128, NCH = SEQ / CHK;
constexpr int NE = 64, FF = 512, LISTCAP = 32768;
constexpr int SLOT_MAX = 81920;
constexpr float EPS = 1e-6f;
constexpr int NCONV = 16, E1 = 14, E7 = 32;

constexpr size_t MiB = 1u << 20;
constexpr size_t WS_CTL = 0, CTL_BYTES = 1 * MiB;
constexpr size_t WS_XN = 1 * MiB;
constexpr size_t WS_DT = 65 * MiB;
constexpr size_t WS_PROJ = 67 * MiB;
constexpr size_t WS_HID = WS_PROJ;
constexpr size_t WS_YB = WS_PROJ + 80 * MiB;
constexpr size_t WS_ST = 307 * MiB;
constexpr size_t WS_MIX = 371 * MiB;
constexpr size_t WS_WGU = 307 * MiB;
constexpr size_t WS_WD = 435 * MiB;
constexpr size_t WS_WIN = 499 * MiB;
constexpr size_t WS_WOUT = 507 * MiB;
constexpr size_t WS_MISC = 511 * MiB;
constexpr size_t WS_CDEC = WS_MISC;
constexpr size_t WS_TE = WS_MISC + 1 * MiB;
constexpr size_t WS_TP = WS_TE + 256 * 1024;
constexpr size_t WS_TG = WS_TP + 256 * 1024;
constexpr size_t WS_LIST = WS_MISC + 2 * MiB;
constexpr size_t WS_HALO = WS_LIST + 8 * MiB;
constexpr size_t WS_WRH = WS_HALO + 3 * MiB;
constexpr size_t WS_WRL = WS_WRH + 256 * 1024;
constexpr size_t WS_RS = WS_WRL + 256 * 1024;
constexpr size_t WS_END = WS_RS + 512 * 1024;
constexpr int CW_BAR = 4096;
constexpr int CW_CNT = 8192;
constexpr int CW_TIME = 8448;

constexpr int NTHREADS = 512, NWAVES = 8;
constexpr int LDS_BYTES = 159744;
constexpr int MISC_OFF = LDS_BYTES - 256;

__device__ __forceinline__ unsigned f2bf(float f) { unsigned u = __builtin_bit_cast(unsigned, f); return (u + 0x7fffu + ((u >> 16) & 1u)) >> 16; }
__device__ __forceinline__ float bf2f(unsigned b) { return __builtin_bit_cast(float, (b & 0xffffu) << 16); }
__device__ __forceinline__ unsigned pk2(float lo, float hi) { return f2bf(lo) | (f2bf(hi) << 16); }
__device__ __forceinline__ float wave_sum(float v) {
#pragma unroll
    for (int o = 1; o < 64; o <<= 1) v += __shfl_xor(v, o);
    return v;
}
__device__ __forceinline__ float silu_f(float x) { return x * __builtin_amdgcn_rcpf(1.0f + __expf(-x)); }
__device__ __forceinline__ float softplus_f(float x) { return x > 20.f ? x : log1pf(expf(x)); }

typedef short bf16x8 __attribute__((ext_vector_type(8)));
typedef short s16x4 __attribute__((ext_vector_type(4)));
typedef float f32x16 __attribute__((ext_vector_type(16)));
typedef float f32x2_t __attribute__((ext_vector_type(2)));
typedef __bf16 bf16x2_t __attribute__((ext_vector_type(2)));
#define MFMA32(a, b, c) __builtin_amdgcn_mfma_f32_32x32x16_bf16((a), (b), (c), 0, 0, 0)
__device__ __forceinline__ unsigned cvtpk(float lo, float hi) { f32x2_t v = {lo, hi}; bf16x2_t b = __builtin_convertvector(v, bf16x2_t); return __builtin_bit_cast(unsigned, b); }
__device__ __forceinline__ s16x4 tr16(LAS const unsigned char* p) { return __builtin_bit_cast(s16x4, __builtin_amdgcn_ds_read_tr16_b64_v4i16((LAS s16x4*)p)); }
__device__ __forceinline__ bf16x8 cat8(s16x4 lo, s16x4 hi) { return __builtin_shufflevector(lo, hi, 0, 1, 2, 3, 4, 5, 6, 7); }
#define PACK8(x, o) __builtin_bit_cast(bf16x8, (u32x4){cvtpk((x)[(o)], (x)[(o) + 1]), cvtpk((x)[(o) + 2], (x)[(o) + 3]), cvtpk((x)[(o) + 4], (x)[(o) + 5]), cvtpk((x)[(o) + 6], (x)[(o) + 7])})

#define XB_TMO      128
#define XB_XCNT(j)  (256  + 64 * (j))
#define XB_XSUB(j)  (1280 + 64 * (j))
#define XB_XGEN(j)  (2304 + 64 * (j))
#define XB_TOP      3328
#define XB_TOPGEN   3392
#define XCD_BAR_WORDS 3456
#define XB_SPIN_CAP (1u << 27)
__device__ __forceinline__ unsigned xb_ld(unsigned* p)              { return __hip_atomic_load(p, __ATOMIC_RELAXED, __HIP_MEMORY_SCOPE_AGENT); }
__device__ __forceinline__ unsigned xb_add(unsigned* p, unsigned v) { return __hip_atomic_fetch_add(p, v, __ATOMIC_RELAXED, __HIP_MEMORY_SCOPE_AGENT); }
__device__ __forceinline__ unsigned xb_xcc_id() { return (unsigned)__builtin_amdgcn_s_getreg((3 << 11) | 20) & 0xFu; }
#define XB_SPIN(cond, bar) do { unsigned _sp = 0; while (cond) { __builtin_amdgcn_s_sleep(1); \
    if ((++_sp & 255u) == 0u) { if (xb_ld(&(bar)[XB_TMO])) break; if (_sp > XB_SPIN_CAP) { atomicAdd(&(bar)[XB_TMO], 1u); break; } } } } while (0)
struct XcdBarrier { unsigned* bar; unsigned x; volatile LAS unsigned* st; };
__device__ __forceinline__ XcdBarrier xcd_barrier_post(unsigned* bar, volatile LAS unsigned* st) {
    XcdBarrier b; b.bar = bar; b.x = xb_xcc_id(); b.st = st;
    if (threadIdx.x == 0) (void)xb_add(&bar[XB_XCNT(b.x)], 1u);
    return b;
}
__device__ __forceinline__ void xcd_barrier_complete(unsigned* bar, unsigned x, unsigned& nloc, unsigned& nx) {
    const unsigned G = gridDim.x * gridDim.y * gridDim.z;
    unsigned sum, cnt, mine, sp = 0u;
    for (;;) {
        sum = 0u; cnt = 0u; mine = 0u;
#pragma unroll
        for (unsigned j = 0; j < 16; ++j) { const unsigned c = xb_ld(&bar[XB_XCNT(j)]); sum += c; cnt += (c > 0u) ? 1u : 0u; mine = (j == x) ? c : mine; }
        if (sum == G) break;
        __builtin_amdgcn_s_sleep(1);
        if ((++sp & 255u) == 0u) { if (xb_ld(&bar[XB_TMO])) break; if (sp > XB_SPIN_CAP) { atomicAdd(&bar[XB_TMO], 1u); break; } }
    }
    nloc = mine > 0u ? mine : 1u; nx = cnt > 0u ? cnt : 1u;
}
__device__ __forceinline__ void xcd_barrier(const XcdBarrier& b) {
    asm volatile("s_waitcnt vmcnt(0)" ::: "memory");
    __syncthreads();
    if (threadIdx.x == 0) {
        unsigned* bar = b.bar;
        __builtin_amdgcn_s_waitcnt(0);
        unsigned nloc = b.st[0], nx = b.st[1];
        if (nloc == 0u) { xcd_barrier_complete(bar, b.x, nloc, nx); b.st[0] = nloc; b.st[1] = nx; }
        const unsigned old = xb_add(&bar[XB_XSUB(b.x)], 1u);
        const unsigned gen = old / nloc;
        if (old + 1u == (gen + 1u) * nloc) {
            __builtin_amdgcn_fence(__ATOMIC_RELEASE, "agent");
            asm volatile("s_waitcnt vmcnt(0)" ::: "memory");
            const unsigned og = xb_add(&bar[XB_TOP], 1u);
            const unsigned tg = og / nx;
            if (og + 1u == (tg + 1u) * nx) xb_add(&bar[XB_TOPGEN], 1u);
            else XB_SPIN(xb_ld(&bar[XB_TOPGEN]) == tg, bar);
            __builtin_amdgcn_fence(__ATOMIC_ACQUIRE, "agent");
            xb_add(&bar[XB_XGEN(b.x)], 1u);
            asm volatile("s_waitcnt vmcnt(0)" ::: "memory");
        } else {
            XB_SPIN(xb_ld(&bar[XB_XGEN(b.x)]) == gen, bar);
            __builtin_amdgcn_fence(__ATOMIC_ACQUIRE, "agent");
            asm volatile("s_waitcnt vmcnt(0)" ::: "memory");
        }
    }
    __syncthreads();
}

struct Args { const float* in[19]; float* out; unsigned char* ws; int ph_lo, ph_hi; };
#ifdef TPH
#define TSTART(k) do { if ((k) == TPH) C.tph0 = __builtin_amdgcn_s_memrealtime(); } while (0)
#define TSTOP(k) do { if ((k) == TPH) C.tphd += __builtin_amdgcn_s_memrealtime() - C.tph0; } while (0)
#else
#define TSTART(k) do {} while (0)
#define TSTOP(k) do {} while (0)
#endif
struct Ctx {
    unsigned long long tph0, tphd;
    unsigned char* lds; int tid, lane, wave, G, bid;
    const float *x, *norm_mix, *w_in, *conv_w, *conv_b, *dt_bias, *a_log, *d_skip, *ssd_norm, *sinks, *attn_norm, *w_out, *norm_ffn, *w_rg, *w_re, *w_gate, *w_up, *w_down, *norm_final;
    float* out; unsigned char* ws;
    bf16 *XN, *PROJ, *HID, *YB, *ST, *MIX, *WIN, *WOUT, *WGU, *WD, *HALO, *WRH, *WRL; float *RS, *RATT, *RSG, *LRS, *LG; int vcu; float *DT, *CDEC, *TG; int *TE, *TP, *LIST; unsigned* ctl;
};

namespace pg8 {
typedef short bf16x8 __attribute__((ext_vector_type(8)));
constexpr int BM = 256, BK = 64, HALF = 128, HTB = HALF * BK * 2, STAGE_BYTES = 8 * HTB, NXCD = 8, WGM = 8;
__device__ __forceinline__ int lds_byte(int r, int c) { const int st = (r >> 4) * 2 + (c >> 5), rr = r & 15, cc = c & 31, ob = rr * 64 + cc * 2; return st * 1024 + (ob ^ (((ob >> 9) & 1) << 5)); }
__device__ __forceinline__ void stage_rc(int b, int& R, int& C) { const int st = b / 1024, sb = b % 1024, swz = sb ^ (((sb >> 9) & 1) << 5); R = (st >> 1) * 16 + swz / 64; C = (st & 1) * 32 + (swz % 64) / 2; }
__device__ __forceinline__ int perm32(int rho) { const int n = rho >> 4, i = rho & 15; return 8 * (i >> 2) + 4 * n + (i & 3); }
__device__ __forceinline__ unsigned cvt_pk_bf16(float lo, float hi) { unsigned r; asm volatile("v_cvt_pk_bf16_f32 %0, %1, %2" : "=v"(r) : "v"(lo), "v"(hi)); return r; }

struct Unit { int pm, pn, e, mt, rowbase, cnt, par; const char* bt; };

struct DenseOrder {
    int nM, nN, nwg, G, c, K; const char* Bt;
    __device__ void init(int M, int N, int K_, const bf16* Bt_, int G_, int c_) { nM = M / BM; nN = N / BM; nwg = nM * nN; G = G_; c = c_; K = K_; Bt = (const char*)Bt_; }
    __device__ __forceinline__ bool next(int i, Unit& u) const {
        const long L = (long)i * G + c; if (L >= nwg) return false;
        int wgid = (int)L; { const int q = nwg / NXCD, r = nwg % NXCD, xcd = wgid % NXCD, off = wgid / NXCD; wgid = (xcd < r ? xcd * (q + 1) : r * (q + 1) + (xcd - r) * q) + off; }
        const int nig = WGM * nN, gid = wgid / nig, fm = gid * WGM, gsz = (nM - fm) < WGM ? (nM - fm) : WGM;
        u.pm = fm + ((wgid % nig) % gsz); u.pn = (wgid % nig) / gsz; u.e = 0; u.mt = 0; u.rowbase = u.pm * BM; u.cnt = BM;
        u.bt = Bt + (size_t)u.pn * BM * K * 2; return true;
    }
    __device__ __forceinline__ unsigned arow(const Unit& u, int R) const { return (unsigned)(u.rowbase + R); }
};
template <bool GATHER> struct MoeOrder {
    const int *cnt, *pstart, *tstart; const int* LIST; const char* W; size_t wstride; int K, npn, ntiles, G, c;
    __device__ __forceinline__ bool next(int i, Unit& u) const {
        const long L = (long)i * G + c; if (L >= (long)ntiles * npn) return false;
        const int tile = (int)(L / npn); u.pn = (int)(L % npn); u.pm = tile;
        int e = 0; while (tstart[e + 1] <= tile) ++e;
        u.e = e; u.mt = tile - tstart[e]; u.rowbase = pstart[e] + u.mt * BM; u.cnt = cnt[e];
        u.bt = W + (size_t)e * wstride + (size_t)u.pn * BM * K * 2; return true;
    }
    __device__ __forceinline__ unsigned arow(const Unit& u, int R) const {
        if (GATHER) { const int pos = u.mt * BM + R; return pos < u.cnt ? (unsigned)(LIST[(size_t)u.e * LISTCAP + pos] >> 1) : 0u; }
        return (unsigned)(u.rowbase + R);
    }
};

struct EpiProj {
    static constexpr bool PERM = true, KSEG = false, UBEGIN = false; bf16* O; int ldc; bf16* HALO;
    __device__ __forceinline__ void operator()(const f32x4 (&acc)[2][2][4][2], const Unit& u, int wr, int wc, int fr, int fq) const {
        bf16* base = O + (size_t)(u.pm * BM + wr * 64 + fr) * ldc + u.pn * BM + wc * 32 + 8 * fq;
#pragma unroll
        for (int ai = 0; ai < 2; ++ai)
#pragma unroll
            for (int m = 0; m < 4; ++m) { bf16* rowp = base + (size_t)(ai * HALF + m * 16) * ldc;
#pragma unroll
                for (int bj = 0; bj < 2; ++bj) { const f32x4 v0 = acc[ai][bj][m][0], v1 = acc[ai][bj][m][1];
                    u32x4 w; w.x = cvt_pk_bf16(v0[0], v0[1]); w.y = cvt_pk_bf16(v0[2], v0[3]); w.z = cvt_pk_bf16(v1[0], v1[1]); w.w = cvt_pk_bf16(v1[2], v1[3]);
                    *(u32x4*)(rowp + bj * HALF) = w;
                    if (m == 3 && wr == 1 && fr >= 13 && u.pn >= 4 && u.pn < 10) {
                        const int row = u.pm * BM + ai * HALF + 125 + (fr - 13), col = u.pn * BM + bj * HALF + wc * 32 + 8 * fq - 1024;
                        *(u32x4*)(HALO + ((size_t)(row >> 7) * 3 + (fr - 13)) * CONVCH + col) = w; } } }
    }
};
struct EpiResid {
    static constexpr bool PERM = true, KSEG = true, UBEGIN = true; const float* base; float* out; bf16* HB; const float* RSG; const float* RATT; LAS float* tab;
    __device__ __forceinline__ f32x4 unit_fetch(const Unit& u) const {
        const int tid = threadIdx.x; f32x4 r = (f32x4){1.f, 1.f, 1.f, 0.f};
        if (tid < 256) { const size_t row = (size_t)(u.pm * BM + tid); r[0] = RSG[row * 2]; r[1] = RSG[row * 2 + 1]; r[2] = RATT[row]; }
        return r;
    }
    __device__ __forceinline__ void unit_commit(const Unit& u, const f32x4 r) const {
        const int tid = threadIdx.x;
        if (tid < 256) { LAS float* tb = tab + u.par * 768; tb[tid] = r[0] * __builtin_amdgcn_rcpf(r[1]); tb[256 + tid] = r[1] * __builtin_amdgcn_rcpf(r[2]); tb[512 + tid] = r[2]; }
    }
    __device__ __forceinline__ void kseg(f32x4 (&acc)[2][2][4][2], const Unit& u, int t, int wr, int fr) const {
        const LAS float* tb = tab + u.par * 768 + (t == 8 ? 0 : 256) + wr * 64 + fr;
#pragma unroll
        for (int ai = 0; ai < 2; ++ai)
#pragma unroll
            for (int m = 0; m < 4; ++m) { const float rt = tb[ai * HALF + m * 16];
#pragma unroll
                for (int bj = 0; bj < 2; ++bj)
#pragma unroll
                    for (int n = 0; n < 2; ++n) acc[ai][bj][m][n] *= rt; }
    }
    __device__ __forceinline__ void operator()(const f32x4 (&acc)[2][2][4][2], const Unit& u, int wr, int wc, int fr, int fq) const {
        const size_t o0 = (size_t)(u.pm * BM + wr * 64 + fr) * DM + u.pn * BM + wc * 32 + 8 * fq;
#pragma unroll
        for (int ai = 0; ai < 2; ++ai) {
            f32x4 bv[4][2][2];
#pragma unroll
            for (int m = 0; m < 4; ++m)
#pragma unroll
                for (int bj = 0; bj < 2; ++bj)
#pragma unroll
                    for (int n = 0; n < 2; ++n) bv[m][bj][n] = *(const f32x4*)(base + o0 + (size_t)(ai * HALF + m * 16) * DM + bj * HALF + n * 4);
            __builtin_amdgcn_sched_barrier(0);
#pragma unroll
            for (int m = 0; m < 4; ++m)
#pragma unroll
                for (int bj = 0; bj < 2; ++bj) { const size_t off = o0 + (size_t)(ai * HALF + m * 16) * DM + bj * HALF;
                    const float sl = tab[u.par * 768 + 512 + ai * HALF + wr * 64 + m * 16 + fr];
                    const f32x4 v0 = bv[m][bj][0] + acc[ai][bj][m][0] * sl, v1 = bv[m][bj][1] + acc[ai][bj][m][1] * sl;
                    u32x4 w; w.x = cvt_pk_bf16(v0[0], v0[1]); w.y = cvt_pk_bf16(v0[2], v0[3]); w.z = cvt_pk_bf16(v1[0], v1[1]); w.w = cvt_pk_bf16(v1[2], v1[3]);
                    *(u32x4*)(HB + off) = w; }
            __builtin_amdgcn_sched_barrier(0);
        }
    }
};
struct EpiHid {
    static constexpr bool PERM = true, KSEG = false, UBEGIN = true; bf16* HID; const int* LIST; const float* RS; LAS float* tab;
    __device__ __forceinline__ f32x4 unit_fetch(const Unit& u) const {
        const int tid = threadIdx.x; f32x4 r = (f32x4){0.f, 0.f, 0.f, 0.f};
        if (tid < 256) { const int pos = u.mt * BM + tid; if (pos < u.cnt) r[0] = RS[(size_t)u.e * LISTCAP + pos]; }
        return r;
    }
    __device__ __forceinline__ void unit_commit(const Unit& u, const f32x4 r) const { const int tid = threadIdx.x; if (tid < 256) tab[u.par * 256 + tid] = r[0]; }
    __device__ __forceinline__ void operator()(const f32x4 (&acc)[2][2][4][2], const Unit& u, int wr, int wc, int fr, int fq) const {
        bf16* base = HID + (size_t)(u.rowbase + wr * 64 + fr) * FF + u.pn * 128 + wc * 32 + 8 * fq;
#pragma unroll
        for (int ai = 0; ai < 2; ++ai)
#pragma unroll
            for (int m = 0; m < 4; ++m) { f32x4 h0, h1; const int pos = u.mt * BM + ai * HALF + wr * 64 + m * 16 + fr;
                const float rs = tab[u.par * 256 + ai * HALF + wr * 64 + m * 16 + fr]; (void)pos;
#pragma unroll
                for (int i = 0; i < 4; ++i) { h0[i] = silu_f(rs * acc[ai][0][m][0][i]) * (rs * acc[ai][1][m][0][i]); h1[i] = silu_f(rs * acc[ai][0][m][1][i]) * (rs * acc[ai][1][m][1][i]); }
                u32x4 w; w.x = cvt_pk_bf16(h0[0], h0[1]); w.y = cvt_pk_bf16(h0[2], h0[3]); w.z = cvt_pk_bf16(h1[0], h1[1]); w.w = cvt_pk_bf16(h1[2], h1[3]);
                *(u32x4*)(base + (size_t)(ai * HALF + m * 16) * FF) = w; }
    }
};
struct EpiYb {
    static constexpr bool PERM = true, KSEG = false, UBEGIN = true; bf16* YB; const int* LIST; const float* TG; LAS float* tab;
    __device__ __forceinline__ f32x4 unit_fetch(const Unit& u) const {
        const int tid = threadIdx.x; f32x4 r = (f32x4){0.f, 0.f, 0.f, 0.f};
        if (tid < 256) { const int pos = u.mt * BM + tid; if (pos < u.cnt) r[0] = TG[(size_t)u.e * LISTCAP + pos]; }
        return r;
    }
    __device__ __forceinline__ void unit_commit(const Unit& u, const f32x4 r) const { const int tid = threadIdx.x; if (tid < 256) tab[u.par * 256 + tid] = r[0]; }
    __device__ __forceinline__ void operator()(const f32x4 (&acc)[2][2][4][2], const Unit& u, int wr, int wc, int fr, int fq) const {
        bf16* base = YB + (size_t)(u.rowbase + wr * 64 + fr) * DM + u.pn * BM + wc * 32 + 8 * fq;
#pragma unroll
        for (int ai = 0; ai < 2; ++ai)
#pragma unroll
            for (int m = 0; m < 4; ++m) { const int pos = u.mt * BM + ai * HALF + wr * 64 + m * 16 + fr;
                const float gt = tab[u.par * 256 + ai * HALF + wr * 64 + m * 16 + fr]; (void)pos;
#pragma unroll
                for (int bj = 0; bj < 2; ++bj) { const f32x4 v0 = acc[ai][bj][m][0] * gt, v1 = acc[ai][bj][m][1] * gt;
                    u32x4 w; w.x = cvt_pk_bf16(v0[0], v0[1]); w.y = cvt_pk_bf16(v0[2], v0[3]); w.z = cvt_pk_bf16(v1[0], v1[1]); w.w = cvt_pk_bf16(v1[2], v1[3]);
                    *(u32x4*)(base + (size_t)(ai * HALF + m * 16) * DM + bj * HALF) = w; } }
    }
};

template <class Epi, class Sched, bool ALIGN_EPI>
__device__ __forceinline__ void gemm_phase(LAS unsigned char* lds, const char* Abase, const int K, const Sched& S, const Epi& E) {
    const int tid = threadIdx.x, wid = __builtin_amdgcn_readfirstlane(tid >> 6), lane = tid & 63, wr = wid >> 2, wc = wid & 3, fr = lane & 15, fq = lane >> 4;
    const int nt = K / BK;
    int Rp[2], Cp[2]; unsigned voffB[2];
#pragma unroll
    for (int i = 0; i < 2; ++i) { int R, C; stage_rc(tid * 16 + i * 8192, R, C); Rp[i] = R; Cp[i] = C; const int Rb = Epi::PERM ? ((R & ~31) + perm32(R & 31)) : R; voffB[i] = (unsigned)(Rb * K + C) * 2u; }
    const size_t kstep = (size_t)(BK * 2);
    const size_t hstep = (size_t)HALF * K * 2;
    const unsigned ldsw = (unsigned)wid * 1024u;
    const int aoff = lds_byte(wr * 64 + fr, fq * 8), boff = lds_byte(wc * 32 + fr, fq * 8);
#define PG8_SA(b, h) (((b) * 2 + (h)) * HTB)
#define PG8_SB(b, h) ((4 + (b) * 2 + (h)) * HTB)
#define PG8_STAGE(bufoff, gbase, voff) do { _Pragma("unroll") for (int _i = 0; _i < 2; ++_i) \
        __builtin_amdgcn_global_load_lds((const unsigned*)((const char*)(gbase) + (voff)[_i]), (LAS unsigned*)(lds + (bufoff) + ldsw + _i * 8192), 16, 0, 0); } while (0)
#define PG8_LDA(dst, b, h) do { _Pragma("unroll") for (int m = 0; m < 4; ++m) _Pragma("unroll") for (int k = 0; k < 2; ++k) dst[m][k] = *(const LAS bf16x8*)(lds + PG8_SA(b, h) + aoff + m * 2048 + k * 1024); } while (0)
#define PG8_LDB(dst, b, h) do { _Pragma("unroll") for (int n = 0; n < 2; ++n) _Pragma("unroll") for (int k = 0; k < 2; ++k) dst[n][k] = *(const LAS bf16x8*)(lds + PG8_SB(b, h) + boff + n * 2048 + k * 1024); } while (0)
#define PG8_MMA(ai, bj, At, Bt) do { __builtin_amdgcn_s_setprio(1); _Pragma("unroll") for (int m = 0; m < 4; ++m) _Pragma("unroll") for (int n = 0; n < 2; ++n) _Pragma("unroll") for (int k = 0; k < 2; ++k) \
        acc[ai][bj][m][n] = __builtin_amdgcn_mfma_f32_16x16x32_bf16(Bt[n][k], At[m][k], acc[ai][bj][m][n], 0, 0, 0); __builtin_amdgcn_s_setprio(0); } while (0)
#define PG8_WAIT_V(n) asm volatile("s_waitcnt vmcnt(" #n ")" ::: "memory")
#define PG8_WAIT_L(n) asm volatile("s_waitcnt lgkmcnt(" #n ")" ::: "memory")
#define PG8_BAR __builtin_amdgcn_s_barrier()
#define PG8_SCHED __builtin_amdgcn_sched_barrier(0)
#define PG8_OFFS(dst, un) do { _Pragma("unroll") for (int _h = 0; _h < 2; ++_h) _Pragma("unroll") for (int _i = 0; _i < 2; ++_i) \
        dst[_h][_i] = (S.arow(un, _h * HALF + Rp[_i]) * (unsigned)K + (unsigned)Cp[_i]) * 2u; } while (0)
    Unit cur, nxt; int ui = 0;
    if (!S.next(0, cur)) return;
    f32x4 acc[2][2][4][2];
#pragma unroll
    for (int a = 0; a < 2; ++a)
#pragma unroll
        for (int b = 0; b < 2; ++b)
#pragma unroll
            for (int m = 0; m < 4; ++m)
#pragma unroll
                for (int n = 0; n < 2; ++n) acc[a][b][m][n] = (f32x4){0.f, 0.f, 0.f, 0.f};
    bf16x8 At[4][2], B0[2][2], B1[2][2];
    unsigned co[2][2], no[2][2];
    cur.par = 0;
    if constexpr (Epi::UBEGIN) E.unit_commit(cur, E.unit_fetch(cur));
    PG8_OFFS(co, cur);
    const char* cB = cur.bt;
    PG8_STAGE(PG8_SB(0, 0), cB, voffB); PG8_STAGE(PG8_SB(0, 1), cB + hstep, voffB); PG8_STAGE(PG8_SA(0, 0), Abase, co[0]); PG8_STAGE(PG8_SA(0, 1), Abase, co[1]);
    if (wr == 1) PG8_BAR;
    PG8_WAIT_V(2); PG8_BAR;
    PG8_STAGE(PG8_SB(1, 0), cB + kstep, voffB); PG8_STAGE(PG8_SA(1, 0), Abase + kstep, co[0]); PG8_STAGE(PG8_SB(1, 1), cB + hstep + kstep, voffB);
    PG8_WAIT_V(6); PG8_BAR;
    for (;;) {
        const bool has_next = S.next(ui + 1, nxt);
        nxt.par = (ui + 1) % 3;
        f32x4 pend = (f32x4){0.f, 0.f, 0.f, 0.f};
        if constexpr (Epi::UBEGIN) { if (has_next) pend = E.unit_fetch(nxt); }
        if (has_next) { PG8_OFFS(no, nxt); } else {
#pragma unroll
            for (int h = 0; h < 2; ++h) { no[h][0] = co[h][0]; no[h][1] = co[h][1]; } }
        const char* nB = has_next ? nxt.bt : cB;
        for (int t = 0; t < nt; t += 2) {
            const bool last = (t == nt - 2);
            const char* a1 = Abase + (size_t)(t + 1) * kstep;
            const char* a2 = last ? Abase : Abase + (size_t)(t + 2) * kstep; const char* b2 = last ? nB : cB + (size_t)(t + 2) * kstep;
            const char* a3 = a2 + kstep; const char* b3 = b2 + kstep;
            unsigned s2[2][2];
#pragma unroll
            for (int h = 0; h < 2; ++h) { s2[h][0] = last ? no[h][0] : co[h][0]; s2[h][1] = last ? no[h][1] : co[h][1]; }
            if constexpr (Epi::KSEG) { if (t == 8 || t == 16) E.kseg(acc, cur, t, wr, fr); }
            PG8_LDB(B0, 0, 0); PG8_LDB(B1, 0, 1); PG8_SCHED; PG8_LDA(At, 0, 0); PG8_STAGE(PG8_SA(1, 1), a1, co[1]);
            PG8_WAIT_V(8); PG8_WAIT_L(0); PG8_BAR; PG8_MMA(0, 0, At, B0); PG8_MMA(0, 1, At, B1); PG8_BAR; PG8_SCHED;
            PG8_LDA(At, 0, 1); PG8_STAGE(PG8_SB(0, 0), b2, voffB); PG8_STAGE(PG8_SB(0, 1), b2 + hstep, voffB); PG8_STAGE(PG8_SA(0, 0), a2, s2[0]);
            PG8_WAIT_V(8); PG8_WAIT_L(0); PG8_BAR; PG8_MMA(1, 0, At, B0); PG8_MMA(1, 1, At, B1); PG8_BAR; PG8_SCHED;
            PG8_LDB(B0, 1, 0); PG8_LDB(B1, 1, 1); PG8_SCHED; PG8_LDA(At, 1, 0); PG8_STAGE(PG8_SA(0, 1), a2, s2[1]);
            PG8_WAIT_V(8); PG8_WAIT_L(0); PG8_BAR; PG8_MMA(0, 0, At, B0); PG8_MMA(0, 1, At, B1); PG8_BAR; PG8_SCHED;
            PG8_LDA(At, 1, 1); PG8_STAGE(PG8_SB(1, 0), b3, voffB); PG8_STAGE(PG8_SB(1, 1), b3 + hstep, voffB); PG8_STAGE(PG8_SA(1, 0), a3, s2[0]);
            PG8_WAIT_V(8); PG8_WAIT_L(0); PG8_BAR; PG8_MMA(1, 0, At, B0); PG8_MMA(1, 1, At, B1); PG8_BAR; PG8_SCHED;
        }
        if constexpr (ALIGN_EPI) { if (wr == 0) PG8_BAR; }
        E(acc, cur, wr, wc, fr, fq);
        if (!has_next) break;
        if constexpr (Epi::UBEGIN) E.unit_commit(nxt, pend);
#pragma unroll
        for (int a = 0; a < 2; ++a)
#pragma unroll
            for (int b = 0; b < 2; ++b)
#pragma unroll
                for (int m = 0; m < 4; ++m)
#pragma unroll
                    for (int n = 0; n < 2; ++n) acc[a][b][m][n] = (f32x4){0.f, 0.f, 0.f, 0.f};
        cur = nxt; cB = nB; ++ui;
#pragma unroll
        for (int h = 0; h < 2; ++h) { co[h][0] = no[h][0]; co[h][1] = no[h][1]; }
        if constexpr (ALIGN_EPI) { if (wr == 1) PG8_BAR; }
    }
    PG8_WAIT_V(0);
    if constexpr (!ALIGN_EPI) { if (wr == 0) PG8_BAR; }
    PG8_BAR;
#undef PG8_SA
#undef PG8_SB
#undef PG8_STAGE
#undef PG8_LDA
#undef PG8_LDB
#undef PG8_MMA
#undef PG8_WAIT_V
#undef PG8_WAIT_L
#undef PG8_BAR
#undef PG8_SCHED
#undef PG8_OFFS
}
}

__device__ __forceinline__ void transpose_load(const float* W, int ldw, int k0, int n0, int lane, const float* kscale, float (&tv)[32], f32x4 (&ks)[2]) {
#pragma unroll
    for (int i = 0; i < 32; ++i) { const int kk = 2 * i + (lane >> 5); tv[i] = W[(size_t)(k0 + kk) * ldw + n0 + (lane & 31)]; }
    ks[0] = (f32x4){1.f, 1.f, 1.f, 1.f}; ks[1] = ks[0];
    if (kscale) { ks[0] = *(const f32x4*)(kscale + k0 + 8 * (lane & 7)); ks[1] = *(const f32x4*)(kscale + k0 + 8 * (lane & 7) + 4); }
}
__device__ __forceinline__ void transpose_store(const float (&tv)[32], const f32x4 (&ks)[2], bf16* WT, int K, int drow0, int k0, LAS float* scr, int lane) {
#pragma unroll
    for (int i = 0; i < 32; ++i) { const int kk = 2 * i + (lane >> 5); scr[kk * 33 + (lane & 31)] = tv[i]; }
    asm volatile("s_waitcnt lgkmcnt(0)" ::: "memory");
    const int c = lane & 7;
#pragma unroll
    for (int j = 0; j < 4; ++j) { const int n = (lane >> 3) + 8 * j; const LAS float* s = scr + (8 * c) * 33 + n;
        u32x4 o; o.x = pk2(s[0 * 33] * ks[0][0], s[1 * 33] * ks[0][1]); o.y = pk2(s[2 * 33] * ks[0][2], s[3 * 33] * ks[0][3]); o.z = pk2(s[4 * 33] * ks[1][0], s[5 * 33] * ks[1][1]); o.w = pk2(s[6 * 33] * ks[1][2], s[7 * 33] * ks[1][3]);
        *(u32x4*)(WT + (size_t)(drow0 + n) * K + k0 + 8 * c) = o; }
    asm volatile("s_waitcnt lgkmcnt(0)" ::: "memory");
}
__device__ __forceinline__ void transpose_item(const float* W, int ldw, int k0, int n0, bf16* WT, int K, int drow0, LAS float* scr, int lane, const float* kscale = nullptr) {
    float tv[32]; f32x4 ks[2];
    transpose_load(W, ldw, k0, n0, lane, kscale, tv, ks);
    transpose_store(tv, ks, WT, K, drow0, k0, scr, lane);
}

__device__ __forceinline__ float conv_silu(const Ctx& C, int b, int t, int ch) {
    float acc = C.conv_b[ch];
#pragma unroll
    for (int j = 0; j < 4; ++j) { const int tt = t - 3 + j; if (tt >= 0) acc += C.conv_w[j * CONVCH + ch] * bf2f(C.PROJ[(size_t)(b * SEQ + tt) * NPROJ + PX + ch]); }
    return silu_f(acc);
}

__device__ __forceinline__ void phase_prologue(Ctx& C) {
    constexpr int WRS = 2064;
    TSTART(1000);
    LAS unsigned char* WH = (LAS unsigned char*)C.lds;
    LAS unsigned char* WLo = WH + 33024;
    LAS float* PD = (LAS float*)(WH + 66048);
    {   float wv[32];
#pragma unroll
        for (int i = 0; i < 32; ++i) { const int idx = C.tid + NTHREADS * i, kk = idx >> 4, j = idx & 15; wv[i] = C.w_in[(size_t)kk * INDIM + DT0 + j]; }
#pragma unroll
        for (int i = 0; i < 32; ++i) { const int idx = C.tid + NTHREADS * i, kk = idx >> 4, j = idx & 15; const float v = wv[i];
            const unsigned hi = f2bf(v); *(LAS bf16*)(WH + j * WRS + kk * 2) = (bf16)hi; *(LAS bf16*)(WLo + j * WRS + kk * 2) = (bf16)f2bf(v - bf2f(hi)); } }
    __syncthreads();
    TSTOP(1000); TSTART(1001);
    const int gw = C.bid * NWAVES + C.wave, NGW = C.G * NWAVES;
    const int lane = C.lane, r32 = lane & 31, h = lane >> 5, w = C.wave, tt = w & 3, kh = w >> 2;
    for (int rb = C.bid; rb < M / 128; rb += C.G) {
        const int row0 = rb * 128 + w;
        f32x4 gn[4], ring[4][4];
#pragma unroll
        for (int j = 0; j < 4; ++j) gn[j] = ((const f32x4*)C.norm_mix)[lane + 64 * j];
#pragma unroll
        for (int s = 0; s < 4; ++s)
#pragma unroll
            for (int j = 0; j < 4; ++j) ring[s][j] = ((const f32x4*)(C.x + (size_t)(row0 + 8 * s) * DM) + lane)[64 * j];
#pragma unroll
        for (int i = 0; i < 16; ++i) {
            const int row = row0 + 8 * i;
            f32x4 v[4];
#pragma unroll
            for (int j = 0; j < 4; ++j) v[j] = ring[i & 3][j];
            if (i + 4 < 16) {
#pragma unroll
                for (int j = 0; j < 4; ++j) ring[i & 3][j] = ((const f32x4*)(C.x + (size_t)(row + 32) * DM) + lane)[64 * j];
            }
            float ss = 0.f;
#pragma unroll
            for (int j = 0; j < 4; ++j) ss += v[j][0] * v[j][0] + v[j][1] * v[j][1] + v[j][2] * v[j][2] + v[j][3] * v[j][3];
            const float rstd = 1.0f / sqrtf(wave_sum(ss) * (1.0f / DM) + EPS);
            u32x2* o = (u32x2*)(C.XN + (size_t)row * DM) + lane;
#pragma unroll
            for (int j = 0; j < 4; ++j) { const f32x4 g = gn[j]; v[j] = v[j] * rstd * g; u32x2 wv; wv.x = cvtpk(v[j][0], v[j][1]); wv.y = cvtpk(v[j][2], v[j][3]); o[64 * j] = wv; }
            __builtin_amdgcn_sched_barrier(0);
        }
        __syncthreads();
        TSTOP(1001); TSTART(1002);
        f32x16 acc;
#pragma unroll
        for (int r = 0; r < 16; ++r) acc[r] = 0.f;
        const bf16* xp = C.XN + (size_t)(rb * 128 + 32 * tt + r32) * DM + 512 * kh + 8 * h;
        LAS const unsigned char* wa = WH + (lane & 15) * WRS + (512 * kh + 8 * h) * 2;
#pragma unroll 1
        for (int kb = 0; kb < 4; ++kb) {
            bf16x8 xf[8];
#pragma unroll
            for (int i = 0; i < 8; ++i) xf[i] = *(const bf16x8*)(xp + (kb * 8 + i) * 16);
            __builtin_amdgcn_sched_barrier(0);
#pragma unroll
            for (int i = 0; i < 8; ++i) { const bf16x8 ah = *(LAS const bf16x8*)(wa + (kb * 8 + i) * 32), al = *(LAS const bf16x8*)(wa + 33024 + (kb * 8 + i) * 32);
                acc = MFMA32(ah, xf[i], acc); acc = MFMA32(al, xf[i], acc); }
            __builtin_amdgcn_sched_barrier(0);
        }
        if (kh == 1) {
#pragma unroll
            for (int r = 0; r < 8; ++r) PD[(tt * 8 + r) * 64 + lane] = acc[r];
        }
        __syncthreads();
        if (kh == 0) {
#pragma unroll
            for (int r = 0; r < 8; ++r) { const int col = (r & 3) + 8 * (r >> 2) + 4 * h;
                const float dv = acc[r] + PD[(tt * 8 + r) * 64 + lane] + C.dt_bias[col];
                C.DT[(size_t)(rb * 128 + 32 * tt + r32) * 16 + col] = softplus_f(dv); }
        }
        __syncthreads();
    }
    TSTOP(1002); TSTART(1003);
    __syncthreads();
    for (int idx = C.bid * NTHREADS + C.tid; idx < 96 * 1024; idx += C.G * NTHREADS) {
        const int e = idx >> 10, kk = idx & 1023;
        float v = 0.f; if (e < 64) v = C.w_re[kk * 64 + e]; else if (e < 72) v = C.w_rg[kk * 8 + (e - 64)];
        v *= C.norm_ffn[kk];
        const unsigned hi = f2bf(v); C.WRH[idx] = (bf16)hi; C.WRL[idx] = (bf16)f2bf(v - bf2f(hi));
    }
    LAS float* scr = (LAS float*)((LAS unsigned char*)C.lds + C.wave * 8704);
    for (int it = gw; it < 1920 + 1024; it += NGW) {
        if (it < 1920) { const int kb = it / 120, nb = it % 120, n0 = nb * 32; transpose_item(C.w_in, INDIM, kb * 64, n0 < DT0 ? n0 : n0 + 16, C.WIN, DM, n0, scr, C.lane); }
        else { const int r = it - 1920, kb = r >> 5, nb = r & 31; transpose_item(C.w_out, DM, kb * 64, nb * 32, C.WOUT, 2048, nb * 32, scr, C.lane, kb < 16 ? C.ssd_norm : C.attn_norm - 1024); }
    }
    TSTOP(1003);
}

__device__ __forceinline__ void phase_gemm1(Ctx& C) {
    pg8::DenseOrder S; S.init(M, NPROJ, DM, C.WIN, C.G - NCONV, C.bid - NCONV);
    pg8::EpiProj E{C.PROJ, NPROJ, C.HALO};
    pg8::gemm_phase<pg8::EpiProj, pg8::DenseOrder, true>((LAS unsigned char*)C.lds, (const char*)C.XN, DM, S, E);
}

__device__ __forceinline__ void ssd_states_unit(Ctx& C, int u) {
    const int g = u & 1, c = (u >> 1) & 31, b = u >> 6;
    float* Bs = (float*)C.lds;
    float* xs = Bs + 128 * 128;
    float* dtl = xs + 128 * 64;
    float* acs = dtl + 128;
    float* wl = acs + 128;
    const int t0 = c * CHK;
    __syncthreads();
    for (int idx = C.tid; idx < 128 * 128; idx += NTHREADS) { const int l = idx >> 7, n = idx & 127; Bs[idx] = conv_silu(C, b, t0 + l, 1024 + g * 128 + n); }
    for (int r = 0; r < 8; ++r) {
        const int h = g * 8 + r;
        __syncthreads();
        if (C.tid < 128) dtl[C.tid] = C.DT[(size_t)(b * SEQ + t0 + C.tid) * 16 + h];
        __syncthreads();
        if (C.tid == 0) { const float A = -expf(C.a_log[h]); float run = 0.f; for (int l = 0; l < 128; ++l) { run += dtl[l] * A; acs[l] = run; } }
        __syncthreads();
        if (C.tid < 128) wl[C.tid] = dtl[C.tid] * expf(acs[127] - acs[C.tid]);
        for (int idx = C.tid; idx < 128 * 64; idx += NTHREADS) { const int l = idx >> 6, p = idx & 63; xs[idx] = conv_silu(C, b, t0 + l, h * 64 + p); }
        __syncthreads();
        const int n = C.tid & 127, pg = C.tid >> 7;
        float acc[16];
#pragma unroll
        for (int i = 0; i < 16; ++i) acc[i] = 0.f;
        for (int l = 0; l < 128; ++l) {
            const float bv = Bs[l * 128 + n] * wl[l];
#pragma unroll
            for (int i = 0; i < 16; ++i) acc[i] += xs[l * 64 + pg * 16 + i] * bv;
        }
        bf16* st = C.ST + ((size_t)((b * NCH + c) * NH + h)) * (HD * NST);
#pragma unroll
        for (int i = 0; i < 16; ++i) st[(pg * 16 + i) * NST + n] = (bf16)f2bf(acc[i]);
        if (C.tid == 0) C.CDEC[(b * NCH + c) * NH + h] = expf(acs[127]);
    }
    __syncthreads();
}

__device__ __forceinline__ void attn_unit(Ctx& C, int u) {
    const int blk = u & 31, b = u >> 5;
    float* Ks = (float*)C.lds;
    float* Vs = Ks + 256 * 68;
    float* ssq = Vs + 256 * 68;
    const int t0 = blk * 128;
    __syncthreads();
    if (C.tid < 128) ssq[C.tid] = 0.f;
    for (int kv = 0; kv < 2; ++kv) {
        __syncthreads();
        for (int idx = C.tid; idx < 256 * 64; idx += NTHREADS) {
            const int key = idx >> 6, d = idx & 63, t = t0 - 128 + key;
            float kvv = 0.f, vvv = 0.f;
            if (t >= 0) { const bf16* pr = C.PROJ + (size_t)(b * SEQ + t) * NPROJ; kvv = bf2f(pr[PK + kv * 64 + d]); vvv = bf2f(pr[PV + kv * 64 + d]); }
            Ks[key * 68 + d] = kvv; Vs[key * 68 + d] = vvv;
        }
        __syncthreads();
        for (int pr2 = 0; pr2 < 2; ++pr2) {
            const int pair = pr2 * 512 + C.tid, r = pair >> 7, qi = pair & 127, hq = kv * 8 + r;
            const bf16* qp = C.PROJ + (size_t)(b * SEQ + t0 + qi) * NPROJ + PQ + hq * 64;
            unsigned qw[32]; float o[64];
#pragma unroll
            for (int d = 0; d < 32; ++d) { qw[d] = *(const unsigned*)(qp + 2 * d); }
#pragma unroll
            for (int d = 0; d < 64; ++d) o[d] = 0.f;
            float m = C.sinks[hq], l = 1.0f;
            for (int j = 1; j <= 128; ++j) {
                const int key = qi + j;
                if (t0 - 128 + key < 0) continue;
                const float* kr = Ks + key * 68; const float* vr = Vs + key * 68;
                float s = 0.f;
#pragma unroll
                for (int d = 0; d < 64; d += 4) { const f32x4 k4 = *(const f32x4*)(kr + d); s += bf2f(qw[d >> 1]) * k4[0] + bf2f(qw[d >> 1] >> 16) * k4[1] + bf2f(qw[(d >> 1) + 1]) * k4[2] + bf2f(qw[(d >> 1) + 1] >> 16) * k4[3]; }
                s *= 0.125f;
                if (s > m) { const float al = expf(m - s); l *= al;
#pragma unroll
                    for (int d = 0; d < 64; ++d) o[d] *= al;
                    m = s; }
                const float p = expf(s - m); l += p;
#pragma unroll
                for (int d = 0; d < 64; d += 4) { const f32x4 v4 = *(const f32x4*)(vr + d); o[d] += p * v4[0]; o[d + 1] += p * v4[1]; o[d + 2] += p * v4[2]; o[d + 3] += p * v4[3]; }
            }
            const float inv = 1.0f / l; float sq = 0.f;
            bf16* op = C.MIX + (size_t)(b * SEQ + t0 + qi) * 2048 + 1024 + hq * 64;
#pragma unroll
            for (int d = 0; d < 64; d += 2) { const float a0 = o[d] * inv, a1 = o[d + 1] * inv; sq += a0 * a0 + a1 * a1; *(unsigned*)(op + d) = pk2(a0, a1); }
            atomicAdd(&ssq[qi], sq);
        }
    }
    __syncthreads();
    for (int idx = C.tid; idx < 128 * 512; idx += NTHREADS) {
        const int qi = idx >> 9, c2 = (idx & 511) * 2;
        const float rs = 1.0f / sqrtf(ssq[qi] * (1.0f / 1024.f) + EPS);
        unsigned* p = (unsigned*)(C.MIX + (size_t)(b * SEQ + t0 + qi) * 2048 + 1024 + c2);
        const unsigned w = *p;
        *p = pk2(bf2f(w) * rs * C.attn_norm[c2], bf2f(w >> 16) * rs * C.attn_norm[c2 + 1]);
    }
    __syncthreads();
}

constexpr int KRS = 144, VRS = 192;
__device__ __forceinline__ void attn_unit_fast(Ctx& C, int u) {
    const int blk = u & 31, b = u >> 5, t0 = blk * 128;
    LAS unsigned char* L = (LAS unsigned char*)C.lds;
    LAS unsigned char* Kimg = L;
    LAS unsigned char* Vimg = L + 36864;
    LAS float* ssq = (LAS float*)(L + 86016);
    LAS float* rsv = ssq + 16 * 128;
    const int lane = C.lane, r32 = lane & 31, h = lane >> 5, q4 = (lane & 15) >> 2, p4 = lane & 3, b16 = (lane >> 4) & 1;
    const float c2 = 0.125f * 1.4426950408889634f;
    for (int kv = 0; kv < 2; ++kv) {
        TSTART(210);
        __syncthreads();
#pragma unroll
        for (int i = 0; i < 4; ++i) {
            const int idx = C.tid + NTHREADS * i, row = idx >> 3, ch = idx & 7, t = t0 - 128 + row;
            u32x4 kk = (u32x4){0u, 0u, 0u, 0u}, vv = (u32x4){0u, 0u, 0u, 0u};
            if (t >= 0) { const bf16* pr = C.PROJ + (size_t)(b * SEQ + t) * NPROJ; kk = *(const u32x4*)(pr + PK + kv * 64 + ch * 8); vv = *(const u32x4*)(pr + PV + kv * 64 + ch * 8); }
            *(LAS u32x4*)(Kimg + row * KRS + ch * 16) = kk; *(LAS u32x4*)(Vimg + row * VRS + ch * 16) = vv;
        }
        __syncthreads();
        TSTOP(210);
        const int hq = kv * 8 + C.wave;
        const float sink2 = C.sinks[hq] * 1.4426950408889634f;
        const bf16* qbase = C.PROJ + (size_t)(b * SEQ + t0 + r32) * NPROJ + PQ + hq * 64 + 8 * h;
        bf16x8 qf[4], qn[4];
#pragma unroll
        for (int d0 = 0; d0 < 4; ++d0) { qf[d0] = *(const bf16x8*)(qbase + 16 * d0); qn[d0] = qf[d0]; }
        for (int rb = 0; rb < 4; ++rb) {
            const int qi = 32 * rb + r32;
            if (rb < 3) {
#pragma unroll
                for (int d0 = 0; d0 < 4; ++d0) qn[d0] = *(const bf16x8*)(qbase + (size_t)(32 * (rb + 1)) * NPROJ + 16 * d0);
            }
            f32x16 o0, o1;
#pragma unroll
            for (int r = 0; r < 16; ++r) { o0[r] = 0.f; o1[r] = 0.f; }
            float m = sink2, l = (h == 0) ? 1.f : 0.f;
            const int kt0 = rb >> 1;
            auto do_tile = [&](const int kt, const int mode) {
                f32x16 p0, p1;
#pragma unroll
                for (int r = 0; r < 16; ++r) { p0[r] = 0.f; p1[r] = 0.f; }
                LAS const unsigned char* ka = Kimg + (kt * 64 + r32) * KRS + 16 * h;
#pragma unroll
                for (int d0 = 0; d0 < 4; ++d0) {
                    const bf16x8 a0 = *(LAS const bf16x8*)(ka + d0 * 32), a1 = *(LAS const bf16x8*)(ka + 32 * KRS + d0 * 32);
                    p0 = MFMA32(a0, qf[d0], p0); p1 = MFMA32(a1, qf[d0], p1);
                }
                const int dq = qi - (kt * 64 + 4 * h);
                float mt = -INFINITY;
#pragma unroll
                for (int r = 0; r < 16; ++r) {
                    const int cr = (r & 3) + 8 * (r >> 2);
                    if (mode == 1) { if (!(cr > dq)) p0[r] = -INFINITY; if (!(cr + 32 > dq)) p1[r] = -INFINITY; }
                    if (mode == 2) { if (!(cr <= dq + 128)) p0[r] = -INFINITY; if (!(cr + 32 <= dq + 128)) p1[r] = -INFINITY; }
                    mt = fmaxf(mt, fmaxf(p0[r], p1[r]));
                }
                mt = fmaxf(mt, __shfl_xor(mt, 32)) * c2;
                const float mn = fmaxf(m, mt), alpha = __builtin_amdgcn_exp2f(m - mn);
                m = mn;
                float ls = 0.f;
#pragma unroll
                for (int r = 0; r < 16; ++r) { p0[r] = __builtin_amdgcn_exp2f(__builtin_fmaf(p0[r], c2, -mn)); p1[r] = __builtin_amdgcn_exp2f(__builtin_fmaf(p1[r], c2, -mn)); ls += p0[r] + p1[r]; }
                l = l * alpha + ls;
#pragma unroll
                for (int r = 0; r < 16; ++r) { o0[r] *= alpha; o1[r] *= alpha; }
                LAS const unsigned char* va = Vimg + (kt * 64 + 4 * h + q4) * VRS + 32 * b16 + 8 * p4;
#pragma unroll
                for (int s = 0; s < 4; ++s) {
                    const bf16x8 pf = (s < 2) ? PACK8(p0, (s & 1) * 8) : PACK8(p1, (s & 1) * 8);
                    const bf16x8 v0f = cat8(tr16(va + (16 * s) * VRS), tr16(va + (16 * s + 8) * VRS));
                    const bf16x8 v1f = cat8(tr16(va + (16 * s) * VRS + 64), tr16(va + (16 * s + 8) * VRS + 64));
                    o0 = MFMA32(v0f, pf, o0); o1 = MFMA32(v1f, pf, o1);
                }
            };
            TSTART(211);
            if (blk > 0 || kt0 >= 2) do_tile(kt0, 1);
            if (blk > 0 || kt0 + 1 >= 2) do_tile(kt0 + 1, 0);
            do_tile(kt0 + 2, 2);
            TSTOP(211); TSTART(212);
            const float ltot = l + __shfl_xor(l, 32), inv = 1.0f / ltot;
            float sq = 0.f;
#pragma unroll
            for (int r = 0; r < 16; ++r) { o0[r] *= inv; o1[r] *= inv; sq += o0[r] * o0[r] + o1[r] * o1[r]; }
            sq += __shfl_xor(sq, 32);
            if (h == 0) ssq[hq * 128 + qi] = sq;
            bf16* op = C.MIX + (size_t)(b * SEQ + t0 + qi) * 2048 + 1024 + hq * 64 + 4 * h;
#pragma unroll
            for (int g = 0; g < 4; ++g) {
                u32x2 w0; w0.x = cvtpk(o0[4 * g], o0[4 * g + 1]); w0.y = cvtpk(o0[4 * g + 2], o0[4 * g + 3]); *(u32x2*)(op + 8 * g) = w0;
                u32x2 w1; w1.x = cvtpk(o1[4 * g], o1[4 * g + 1]); w1.y = cvtpk(o1[4 * g + 2], o1[4 * g + 3]); *(u32x2*)(op + 32 + 8 * g) = w1;
            }
#pragma unroll
            for (int d0 = 0; d0 < 4; ++d0) qf[d0] = qn[d0];
            TSTOP(212);
        }
    }
    __syncthreads();
    if (C.tid < 128) { float s = 0.f;
#pragma unroll
        for (int hh = 0; hh < 16; ++hh) s += ssq[hh * 128 + C.tid];
        C.RATT[b * SEQ + t0 + C.tid] = 1.0f / sqrtf(s * (1.0f / 1024.f) + EPS); }
    __syncthreads();
}

__device__ __forceinline__ void phase_scan(Ctx& C) {
    const int total = NB * NH * HD * NST;
    for (int e = C.bid * NTHREADS + C.tid; e < total; e += C.G * NTHREADS) {
        const int pn = e & (HD * NST - 1), h = (e >> 13) & 15, b = e >> 17;
        float carry = 0.f;
        for (int c = 0; c < NCH; ++c) {
            bf16* p = C.ST + ((size_t)((b * NCH + c) * NH + h)) * (HD * NST) + pn;
            const float s = bf2f(*p), dec = C.CDEC[(b * NCH + c) * NH + h];
            *p = (bf16)f2bf(carry);
            carry = carry * dec + s;
        }
    }
}

__device__ __forceinline__ void ssd_out_unit(Ctx& C, int u) {
    const int g = u & 1, c = (u >> 1) & 31, b = u >> 6;
    bf16* Cs = (bf16*)C.lds;
    bf16* Bs = Cs + 128 * 130;
    float* xs = (float*)Bs;
    float* cb = (float*)(C.lds + 2 * 33280);
    bf16* pv = (bf16*)(C.lds + 2 * 33280 + 65536);
    float* dts = (float*)(C.lds + 2 * 33280 + 65536 + 16640);
    float* acs = dts + 128; float* ssl = acs + 128; float* rsl = ssl + 128;
    const int t0 = c * CHK;
    __syncthreads();
    for (int idx = C.tid; idx < 128 * 128; idx += NTHREADS) { const int l = idx >> 7, n = idx & 127;
        Bs[l * 130 + n] = (bf16)f2bf(conv_silu(C, b, t0 + l, 1024 + g * 128 + n));
        Cs[l * 130 + n] = (bf16)f2bf(conv_silu(C, b, t0 + l, 1280 + g * 128 + n)); }
    if (C.tid < 128) ssl[C.tid] = 0.f;
    __syncthreads();
    {
        const int s = C.tid & 127, lg = C.tid >> 7;
        float acc[32];
#pragma unroll
        for (int i = 0; i < 32; ++i) acc[i] = 0.f;
        for (int n = 0; n < 128; ++n) { const float bv = bf2f(Bs[s * 130 + n]);
#pragma unroll
            for (int i = 0; i < 32; ++i) acc[i] += bf2f(Cs[(lg * 32 + i) * 130 + n]) * bv; }
#pragma unroll
        for (int i = 0; i < 32; ++i) cb[(lg * 32 + i) * 128 + s] = acc[i];
    }
    for (int r = 0; r < 8; ++r) {
        const int h = g * 8 + r;
        __syncthreads();
        if (C.tid < 128) dts[C.tid] = C.DT[(size_t)(b * SEQ + t0 + C.tid) * 16 + h];
        __syncthreads();
        if (C.tid == 0) { const float A = -expf(C.a_log[h]); float run = 0.f; for (int l = 0; l < 128; ++l) { run += dts[l] * A; acs[l] = run; } }
        for (int idx = C.tid; idx < 128 * 64; idx += NTHREADS) { const int l = idx >> 6, p = idx & 63; xs[idx] = conv_silu(C, b, t0 + l, h * 64 + p); }
        { const bf16* st = C.ST + ((size_t)((b * NCH + c) * NH + h)) * (HD * NST);
          for (int idx = C.tid; idx < 64 * 128; idx += NTHREADS) { const int p = idx >> 7, n = idx & 127; pv[p * 130 + n] = st[idx]; } }
        __syncthreads();
        const int p = C.tid & 63, lg = C.tid >> 6;
        const float dsk = C.d_skip[h];
        for (int i = 0; i < 16; ++i) {
            const int l = lg * 16 + i;
            float acc = 0.f;
            for (int s = 0; s <= l; ++s) acc += cb[l * 128 + s] * __expf(acs[l] - acs[s]) * dts[s] * xs[s * 64 + p];
            float off = 0.f;
            for (int n = 0; n < 128; ++n) off += bf2f(Cs[l * 130 + n]) * bf2f(pv[p * 130 + n]);
            const float y = acc + __expf(acs[l]) * off + dsk * xs[l * 64 + p];
            const size_t row = (size_t)(b * SEQ + t0 + l);
            const float z = bf2f(C.PROJ[row * NPROJ + PZ + h * 64 + p]);
            const float uu = y * silu_f(z);
            C.MIX[row * 2048 + h * 64 + p] = (bf16)f2bf(uu);
            const float sq = wave_sum(uu * uu);
            if (C.lane == 0) ssl[l] += sq;
        }
    }
    __syncthreads();
    if (C.tid < 128) rsl[C.tid] = 1.0f / sqrtf(ssl[C.tid] * (1.0f / 512.f) + EPS);
    __syncthreads();
    for (int idx = C.tid; idx < 128 * 256; idx += NTHREADS) {
        const int l = idx >> 8, c2 = (idx & 255) * 2, col = g * 512 + c2;
        unsigned* p = (unsigned*)(C.MIX + (size_t)(b * SEQ + t0 + l) * 2048 + col);
        const unsigned w = *p;
        *p = pk2(bf2f(w) * rsl[l] * C.ssd_norm[col], bf2f(w >> 16) * rsl[l] * C.ssd_norm[col + 1]);
    }
    __syncthreads();
}

__device__ __forceinline__ void chunk_cumsum(const Ctx& C, int rowbase, int hd, float& d0, float& d1, float& c0, float& c1, float& total) {
    const float A = -expf(C.a_log[hd]);
    d0 = C.DT[(size_t)(rowbase + 2 * C.lane) * 16 + hd]; d1 = C.DT[(size_t)(rowbase + 2 * C.lane + 1) * 16 + hd];
    const float a0 = d0 * A, a1 = d1 * A;
    float v = a0 + a1;
#pragma unroll
    for (int o = 1; o < 64; o <<= 1) { const float t = __shfl_up(v, o); if (C.lane >= o) v += t; }
    c1 = v; c0 = v - a1; total = __shfl(v, 63);
}

constexpr int X4RS = 576, BRS = 320;
__device__ __forceinline__ void ssd_states_fast(Ctx& C, int u) {
    const int g = u & 1, c = (u >> 1) & 31, b = u >> 6, t0 = c * CHK, rowbase = b * SEQ + t0;
    LAS unsigned char* L = (LAS unsigned char*)C.lds;
    LAS unsigned char* XI = L;
    LAS unsigned char* BI = L + 73728;
    LAS float* WL = (LAS float*)(L + 114688);
    const int lane = C.lane, r32 = lane & 31, h = lane >> 5, q4 = (lane & 15) >> 2, p4 = lane & 3, b16 = (lane >> 4) & 1, w = C.wave;
    __syncthreads();
    TSTART(200);
    {
        float d0, d1, c0, c1, tot; chunk_cumsum(C, rowbase, g * 8 + w, d0, d1, c0, c1, tot);
        WL[w * 128 + 2 * lane] = d0 * expf(tot - c0); WL[w * 128 + 2 * lane + 1] = d1 * expf(tot - c1);
        if (lane == 0) C.CDEC[(b * NCH + c) * NH + g * 8 + w] = expf(tot);
    }
    TSTOP(200);
    for (int ps = 0; ps < 2; ++ps) {
        TSTART(201);
        const bool task = ps == 0 || C.tid < 256;
        const int cg = ps == 0 ? (C.tid & 63) : (C.tid & 31), run = ps == 0 ? (C.tid >> 6) : (C.tid >> 5);
        const int ch = ps == 1 ? g * 512 + 256 + cg * 8 : (cg < 32 ? g * 512 + cg * 8 : (cg < 48 ? 1024 + g * 128 + (cg - 32) * 8 : 1280 + g * 128 + (cg - 48) * 8));
        const int l0 = 16 * run;
        u32x4 raw[19];
#pragma unroll
        for (int i = 0; i < 19; ++i) raw[i] = (u32x4){0u, 0u, 0u, 0u};
        if (task) {
#pragma unroll
            for (int i = 0; i < 3; ++i) {
                if (l0 > 0) raw[i] = *(const u32x4*)(C.PROJ + (size_t)(rowbase + l0 + i - 3) * NPROJ + PX + ch);
                else if (c > 0) raw[i] = *(const u32x4*)(C.HALO + ((size_t)(b * NCH + c - 1) * 3 + i) * CONVCH + ch);
            }
#pragma unroll
            for (int i = 3; i < 19; ++i) raw[i] = *(const u32x4*)(C.PROJ + (size_t)(rowbase + l0 + i - 3) * NPROJ + PX + ch);
        }
        __syncthreads();
        TSTOP(201); TSTART(202);
        if (task) {
            float cw[4][8], cbias[8];
#pragma unroll
            for (int j = 0; j < 4; ++j) { const f32x4 a = *(const f32x4*)(C.conv_w + j * CONVCH + ch), bq = *(const f32x4*)(C.conv_w + j * CONVCH + ch + 4);
                cw[j][0] = a[0]; cw[j][1] = a[1]; cw[j][2] = a[2]; cw[j][3] = a[3]; cw[j][4] = bq[0]; cw[j][5] = bq[1]; cw[j][6] = bq[2]; cw[j][7] = bq[3]; }
            { const f32x4 a = *(const f32x4*)(C.conv_b + ch), bq = *(const f32x4*)(C.conv_b + ch + 4);
              cbias[0] = a[0]; cbias[1] = a[1]; cbias[2] = a[2]; cbias[3] = a[3]; cbias[4] = bq[0]; cbias[5] = bq[1]; cbias[6] = bq[2]; cbias[7] = bq[3]; }
#pragma unroll
            for (int i = 0; i < 16; ++i) {
                float o[8];
#pragma unroll
                for (int k = 0; k < 8; ++k) o[k] = cbias[k];
#pragma unroll
                for (int j = 0; j < 4; ++j) { const u32x4 rv = raw[i + j];
                    o[0] += cw[j][0] * bf2f(rv.x); o[1] += cw[j][1] * bf2f(rv.x >> 16); o[2] += cw[j][2] * bf2f(rv.y); o[3] += cw[j][3] * bf2f(rv.y >> 16);
                    o[4] += cw[j][4] * bf2f(rv.z); o[5] += cw[j][5] * bf2f(rv.z >> 16); o[6] += cw[j][6] * bf2f(rv.w); o[7] += cw[j][7] * bf2f(rv.w >> 16); }
                u32x4 pk; pk.x = cvtpk(silu_f(o[0]), silu_f(o[1])); pk.y = cvtpk(silu_f(o[2]), silu_f(o[3])); pk.z = cvtpk(silu_f(o[4]), silu_f(o[5])); pk.w = cvtpk(silu_f(o[6]), silu_f(o[7]));
                *(u32x4*)(C.PROJ + (size_t)(rowbase + l0 + i) * NPROJ + PX + ch) = pk;
                if (ps == 1 || cg < 32) *(LAS u32x4*)(XI + (l0 + i) * X4RS + (cg & 31) * 16) = pk;
                else if (cg < 48) *(LAS u32x4*)(BI + (l0 + i) * BRS + (cg - 32) * 16) = pk;
            }
        }
        __syncthreads();
        TSTOP(202); TSTART(203);
        const int hl = w & 3, hh = ps * 4 + hl, nt0 = 2 * (w >> 2);
        f32x16 acc[2][2];
#pragma unroll
        for (int i = 0; i < 2; ++i)
#pragma unroll
            for (int pt = 0; pt < 2; ++pt)
#pragma unroll
                for (int r = 0; r < 16; ++r) acc[i][pt][r] = 0.f;
#pragma unroll 2
        for (int ks = 0; ks < 8; ++ks) {
            const f32x4 w0 = *(LAS const f32x4*)(WL + hh * 128 + 16 * ks + 8 * h), w1 = *(LAS const f32x4*)(WL + hh * 128 + 16 * ks + 8 * h + 4);
            LAS const unsigned char* xa = XI + (16 * ks + 8 * h + q4) * X4RS + (hl * 64) * 2 + 32 * b16 + 8 * p4;
            LAS const unsigned char* ba = BI + (16 * ks + 8 * h + q4) * BRS + (nt0 * 32) * 2 + 32 * b16 + 8 * p4;
            bf16x8 xf[2];
#pragma unroll
            for (int pt = 0; pt < 2; ++pt) {
                const s16x4 lo = tr16(xa + pt * 64), hi = tr16(xa + 4 * X4RS + pt * 64);
                u32x4 sc;
                sc.x = cvtpk(bf2f((unsigned short)lo[0]) * w0[0], bf2f((unsigned short)lo[1]) * w0[1]); sc.y = cvtpk(bf2f((unsigned short)lo[2]) * w0[2], bf2f((unsigned short)lo[3]) * w0[3]);
                sc.z = cvtpk(bf2f((unsigned short)hi[0]) * w1[0], bf2f((unsigned short)hi[1]) * w1[1]); sc.w = cvtpk(bf2f((unsigned short)hi[2]) * w1[2], bf2f((unsigned short)hi[3]) * w1[3]);
                xf[pt] = __builtin_bit_cast(bf16x8, sc);
            }
#pragma unroll
            for (int i = 0; i < 2; ++i) {
                const bf16x8 bfr = cat8(tr16(ba + i * 64), tr16(ba + 4 * BRS + i * 64));
                acc[i][0] = MFMA32(bfr, xf[0], acc[i][0]); acc[i][1] = MFMA32(bfr, xf[1], acc[i][1]);
            }
        }
        bf16* st = C.ST + ((size_t)((b * NCH + c) * NH + g * 8 + hh)) * (HD * NST);
#pragma unroll
        for (int i = 0; i < 2; ++i)
#pragma unroll
            for (int pt = 0; pt < 2; ++pt)
#pragma unroll
                for (int gq = 0; gq < 4; ++gq) { u32x2 wv; wv.x = cvtpk(acc[i][pt][4 * gq], acc[i][pt][4 * gq + 1]); wv.y = cvtpk(acc[i][pt][4 * gq + 2], acc[i][pt][4 * gq + 3]);
                    *(u32x2*)(st + (32 * pt + r32) * NST + 32 * (nt0 + i) + 8 * gq + 4 * h) = wv; }
        TSTOP(203);
    }
    __syncthreads();
}

__device__ __forceinline__ void phase_scan_fast(Ctx& C) {
    const int total = NB * NH * HD * NST / 8;
    for (int e = C.bid * NTHREADS + C.tid; e < total; e += C.G * NTHREADS) {
        const int pn = e & 1023, hd = (e >> 10) & 15, b = e >> 14;
        float carry[8];
#pragma unroll
        for (int k = 0; k < 8; ++k) carry[k] = 0.f;
        u32x4* p = (u32x4*)(C.ST + ((size_t)(b * NCH * NH + hd)) * (HD * NST)) + pn;
        const float* dc = C.CDEC + b * NCH * NH + hd;
        for (int c0 = 0; c0 < NCH; c0 += 8) {
            u32x4 sv[8]; float dv[8];
#pragma unroll
            for (int i = 0; i < 8; ++i) { sv[i] = p[(size_t)(c0 + i) * NH * 1024]; dv[i] = dc[(c0 + i) * NH]; }
#pragma unroll
            for (int i = 0; i < 8; ++i) {
                const u32x4 s = sv[i]; const float dec = dv[i];
                u32x4 o; o.x = cvtpk(carry[0], carry[1]); o.y = cvtpk(carry[2], carry[3]); o.z = cvtpk(carry[4], carry[5]); o.w = cvtpk(carry[6], carry[7]);
                p[(size_t)(c0 + i) * NH * 1024] = o;
                carry[0] = carry[0] * dec + bf2f(s.x); carry[1] = carry[1] * dec + bf2f(s.x >> 16); carry[2] = carry[2] * dec + bf2f(s.y); carry[3] = carry[3] * dec + bf2f(s.y >> 16);
                carry[4] = carry[4] * dec + bf2f(s.z); carry[5] = carry[5] * dec + bf2f(s.z >> 16); carry[6] = carry[6] * dec + bf2f(s.w); carry[7] = carry[7] * dec + bf2f(s.w >> 16);
            }
        }
    }
}

constexpr int BCRS = 272;
__device__ __forceinline__ void ssd_out_fast(Ctx& C, int u) {
    const int g = u & 1, c = (u >> 1) & 31, b = u >> 6, t0 = c * CHK, rowbase = b * SEQ + t0;
    LAS unsigned char* L = (LAS unsigned char*)C.lds;
    LAS unsigned char* BI = L;
    LAS unsigned char* CI = L + 34816;
    LAS unsigned char* XI = L + 69632;
    LAS float* AC = (LAS float*)(L + 143360);
    LAS float* DL = AC + 1024;
    LAS float* ssl = DL + 1024;
    LAS float* rsl = ssl + 128;
    const int lane = C.lane, r32 = lane & 31, h = lane >> 5, q4 = (lane & 15) >> 2, p4 = lane & 3, b16 = (lane >> 4) & 1, w = C.wave;
    __syncthreads();
    TSTART(40);
    {   float d0, d1, c0, c1, tot; chunk_cumsum(C, rowbase, g * 8 + w, d0, d1, c0, c1, tot);
        AC[w * 128 + 2 * lane] = c0 * 1.4426950408889634f; AC[w * 128 + 2 * lane + 1] = c1 * 1.4426950408889634f;
        DL[w * 128 + 2 * lane] = d0; DL[w * 128 + 2 * lane + 1] = d1; }
    if (C.tid < 128) ssl[C.tid] = 0.f;
#pragma unroll
    for (int i = 0; i < 8; ++i) { const int idx = C.tid + NTHREADS * i, row = idx >> 5, cc = idx & 31;
        const u32x4 v = *(const u32x4*)(C.PROJ + (size_t)(rowbase + row) * NPROJ + PX + 1024 + (cc >> 4) * 256 + g * 128 + (cc & 15) * 8);
        *(LAS u32x4*)((cc < 16 ? BI : CI) + row * BCRS + (cc & 15) * 16) = v; }
    TSTOP(40);
    for (int ps = 0; ps < 2; ++ps) {
        TSTART(41);
        __syncthreads();
#pragma unroll
        for (int i = 0; i < 8; ++i) { const int idx = C.tid + NTHREADS * i, row = idx >> 5, cc = idx & 31;
            *(LAS u32x4*)(XI + row * X4RS + cc * 16) = *(const u32x4*)(C.PROJ + (size_t)(rowbase + row) * NPROJ + PX + g * 512 + ps * 256 + cc * 8); }
        __syncthreads();
        TSTOP(41);
        const int hl = w & 3, hh = ps * 4 + hl, hd = g * 8 + hh;
        const float dsk = C.d_skip[hd];
        const bf16* prev = C.ST + ((size_t)((b * NCH + c) * NH + hd)) * (HD * NST);
        for (int li = 0; li < 2; ++li) {
            const int lt = (w >> 2) ? (1 + li) : (3 * li);
            const int l = 32 * lt + r32;
            f32x16 acc[2];
#pragma unroll
            for (int r = 0; r < 16; ++r) { acc[0][r] = 0.f; acc[1][r] = 0.f; }
            TSTART(42);
            const size_t grow = (size_t)(rowbase + l);
            u32x2 zr[2][4];
#pragma unroll
            for (int pt = 0; pt < 2; ++pt)
#pragma unroll
                for (int gq = 0; gq < 4; ++gq) zr[pt][gq] = *(const u32x2*)(C.PROJ + grow * NPROJ + PZ + hd * 64 + 32 * pt + 8 * gq + 4 * h);
            bf16x8 cf[8];
#pragma unroll
            for (int ks = 0; ks < 8; ++ks) cf[ks] = *(LAS const bf16x8*)(CI + l * BCRS + (16 * ks + 8 * h) * 2);
            {   bf16x8 pf[2][8];
#pragma unroll
                for (int pt = 0; pt < 2; ++pt)
#pragma unroll
                    for (int ks = 0; ks < 8; ++ks) pf[pt][ks] = *(const bf16x8*)(prev + (32 * pt + r32) * NST + 16 * ks + 8 * h);
                __builtin_amdgcn_sched_barrier(0);
#pragma unroll
                for (int pt = 0; pt < 2; ++pt)
#pragma unroll
                    for (int ks = 0; ks < 8; ++ks) acc[pt] = MFMA32(pf[pt][ks], cf[ks], acc[pt]);
            }
            const float al = AC[hh * 128 + l], el = __builtin_amdgcn_exp2f(al);
#pragma unroll
            for (int r = 0; r < 16; ++r) { acc[0][r] *= el; acc[1][r] *= el; }
            TSTOP(42); TSTART(43);
            for (int st = 0; st <= lt; ++st) {
                f32x16 X;
#pragma unroll
                for (int r = 0; r < 16; ++r) X[r] = 0.f;
#pragma unroll
                for (int ks = 0; ks < 8; ++ks) { const bf16x8 bfr = *(LAS const bf16x8*)(BI + (32 * st + r32) * BCRS + (16 * ks + 8 * h) * 2); X = MFMA32(bfr, cf[ks], X); }
#pragma unroll
                for (int gq = 0; gq < 4; ++gq) {
                    const int s0 = 32 * st + 8 * gq + 4 * h;
                    const f32x4 as = *(LAS const f32x4*)(AC + hh * 128 + s0), ds = *(LAS const f32x4*)(DL + hh * 128 + s0);
#pragma unroll
                    for (int i = 0; i < 4; ++i) { const float e = __builtin_amdgcn_exp2f(fminf(al - as[i], 0.f)) * ds[i]; X[4 * gq + i] = (s0 + i <= l) ? X[4 * gq + i] * e : 0.f; }
                }
                LAS const unsigned char* xa = XI + (32 * st + 4 * h + q4) * X4RS + (hl * 64) * 2 + 32 * b16 + 8 * p4;
#pragma unroll
                for (int tq = 0; tq < 2; ++tq) {
                    const bf16x8 mf = (tq == 0) ? PACK8(X, 0) : PACK8(X, 8);
#pragma unroll
                    for (int pt = 0; pt < 2; ++pt) { const bf16x8 xf = cat8(tr16(xa + (16 * tq) * X4RS + pt * 64), tr16(xa + (16 * tq + 8) * X4RS + pt * 64)); acc[pt] = MFMA32(xf, mf, acc[pt]); }
                }
            }
            TSTOP(43); TSTART(44);
            float sq = 0.f;
#pragma unroll
            for (int pt = 0; pt < 2; ++pt)
#pragma unroll
                for (int gq = 0; gq < 4; ++gq) {
                    const int p0 = 32 * pt + 8 * gq + 4 * h;
                    const u32x2 xv = *(LAS const u32x2*)(XI + l * X4RS + (hl * 64 + p0) * 2);
                    const u32x2 zv = zr[pt][gq];
                    const float y0 = (acc[pt][4 * gq] + dsk * bf2f(xv.x)) * silu_f(bf2f(zv.x)), y1 = (acc[pt][4 * gq + 1] + dsk * bf2f(xv.x >> 16)) * silu_f(bf2f(zv.x >> 16));
                    const float y2 = (acc[pt][4 * gq + 2] + dsk * bf2f(xv.y)) * silu_f(bf2f(zv.y)), y3 = (acc[pt][4 * gq + 3] + dsk * bf2f(xv.y >> 16)) * silu_f(bf2f(zv.y >> 16));
                    sq += y0 * y0 + y1 * y1 + y2 * y2 + y3 * y3;
                    u32x2 o; o.x = cvtpk(y0, y1); o.y = cvtpk(y2, y3);
                    *(u32x2*)(C.MIX + grow * 2048 + hd * 64 + p0) = o;
                }
            sq += __shfl_xor(sq, 32);
            if (h == 0) atomicAdd((float*)(ssl + l), sq);
            TSTOP(44);
        }
    }
    __syncthreads();
    if (C.tid < 128) C.RSG[(size_t)(rowbase + C.tid) * 2 + g] = 1.0f / sqrtf(ssl[C.tid] * (1.0f / 512.f) + EPS);
    __syncthreads();
}

__device__ __forceinline__ void phase_gemm2(Ctx& C) {
    pg8::DenseOrder S; S.init(M, DM, 2048, C.WOUT, C.G, C.bid);
    pg8::EpiResid E{C.x, C.out, C.XN, C.RSG, C.RATT, (LAS float*)((LAS unsigned char*)C.lds + 135168)};
    pg8::gemm_phase<pg8::EpiResid, pg8::DenseOrder, true>((LAS unsigned char*)C.lds, (const char*)C.MIX, 2048, S, E);
}

__device__ __forceinline__ void phase_router(Ctx& C) {
    float* T = (float*)C.lds + C.wave * 4096;
    const int gw = C.bid * NWAVES + C.wave, NGW = C.G * NWAVES;
    unsigned* cnt = C.ctl + CW_CNT;
    for (int r0 = gw * 4; r0 < M; r0 += NGW * 4) {
#pragma unroll
        for (int r = 0; r < 4; ++r) {
            const int row = r0 + r;
            const f32x4* hr = (const f32x4*)(C.out + (size_t)row * DM) + C.lane;
            f32x4 v[4]; float ss = 0.f;
#pragma unroll
            for (int j = 0; j < 4; ++j) { v[j] = hr[64 * j]; ss += v[j][0] * v[j][0] + v[j][1] * v[j][1] + v[j][2] * v[j][2] + v[j][3] * v[j][3]; }
            const float rstd = 1.0f / sqrtf(wave_sum(ss) * (1.0f / DM) + EPS);
            u32x2* o = (u32x2*)(C.XN + (size_t)row * DM) + C.lane;
#pragma unroll
            for (int j = 0; j < 4; ++j) { const f32x4 g = ((const f32x4*)C.norm_ffn)[C.lane + 64 * j]; v[j] = v[j] * rstd * g;
                u32x2 w; w.x = pk2(v[j][0], v[j][1]); w.y = pk2(v[j][2], v[j][3]); o[64 * j] = w;
                *(f32x4*)(T + r * 1024 + (C.lane + 64 * j) * 4) = v[j]; }
        }
        asm volatile("s_waitcnt lgkmcnt(0)" ::: "memory");
        float ae[4] = {0.f, 0.f, 0.f, 0.f}, ag[4] = {0.f, 0.f, 0.f, 0.f};
        for (int k = 0; k < DM; ++k) { const float w = C.w_re[k * 64 + C.lane];
#pragma unroll
            for (int r = 0; r < 4; ++r) ae[r] += T[r * 1024 + k] * w; }
        { const int col = C.lane & 7, ks = C.lane >> 3;
          for (int kk = 0; kk < 128; ++kk) { const int k = ks * 128 + kk; const float w = C.w_rg[k * 8 + col];
#pragma unroll
              for (int r = 0; r < 4; ++r) ag[r] += T[r * 1024 + k] * w; }
#pragma unroll
          for (int r = 0; r < 4; ++r) { ag[r] += __shfl_xor(ag[r], 8); ag[r] += __shfl_xor(ag[r], 16); ag[r] += __shfl_xor(ag[r], 32); } }
#pragma unroll
        for (int r = 0; r < 4; ++r) {
            const int row = r0 + r;
            float gl[8]; int gsel = 0; float gmax;
#pragma unroll
            for (int c2 = 0; c2 < 8; ++c2) gl[c2] = __shfl(ag[r], c2);
            gmax = gl[0];
#pragma unroll
            for (int c2 = 1; c2 < 8; ++c2) if (gl[c2] > gmax) { gmax = gl[c2]; gsel = c2; }
            float gsum = 0.f;
#pragma unroll
            for (int c2 = 0; c2 < 8; ++c2) gsum += expf(gl[c2] - gmax);
            const float pgrp = 1.0f / gsum;
            float el[8];
#pragma unroll
            for (int i = 0; i < 8; ++i) el[i] = __shfl(ae[r], gsel * 8 + i);
            int i0 = 0; float l0 = el[0];
#pragma unroll
            for (int i = 1; i < 8; ++i) if (el[i] > l0) { l0 = el[i]; i0 = i; }
            int i1 = -1; float l1 = -INFINITY;
#pragma unroll
            for (int i = 0; i < 8; ++i) if (i != i0 && el[i] > l1) { l1 = el[i]; i1 = i; }
            const float e1 = expf(l1 - l0), g0 = pgrp / (1.0f + e1), g1 = pgrp * e1 / (1.0f + e1);
            if (C.lane == 0) {
#pragma unroll
                for (int k = 0; k < 2; ++k) { const int e = gsel * 8 + (k == 0 ? i0 : i1);
                    const unsigned pos = atomicAdd(&cnt[e], 1u);
                    C.TE[row * 2 + k] = e; C.TP[row * 2 + k] = (int)pos; C.TG[row * 2 + k] = (k == 0 ? g0 : g1);
                    C.LIST[(size_t)e * LISTCAP + pos] = row * 2 + k; }
            }
        }
    }
    __syncthreads();
    LAS float* scr = (LAS float*)((LAS unsigned char*)C.lds + C.wave * 8704);
    for (int _rep = 0; _rep < (RPH == 60 ? 2 : 1); ++_rep)
    for (int it = gw; it < NE * 768; it += NGW) {
        const int e = it / 768; int r = it % 768;
        if (r < 512) { const bool up = r >= 256; r &= 255; const int kb = r >> 4, nb = r & 15, n0 = nb * 32;
            transpose_item((up ? C.w_up : C.w_gate) + (size_t)e * DM * FF, FF, kb * 64, n0, C.WGU + (size_t)e * 1024 * 1024, DM, (n0 >> 7) * 256 + (n0 & 127) + (up ? 128 : 0), scr, C.lane, C.norm_ffn); }
        else { r -= 512; const int kb = r >> 5, nb = r & 31; transpose_item(C.w_down + (size_t)e * FF * DM, DM, kb * 64, nb * 32, C.WD + (size_t)e * 1024 * FF, FF, nb * 32, scr, C.lane); }
    }
}

struct MoeItem { const float* W; int ldw, k0, n0; bf16* WT; int K, drow0; const float* ks; };
__device__ __forceinline__ MoeItem moe_item(const Ctx& C, int it) {
    MoeItem I; const int e = it / 768; int r = it % 768;
    if (r < 512) { const bool up = r >= 256; r &= 255; const int kb = r >> 4, nb = r & 15, n0 = nb * 32;
        I.W = (up ? C.w_up : C.w_gate) + (size_t)e * DM * FF; I.ldw = FF; I.k0 = kb * 64; I.n0 = n0; I.WT = C.WGU + (size_t)e * 1024 * 1024; I.K = DM; I.drow0 = (n0 >> 7) * 256 + (n0 & 127) + (up ? 128 : 0); I.ks = C.norm_ffn; }
    else { r -= 512; const int kb = r >> 5, nb = r & 31;
        I.W = C.w_down + (size_t)e * FF * DM; I.ldw = DM; I.k0 = kb * 64; I.n0 = nb * 32; I.WT = C.WD + (size_t)e * 1024 * FF; I.K = FF; I.drow0 = nb * 32; I.ks = nullptr; }
    return I;
}
__device__ __forceinline__ void moe_convert_item(Ctx& C, int it, LAS float* scr) {
    const int e = it / 768; int r = it % 768;
    if (r < 512) { const bool up = r >= 256; r &= 255; const int kb = r >> 4, nb = r & 15, n0 = nb * 32;
        transpose_item((up ? C.w_up : C.w_gate) + (size_t)e * DM * FF, FF, kb * 64, n0, C.WGU + (size_t)e * 1024 * 1024, DM, (n0 >> 7) * 256 + (n0 & 127) + (up ? 128 : 0), scr, C.lane, C.norm_ffn); }
    else { r -= 512; const int kb = r >> 5, nb = r & 31; transpose_item(C.w_down + (size_t)e * FF * DM, DM, kb * 64, nb * 32, C.WD + (size_t)e * 1024 * FF, FF, nb * 32, scr, C.lane); }
}
constexpr int NREM = (NE - E1) * 512 + (NE - E7) * 256;
__device__ __forceinline__ int rem_item(int j) { if (j < (NE - E1) * 512) return (E1 + j / 512) * 768 + (j % 512); j -= (NE - E1) * 512; return (E7 + j / 256) * 768 + 512 + (j % 256); }
template <class ItemOf> __device__ __forceinline__ void conv_stream(Ctx& C, int nitems, ItemOf item_of) {
    LAS float* scr = (LAS float*)((LAS unsigned char*)C.lds + C.wave * 8704);
    const int j0 = C.bid * NWAVES + C.wave, step = NCONV * NWAVES;
    if (j0 >= nitems) return;
    float ta[32], tb[32]; f32x4 ka[2], kb2[2];
    MoeItem A = moe_item(C, item_of(j0)), B = A;
    transpose_load(A.W, A.ldw, A.k0, A.n0, C.lane, A.ks, ta, ka);
    for (int j = j0; j < nitems; j += 2 * step) {
        const bool hb = j + step < nitems, ha = j + 2 * step < nitems;
        if (hb) { B = moe_item(C, item_of(j + step)); transpose_load(B.W, B.ldw, B.k0, B.n0, C.lane, B.ks, tb, kb2); }
        transpose_store(ta, ka, A.WT, A.K, A.drow0, A.k0, scr, C.lane);
        if (ha) { A = moe_item(C, item_of(j + 2 * step)); transpose_load(A.W, A.ldw, A.k0, A.n0, C.lane, A.ks, ta, ka); }
        if (hb) transpose_store(tb, kb2, B.WT, B.K, B.drow0, B.k0, scr, C.lane);
    }
}
__device__ __forceinline__ void conv_gateup_early(Ctx& C) { conv_stream(C, E1 * 512, [](int j) { return (j / 512) * 768 + (j % 512); }); }
__device__ __forceinline__ void conv_down_early(Ctx& C) { conv_stream(C, E7 * 256, [](int j) { return (j / 256) * 768 + 512 + (j % 256); }); }
__device__ __forceinline__ void phase_router_fast(Ctx& C) {
    LAS float* scr = (LAS float*)((LAS unsigned char*)C.lds + C.wave * 8704);
    LAS float* PA = (LAS float*)((LAS unsigned char*)C.lds + 71680);
    int cit = C.bid * NWAVES + C.wave;
    const int lane = C.lane, r32 = lane & 31, h = lane >> 5, w = C.wave, tt = w & 3, kh = w >> 2;
    const int gw = C.bid * NWAVES + C.wave, NGW = C.G * NWAVES;
    unsigned* cnt = C.ctl + CW_CNT;
    LAS unsigned* hist = (LAS unsigned*)(PA + 4 * 49 * 64);
    LAS unsigned* hbase = hist + 64;
    TSTART(60);
    for (int rb = C.bid; rb < M / 128; rb += C.G) {
        const int row = rb * 128 + 32 * tt + r32;
        if (C.tid < 64) hist[C.tid] = 0u;
        const bf16* hp = C.XN + (size_t)row * DM + 512 * kh + 8 * h;
        const bf16* whp = C.WRH + (size_t)r32 * DM + 512 * kh + 8 * h;
        const bf16* wlp = C.WRL + (size_t)r32 * DM + 512 * kh + 8 * h;
        f32x16 acc[3];
#pragma unroll
        for (int t = 0; t < 3; ++t)
#pragma unroll
            for (int r = 0; r < 16; ++r) acc[t][r] = 0.f;
        float ss = 0.f;
#pragma unroll 1
        for (int kb = 0; kb < 8; ++kb) {
            u32x4 hv[4]; bf16x8 wh[4][3], wl[4][3];
#pragma unroll
            for (int i = 0; i < 4; ++i) hv[i] = *(const u32x4*)(hp + (kb * 4 + i) * 16);
#pragma unroll
            for (int i = 0; i < 4; ++i)
#pragma unroll
                for (int t = 0; t < 3; ++t) { wh[i][t] = *(const bf16x8*)(whp + (size_t)t * 32 * DM + (kb * 4 + i) * 16); wl[i][t] = *(const bf16x8*)(wlp + (size_t)t * 32 * DM + (kb * 4 + i) * 16); }
            __builtin_amdgcn_sched_barrier(0);
            if (cit < NREM) { moe_convert_item(C, rem_item(cit), scr); cit += NGW; }
            __builtin_amdgcn_sched_barrier(0);
#pragma unroll
            for (int i = 0; i < 4; ++i) {
                const u32x4 a = hv[i];
                const float f0 = bf2f(a.x), f1 = bf2f(a.x >> 16), f2 = bf2f(a.y), f3 = bf2f(a.y >> 16), f4 = bf2f(a.z), f5 = bf2f(a.z >> 16), f6 = bf2f(a.w), f7 = bf2f(a.w >> 16);
                ss += f0 * f0 + f1 * f1 + f2 * f2 + f3 * f3 + f4 * f4 + f5 * f5 + f6 * f6 + f7 * f7;
                const bf16x8 thf = __builtin_bit_cast(bf16x8, a);
#pragma unroll
                for (int t = 0; t < 3; ++t) { acc[t] = MFMA32(wh[i][t], thf, acc[t]); acc[t] = MFMA32(wl[i][t], thf, acc[t]); }
            }
            __builtin_amdgcn_sched_barrier(0);
        }
        __syncthreads();
        if (kh == 1) {
#pragma unroll
            for (int t = 0; t < 3; ++t)
#pragma unroll
                for (int r = 0; r < 16; ++r) PA[(tt * 49 + t * 16 + r) * 64 + lane] = acc[t][r];
            PA[(tt * 49 + 48) * 64 + lane] = ss;
        }
        __syncthreads();
        int es0 = 0, es1 = 0; float gs0 = 0.f, gs1 = 0.f, rstd_s = 0.f; unsigned lp0 = 0u, lp1 = 0u;
        if (kh == 0) {
#pragma unroll
            for (int t = 0; t < 3; ++t)
#pragma unroll
                for (int r = 0; r < 16; ++r) acc[t][r] += PA[(tt * 49 + t * 16 + r) * 64 + lane];
            ss += PA[(tt * 49 + 48) * 64 + lane];
            ss += __shfl_xor(ss, 32);
            const float rstd = 1.0f / sqrtf(ss * (1.0f / DM) + EPS);
            if (h == 0) C.RS[row] = rstd;
            float gm[4], go[4], gl[8];
#pragma unroll
            for (int i = 0; i < 4; ++i) { gm[i] = acc[2][i] * rstd; go[i] = __shfl_xor(gm[i], 32); }
#pragma unroll
            for (int i = 0; i < 4; ++i) { gl[i] = h ? go[i] : gm[i]; gl[4 + i] = h ? gm[i] : go[i]; }
            int gsel = 0; float gmax = gl[0];
#pragma unroll
            for (int c2 = 1; c2 < 8; ++c2) if (gl[c2] > gmax) { gmax = gl[c2]; gsel = c2; }
            float gsum = 0.f;
#pragma unroll
            for (int c2 = 0; c2 < 8; ++c2) gsum += expf(gl[c2] - gmax);
            const float pgrp = 1.0f / gsum;
            float em[4], eo[4], el[8];
#pragma unroll
            for (int i = 0; i < 4; ++i) { float v = acc[0][i];
#pragma unroll
                for (int gg = 1; gg < 8; ++gg) v = (gsel == gg) ? acc[gg >> 2][4 * (gg & 3) + i] : v;
                em[i] = v * rstd; eo[i] = __shfl_xor(em[i], 32); }
#pragma unroll
            for (int i = 0; i < 4; ++i) { el[i] = h ? eo[i] : em[i]; el[4 + i] = h ? em[i] : eo[i]; }
            int i0 = 0; float l0 = el[0];
#pragma unroll
            for (int i = 1; i < 8; ++i) if (el[i] > l0) { l0 = el[i]; i0 = i; }
            int i1 = -1; float l1 = -INFINITY;
#pragma unroll
            for (int i = 0; i < 8; ++i) if (i != i0 && el[i] > l1) { l1 = el[i]; i1 = i; }
            const float e1 = expf(l1 - l0), g0 = pgrp / (1.0f + e1), g1 = pgrp * e1 / (1.0f + e1);
            es0 = gsel * 8 + i0; es1 = gsel * 8 + i1; gs0 = g0; gs1 = g1; rstd_s = rstd;
            if (h == 0) { lp0 = atomicAdd((unsigned*)(hist + es0), 1u); lp1 = atomicAdd((unsigned*)(hist + es1), 1u); }
        }
        __syncthreads();
        if (w == 0) { const unsigned n = hist[lane]; unsigned bs = 0u; if (n) bs = atomicAdd(&cnt[lane], n); hbase[lane] = bs; }
        __syncthreads();
        if (kh == 0 && h == 0) {
            const unsigned p0 = hbase[es0] + lp0, p1 = hbase[es1] + lp1;
            C.TE[row * 2] = es0; C.TP[row * 2] = (int)p0; C.LIST[(size_t)es0 * LISTCAP + p0] = row * 2; C.LG[(size_t)es0 * LISTCAP + p0] = gs0; C.LRS[(size_t)es0 * LISTCAP + p0] = rstd_s;
            C.TE[row * 2 + 1] = es1; C.TP[row * 2 + 1] = (int)p1; C.LIST[(size_t)es1 * LISTCAP + p1] = row * 2 + 1; C.LG[(size_t)es1 * LISTCAP + p1] = gs1; C.LRS[(size_t)es1 * LISTCAP + p1] = rstd_s;
        }
    }
    __syncthreads();
    TSTOP(60); TSTART(61);
    for (; cit < NREM; cit += NGW) moe_convert_item(C, rem_item(cit), scr);
    TSTOP(61);
}

struct MoeTab { int* cnt; int* pstart; int* tstart; };
__device__ __forceinline__ MoeTab moe_tables(Ctx& C, int off) {
    MoeTab T; T.cnt = (int*)(C.lds + off); T.pstart = T.cnt + 64; T.tstart = T.pstart + 65;
    __syncthreads();
    if (C.tid < 64) T.cnt[C.tid] = (int)__hip_atomic_load(C.ctl + CW_CNT + C.tid, __ATOMIC_RELAXED, __HIP_MEMORY_SCOPE_AGENT);
    __syncthreads();
    if (C.tid == 0) { int ps = 0, ts = 0; for (int e = 0; e < 64; ++e) { T.pstart[e] = ps; T.tstart[e] = ts; ps += ((T.cnt[e] + 255) >> 8) << 8; ts += (T.cnt[e] + 255) >> 8; } T.pstart[64] = ps; T.tstart[64] = ts; }
    __syncthreads();
    return T;
}

constexpr int MOE_TAB_OFF = 132096;
__device__ __forceinline__ void phase_moe_a(Ctx& C) {
    const MoeTab T = moe_tables(C, MOE_TAB_OFF);
    if (C.bid < NCONV) { conv_down_early(C); return; }
    const int G2 = C.G - NCONV, b2 = C.bid - NCONV, vcu2 = (G2 % 8 == 0) ? (b2 % 8) * (G2 / 8) + b2 / 8 : b2;
    pg8::MoeOrder<true> S{T.cnt, T.pstart, T.tstart, C.LIST, (const char*)C.WGU, (size_t)1024 * 1024 * 2, DM, 4, T.tstart[64], G2, vcu2};
    pg8::EpiHid E{C.HID, C.LIST, C.LRS, (LAS float*)((LAS unsigned char*)C.lds + 135168)};
    pg8::gemm_phase<pg8::EpiHid, pg8::MoeOrder<true>, true>((LAS unsigned char*)C.lds, (const char*)C.XN, DM, S, E);
}
__device__ __forceinline__ void phase_moe_b(Ctx& C) {
    const MoeTab T = moe_tables(C, MOE_TAB_OFF);
    pg8::MoeOrder<false> S{T.cnt, T.pstart, T.tstart, C.LIST, (const char*)C.WD, (size_t)1024 * FF * 2, FF, 4, T.tstart[64], C.G, C.vcu};
    pg8::EpiYb E{C.YB, C.LIST, C.LG, (LAS float*)((LAS unsigned char*)C.lds + 135168)};
    pg8::gemm_phase<pg8::EpiYb, pg8::MoeOrder<false>, true>((LAS unsigned char*)C.lds, (const char*)C.HID, FF, S, E);
}
__device__ __forceinline__ void phase_final(Ctx& C) {
    const MoeTab T = moe_tables(C, 0);
    const int gw = C.bid * NWAVES + C.wave, NGW = C.G * NWAVES;
    f32x4 hn[4], gfin[4]; u32x2 an[4], cn[4];
#pragma unroll
    for (int j = 0; j < 4; ++j) gfin[j] = ((const f32x4*)C.norm_final)[C.lane + 64 * j];
#define FIN_LOAD(r) do { const size_t s0_ = (size_t)T.pstart[C.TE[(r) * 2]] + C.TP[(r) * 2], s1_ = (size_t)T.pstart[C.TE[(r) * 2 + 1]] + C.TP[(r) * 2 + 1]; \
        _Pragma("unroll") for (int j = 0; j < 4; ++j) { { const u32x2 hb_ = ((const u32x2*)(C.XN + (size_t)(r) * DM) + C.lane)[64 * j]; hn[j][0] = bf2f(hb_.x); hn[j][1] = bf2f(hb_.x >> 16); hn[j][2] = bf2f(hb_.y); hn[j][3] = bf2f(hb_.y >> 16); } an[j] = ((const u32x2*)(C.YB + s0_ * DM) + C.lane)[64 * j]; cn[j] = ((const u32x2*)(C.YB + s1_ * DM) + C.lane)[64 * j]; } } while (0)
    for (int rb = C.bid; rb < M / 128; rb += C.G) {
        const int row0 = rb * 128 + C.wave * 16;
        FIN_LOAD(row0);
#pragma unroll
        for (int i = 0; i < 16; ++i) {
            const int row = row0 + i;
            f32x4 v[4]; u32x2 ya[4], yc[4];
#pragma unroll
            for (int j = 0; j < 4; ++j) { v[j] = hn[j]; ya[j] = an[j]; yc[j] = cn[j]; }
            FIN_LOAD(row0 + ((i + 1) & 15));
            float ss = 0.f;
#pragma unroll
            for (int j = 0; j < 4; ++j) { const u32x2 a = ya[j], c = yc[j];
                v[j][0] += bf2f(a.x) + bf2f(c.x); v[j][1] += bf2f(a.x >> 16) + bf2f(c.x >> 16); v[j][2] += bf2f(a.y) + bf2f(c.y); v[j][3] += bf2f(a.y >> 16) + bf2f(c.y >> 16);
                ss += v[j][0] * v[j][0] + v[j][1] * v[j][1] + v[j][2] * v[j][2] + v[j][3] * v[j][3]; }
            const float rstd = 1.0f / sqrtf(wave_sum(ss) * (1.0f / DM) + EPS);
            f32x4* hr = (f32x4*)(C.out + (size_t)row * DM) + C.lane;
#pragma unroll
            for (int j = 0; j < 4; ++j) hr[64 * j] = v[j] * rstd * gfin[j];
            __builtin_amdgcn_sched_barrier(0);
        }
    }
#undef FIN_LOAD
}

constexpr int NPHASE = 10;
__global__ void __launch_bounds__(NTHREADS, 2) fwd_kernel(Args args) {
    extern __shared__ __attribute__((aligned(16))) unsigned char lds[];
    Ctx C;
    C.tph0 = 0; C.tphd = 0;
    C.lds = lds; C.tid = threadIdx.x; C.lane = C.tid & 63; C.wave = __builtin_amdgcn_readfirstlane(C.tid >> 6); C.G = gridDim.x; C.bid = blockIdx.x;
    C.x = args.in[0]; C.norm_mix = args.in[1]; C.w_in = args.in[2]; C.conv_w = args.in[3]; C.conv_b = args.in[4]; C.dt_bias = args.in[5]; C.a_log = args.in[6]; C.d_skip = args.in[7];
    C.ssd_norm = args.in[8]; C.sinks = args.in[9]; C.attn_norm = args.in[10]; C.w_out = args.in[11]; C.norm_ffn = args.in[12]; C.w_rg = args.in[13]; C.w_re = args.in[14];
    C.w_gate = args.in[15]; C.w_up = args.in[16]; C.w_down = args.in[17]; C.norm_final = args.in[18];
    C.out = args.out; C.ws = args.ws;
    unsigned char* ws = args.ws;
    C.ctl = (unsigned*)(ws + WS_CTL);
    C.XN = (bf16*)(ws + WS_XN); C.DT = (float*)(ws + WS_DT); C.PROJ = (bf16*)(ws + WS_PROJ); C.HID = (bf16*)(ws + WS_HID); C.YB = (bf16*)(ws + WS_YB);
    C.ST = (bf16*)(ws + WS_ST); C.MIX = (bf16*)(ws + WS_MIX); C.CDEC = (float*)(ws + WS_CDEC); C.TE = (int*)(ws + WS_TE); C.TP = (int*)(ws + WS_TP); C.TG = (float*)(ws + WS_TG);
    C.LIST = (int*)(ws + WS_LIST); C.WIN = (bf16*)(ws + WS_WIN); C.WOUT = (bf16*)(ws + WS_WOUT); C.WGU = (bf16*)args.out;            C.WD = (bf16*)(ws + WS_WD); C.HALO = (bf16*)(ws + WS_HALO); C.WRH = (bf16*)(ws + WS_WRH); C.WRL = (bf16*)(ws + WS_WRL); C.RS = (float*)(ws + WS_RS); C.RATT = C.RS + M; C.RSG = C.RS + 2 * M; C.LRS = (float*)(ws + WS_WGU); C.LG = C.LRS + (size_t)NE * LISTCAP;
    C.vcu = (C.G % 8 == 0) ? (C.bid % 8) * (C.G / 8) + C.bid / 8 : C.bid;
    TSTART(9999);
    volatile LAS unsigned* MISC = (volatile LAS unsigned*)((LAS unsigned char*)lds + MISC_OFF);
    if (C.tid < 64) MISC[C.tid] = 0u;
    __syncthreads();
    XcdBarrier bar; bar.bar = C.ctl + CW_BAR; bar.x = 0; bar.st = nullptr;
#if ONE_LAUNCH
    bar = xcd_barrier_post(C.ctl + CW_BAR, MISC + 8);
#define GRID_BAR() xcd_barrier(bar)
#else
#define GRID_BAR() do {} while (0)
#endif
    const int lo = args.ph_lo, hi = args.ph_hi;
#define IN(k) (lo <= (k) && (k) < hi)
#define SEAM(k) do { if (IN(k) && IN((k) + 1)) GRID_BAR(); } while (0)
#define REP(k) for (int _rep = 0; _rep < ((k) == RPH ? 2 : 1); ++_rep)
    TSTART(0); if (IN(0)) { REP(0) phase_prologue(C); } SEAM(0); TSTOP(0);
    TSTART(1); if (IN(1)) { if (C.bid < NCONV) conv_gateup_early(C); else phase_gemm1(C); } SEAM(1); TSTOP(1);
    TSTART(2); if (IN(2)) { TSTART(20); for (int u = C.bid; u < NB * NCH * 2; u += C.G) ssd_states_fast(C, u); TSTOP(20); TSTART(21); REP(20) for (int u = C.bid; u < NB * 32; u += C.G) attn_unit_fast(C, u); TSTOP(21); } SEAM(2); TSTOP(2);
    TSTART(3); if (IN(3)) { phase_scan_fast(C); } SEAM(3); TSTOP(3);
    TSTART(4); if (IN(4)) { REP(4) for (int u = C.bid; u < NB * NCH * 2; u += C.G) ssd_out_fast(C, u); } SEAM(4); TSTOP(4);
    TSTART(5); if (IN(5)) { REP(5) phase_gemm2(C); } SEAM(5); TSTOP(5);
    TSTART(6); if (IN(6)) { phase_router_fast(C); } SEAM(6); TSTOP(6);
    TSTART(7); if (IN(7)) { REP(7) phase_moe_a(C); } SEAM(7); TSTOP(7);
    TSTART(8); if (IN(8)) { REP(8) phase_moe_b(C); } SEAM(8); TSTOP(8);
    TSTART(9); if (IN(9)) { phase_final(C); } TSTOP(9); TSTOP(9999);
#ifdef TPH
    if (C.tid == 0) { const unsigned long long te = __builtin_amdgcn_s_memrealtime(); while (__builtin_amdgcn_s_memrealtime() - te < C.tphd) __builtin_amdgcn_s_sleep(8); }
#endif
}

extern "C" void kernel_launch(void* const* d_in, const int* in_sizes, int n_in, void* d_out, int out_size, void* d_ws, size_t ws_size, hipStream_t stream) {
    static int grid = 0;
    if (grid == 0) {
        if (n_in != 19 || in_sizes[0] != M * DM || out_size != M * DM || ws_size < WS_END) { fprintf(stderr, "kernel_launch: unexpected shapes (n_in %d, in0 %d, out %d, ws %zu)\n", n_in, n_in > 0 ? in_sizes[0] : -1, out_size, ws_size); grid = -1; return; }
        int dev = 0, cus = 0, per_cu = 0;
        if (hipGetDevice(&dev) != hipSuccess || hipDeviceGetAttribute(&cus, hipDeviceAttributeMultiprocessorCount, dev) != hipSuccess) { grid = -1; return; }
        if (hipFuncSetAttribute((const void*)fwd_kernel, hipFuncAttributeMaxDynamicSharedMemorySize, LDS_BYTES) != hipSuccess) { fprintf(stderr, "kernel_launch: hipFuncSetAttribute failed\n"); grid = -1; return; }
        if (hipOccupancyMaxActiveBlocksPerMultiprocessor(&per_cu, (const void*)fwd_kernel, NTHREADS, LDS_BYTES) != hipSuccess || per_cu < 1) { fprintf(stderr, "kernel_launch: occupancy query says %d\n", per_cu); (void)hipGetLastError(); per_cu = 1; }
        grid = cus;
    }
    if (grid < 0) return;
    (void)hipMemsetAsync((char*)d_ws + WS_CTL, 0, CTL_BYTES, stream);
    Args a{};
    for (int i = 0; i < 19; ++i) a.in[i] = (const float*)d_in[i];
    a.out = (float*)d_out; a.ws = (unsigned char*)d_ws;
#if ONE_LAUNCH
    a.ph_lo = 0; a.ph_hi = NPHASE;
    hipLaunchKernelGGL(fwd_kernel, dim3(grid), dim3(NTHREADS), LDS_BYTES, stream, a);
#else
    for (int p = 0; p < NPHASE; ++p) { a.ph_lo = p; a.ph_hi = p + 1; hipLaunchKernelGGL(fwd_kernel, dim3(grid), dim3(NTHREADS), LDS_BYTES, stream, a); }
#endif
}
```

```cpp
#include <hip/hip_runtime.h>
#include <cstdio>
#include <cstdint>

#ifndef RPH
#define RPH -1
#endif
#ifndef ONE_LAUNCH
#define ONE_LAUNCH 1
#endif

#define LAS __attribute__((address_space(3)))
typedef unsigned short bf16;
typedef float f32x4 __attribute__((ext_vector_type(4)));
typedef unsigned u32x4 __attribute__((ext_vector_type(4)));
typedef unsigned u32x2 __attribute__((ext_vector_type(2)));

constexpr int NB = 8, SEQ = 4096, DM = 1024, M = NB * SEQ;
constexpr int INDIM = 3856;
constexpr int NPROJ = 3840;
constexpr int PZ = 0, PX = 1024, PQ = 2560, PK = 3584, PV = 3712;
constexpr int DT0 = 2560;
constexpr int CONVCH = 1536;
constexpr int NH = 16, HD = 64, NST = 128, CHK = 128, NCH = SEQ / CHK;
constexpr int NE = 64, FF = 512, LISTCAP = 32768;
constexpr int SLOT_MAX = 81920;
constexpr float EPS = 1e-6f;
constexpr int NCONV = 16, E1 = 14, E7 = 32;

constexpr size_t MiB = 1u << 20;
constexpr size_t WS_CTL = 0, CTL_BYTES = 1 * MiB;
constexpr size_t WS_XN = 1 * MiB;
constexpr size_t WS_DT = 65 * MiB;
constexpr size_t WS_PROJ = 67 * MiB;
constexpr size_t WS_HID = WS_PROJ;
constexpr size_t WS_YB = WS_PROJ + 80 * MiB;
constexpr size_t WS_ST = 307 * MiB;
constexpr size_t WS_MIX = 371 * MiB;
constexpr size_t WS_WGU = 307 * MiB;
constexpr size_t WS_WD = 435 * MiB;
constexpr size_t WS_WIN = 499 * MiB;
constexpr size_t WS_WOUT = 507 * MiB;
constexpr size_t WS_MISC = 511 * MiB;
constexpr size_t WS_CDEC = WS_MISC;
constexpr size_t WS_TE = WS_MISC + 1 * MiB;
constexpr size_t WS_TP = WS_TE + 256 * 1024;
constexpr size_t WS_TG = WS_TP + 256 * 1024;
constexpr size_t WS_LIST = WS_MISC + 2 * MiB;
constexpr size_t WS_HALO = WS_LIST + 8 * MiB;
constexpr size_t WS_WRH = WS_HALO + 3 * MiB;
constexpr size_t WS_WRL = WS_WRH + 256 * 1024;
constexpr size_t WS_RS = WS_WRL + 256 * 1024;
constexpr size_t WS_END = WS_RS + 512 * 1024;
constexpr int CW_BAR = 4096;
constexpr int CW_CNT = 8192;
constexpr int CW_TIME = 8448;

constexpr int NTHREADS = 512, NWAVES = 8;
constexpr int LDS_BYTES = 159744;
constexpr int MISC_OFF = LDS_BYTES - 256;

__device__ __forceinline__ unsigned f2bf(float f) { unsigned u = __builtin_bit_cast(unsigned, f); return (u + 0x7fffu + ((u >> 16) & 1u)) >> 16; }
__device__ __forceinline__ float bf2f(unsigned b) { return __builtin_bit_cast(float, (b & 0xffffu) << 16); }
__device__ __forceinline__ unsigned pk2(float lo, float hi) { return f2bf(lo) | (f2bf(hi) << 16); }
__device__ __forceinline__ float wave_sum(float v) {
#pragma unroll
    for (int o = 1; o < 64; o <<= 1) v += __shfl_xor(v, o);
    return v;
}
__device__ __forceinline__ float silu_f(float x) { return x * __builtin_amdgcn_rcpf(1.0f + __expf(-x)); }
__device__ __forceinline__ float softplus_f(float x) { return x > 20.f ? x : log1pf(expf(x)); }

typedef short bf16x8 __attribute__((ext_vector_type(8)));
typedef short s16x4 __attribute__((ext_vector_type(4)));
typedef float f32x16 __attribute__((ext_vector_type(16)));
typedef float f32x2_t __attribute__((ext_vector_type(2)));
typedef __bf16 bf16x2_t __attribute__((ext_vector_type(2)));
#define MFMA32(a, b, c) __builtin_amdgcn_mfma_f32_32x32x16_bf16((a), (b), (c), 0, 0, 0)
__device__ __forceinline__ unsigned cvtpk(float lo, float hi) { f32x2_t v = {lo, hi}; bf16x2_t b = __builtin_convertvector(v, bf16x2_t); return __builtin_bit_cast(unsigned, b); }
__device__ __forceinline__ s16x4 tr16(LAS const unsigned char* p) { return __builtin_bit_cast(s16x4, __builtin_amdgcn_ds_read_tr16_b64_v4i16((LAS s16x4*)p)); }
__device__ __forceinline__ bf16x8 cat8(s16x4 lo, s16x4 hi) { return __builtin_shufflevector(lo, hi, 0, 1, 2, 3, 4, 5, 6, 7); }
#define PACK8(x, o) __builtin_bit_cast(bf16x8, (u32x4){cvtpk((x)[(o)], (x)[(o) + 1]), cvtpk((x)[(o) + 2], (x)[(o) + 3]), cvtpk((x)[(o) + 4], (x)[(o) + 5]), cvtpk((x)[(o) + 6], (x)[(o) + 7])})

#define XB_TMO      128
#define XB_XCNT(j)  (256  + 64 * (j))
#define XB_XSUB(j)  (1280 + 64 * (j))
#define XB_XGEN(j)  (2304 + 64 * (j))
#define XB_TOP      3328
#define XB_TOPGEN   3392
#define XCD_BAR_WORDS 3456
#define XB_SPIN_CAP (1u << 27)
__device__ __forceinline__ unsigned xb_ld(unsigned* p)              { return __hip_atomic_load(p, __ATOMIC_RELAXED, __HIP_MEMORY_SCOPE_AGENT); }
__device__ __forceinline__ unsigned xb_add(unsigned* p, unsigned v) { return __hip_atomic_fetch_add(p, v, __ATOMIC_RELAXED, __HIP_MEMORY_SCOPE_AGENT); }
__device__ __forceinline__ unsigned xb_xcc_id() { return (unsigned)__builtin_amdgcn_s_getreg((3 << 11) | 20) & 0xFu; }
#define XB_SPIN(cond, bar) do { unsigned _sp = 0; while (cond) { __builtin_amdgcn_s_sleep(1); \
    if ((++_sp & 255u) == 0u) { if (xb_ld(&(bar)[XB_TMO])) break; if (_sp > XB_SPIN_CAP) { atomicAdd(&(bar)[XB_TMO], 1u); break; } } } } while (0)
struct XcdBarrier { unsigned* bar; unsigned x; volatile LAS unsigned* st; };
__device__ __forceinline__ XcdBarrier xcd_barrier_post(unsigned* bar, volatile LAS unsigned* st) {
    XcdBarrier b; b.bar = bar; b.x = xb_xcc_id(); b.st = st;
    if (threadIdx.x == 0) (void)xb_add(&bar[XB_XCNT(b.x)], 1u);
    return b;
}
__device__ __forceinline__ void xcd_barrier_complete(unsigned* bar, unsigned x, unsigned& nloc, unsigned& nx) {
    const unsigned G = gridDim.x * gridDim.y * gridDim.z;
    unsigned sum, cnt, mine, sp = 0u;
    for (;;) {
        sum = 0u; cnt = 0u; mine = 0u;
#pragma unroll
        for (unsigned j = 0; j < 16; ++j) { const unsigned c = xb_ld(&bar[XB_XCNT(j)]); sum += c; cnt += (c > 0u) ? 1u : 0u; mine = (j == x) ? c : mine; }
        if (sum == G) break;
        __builtin_amdgcn_s_sleep(1);
        if ((++sp & 255u) == 0u) { if (xb_ld(&bar[XB_TMO])) break; if (sp > XB_SPIN_CAP) { atomicAdd(&bar[XB_TMO], 1u); break; } }
    }
    nloc = mine > 0u ? mine : 1u; nx = cnt > 0u ? cnt : 1u;
}
__device__ __forceinline__ void xcd_barrier(const XcdBarrier& b) {
    asm volatile("s_waitcnt vmcnt(0)" ::: "memory");
    __syncthreads();
    if (threadIdx.x == 0) {
        unsigned* bar = b.bar;
        __builtin_amdgcn_s_waitcnt(0);
        unsigned nloc = b.st[0], nx = b.st[1];
        if (nloc == 0u) { xcd_barrier_complete(bar, b.x, nloc, nx); b.st[0] = nloc; b.st[1] = nx; }
        const unsigned old = xb_add(&bar[XB_XSUB(b.x)], 1u);
        const unsigned gen = old / nloc;
        if (old + 1u == (gen + 1u) * nloc) {
            __builtin_amdgcn_fence(__ATOMIC_RELEASE, "agent");
            asm volatile("s_waitcnt vmcnt(0)" ::: "memory");
            const unsigned og = xb_add(&bar[XB_TOP], 1u);
            const unsigned tg = og / nx;
            if (og + 1u == (tg + 1u) * nx) xb_add(&bar[XB_TOPGEN], 1u);
            else XB_SPIN(xb_ld(&bar[XB_TOPGEN]) == tg, bar);
            __builtin_amdgcn_fence(__ATOMIC_ACQUIRE, "agent");
            xb_add(&bar[XB_XGEN(b.x)], 1u);
            asm volatile("s_waitcnt vmcnt(0)" ::: "memory");
        } else {
            XB_SPIN(xb_ld(&bar[XB_XGEN(b.x)]) == gen, bar);
            __builtin_amdgcn_fence(__ATOMIC_ACQUIRE, "agent");
            asm volatile("s_waitcnt vmcnt(0)" ::: "memory");
        }
    }
    __syncthreads();
}

struct Args { const float* in[19]; float* out; unsigned char* ws; int ph_lo, ph_hi; };
#ifdef TPH
#define TSTART(k) do { if ((k) == TPH) C.tph0 = __builtin_amdgcn_s_memrealtime(); } while (0)
#define TSTOP(k) do { if ((k) == TPH) C.tphd += __builtin_amdgcn_s_memrealtime() - C.tph0; } while (0)
#else
#define TSTART(k) do {} while (0)
#define TSTOP(k) do {} while (0)
#endif
struct Ctx {
    unsigned long long tph0, tphd;
    unsigned char* lds; int tid, lane, wave, G, bid;
    const float *x, *norm_mix, *w_in, *conv_w, *conv_b, *dt_bias, *a_log, *d_skip, *ssd_norm, *sinks, *attn_norm, *w_out, *norm_ffn, *w_rg, *w_re, *w_gate, *w_up, *w_down, *norm_final;
    float* out; unsigned char* ws;
    bf16 *XN, *PROJ, *HID, *YB, *ST, *MIX, *WIN, *WOUT, *WGU, *WD, *HALO, *WRH, *WRL; float *RS, *RATT, *RSG, *LRS, *LG; int vcu; float *DT, *CDEC, *TG; int *TE, *TP, *LIST; unsigned* ctl;
};

namespace pg8 {
typedef short bf16x8 __attribute__((ext_vector_type(8)));
constexpr int BM = 256, BK = 64, HALF = 128, HTB = HALF * BK * 2, STAGE_BYTES = 8 * HTB, NXCD = 8, WGM = 8;
__device__ __forceinline__ int lds_byte(int r, int c) { const int st = (r >> 4) * 2 + (c >> 5), rr = r & 15, cc = c & 31, ob = rr * 64 + cc * 2; return st * 1024 + (ob ^ (((ob >> 9) & 1) << 5)); }
__device__ __forceinline__ void stage_rc(int b, int& R, int& C) { const int st = b / 1024, sb = b % 1024, swz = sb ^ (((sb >> 9) & 1) << 5); R = (st >> 1) * 16 + swz / 64; C = (st & 1) * 32 + (swz % 64) / 2; }
__device__ __forceinline__ int perm32(int rho) { const int n = rho >> 4, i = rho & 15; return 8 * (i >> 2) + 4 * n + (i & 3); }
__device__ __forceinline__ unsigned cvt_pk_bf16(float lo, float hi) { unsigned r; asm volatile("v_cvt_pk_bf16_f32 %0, %1, %2" : "=v"(r) : "v"(lo), "v"(hi)); return r; }

struct Unit { int pm, pn, e, mt, rowbase, cnt, par; const char* bt; };

struct DenseOrder {
    int nM, nN, nwg, G, c, K; const char* Bt;
    __device__ void init(int M, int N, int K_, const bf16* Bt_, int G_, int c_) { nM = M / BM; nN = N / BM; nwg = nM * nN; G = G_; c = c_; K = K_; Bt = (const char*)Bt_; }
    __device__ __forceinline__ bool next(int i, Unit& u) const {
        const long L = (long)i * G + c; if (L >= nwg) return false;
        int wgid = (int)L; { const int q = nwg / NXCD, r = nwg % NXCD, xcd = wgid % NXCD, off = wgid / NXCD; wgid = (xcd < r ? xcd * (q + 1) : r * (q + 1) + (xcd - r) * q) + off; }
        const int nig = WGM * nN, gid = wgid / nig, fm = gid * WGM, gsz = (nM - fm) < WGM ? (nM - fm) : WGM;
        u.pm = fm + ((wgid % nig) % gsz); u.pn = (wgid % nig) / gsz; u.e = 0; u.mt = 0; u.rowbase = u.pm * BM; u.cnt = BM;
        u.bt = Bt + (size_t)u.pn * BM * K * 2; return true;
    }
    __device__ __forceinline__ unsigned arow(const Unit& u, int R) const { return (unsigned)(u.rowbase + R); }
};
template <bool GATHER> struct MoeOrder {
    const int *cnt, *pstart, *tstart; const int* LIST; const char* W; size_t wstride; int K, npn, ntiles, G, c;
    __device__ __forceinline__ bool next(int i, Unit& u) const {
        const long L = (long)i * G + c; if (L >= (long)ntiles * npn) return false;
        const int tile = (int)(L / npn); u.pn = (int)(L % npn); u.pm = tile;
        int e = 0; while (tstart[e + 1] <= tile) ++e;
        u.e = e; u.mt = tile - tstart[e]; u.rowbase = pstart[e] + u.mt * BM; u.cnt = cnt[e];
        u.bt = W + (size_t)e * wstride + (size_t)u.pn * BM * K * 2; return true;
    }
    __device__ __forceinline__ unsigned arow(const Unit& u, int R) const {
        if (GATHER) { const int pos = u.mt * BM + R; return pos < u.cnt ? (unsigned)(LIST[(size_t)u.e * LISTCAP + pos] >> 1) : 0u; }
        return (unsigned)(u.rowbase + R);
    }
};

struct EpiProj {
    static constexpr bool PERM = true, KSEG = false, UBEGIN = false; bf16* O; int ldc; bf16* HALO;
    __device__ __forceinline__ void operator()(const f32x4 (&acc)[2][2][4][2], const Unit& u, int wr, int wc, int fr, int fq) const {
        bf16* base = O + (size_t)(u.pm * BM + wr * 64 + fr) * ldc + u.pn * BM + wc * 32 + 8 * fq;
#pragma unroll
        for (int ai = 0; ai < 2; ++ai)
#pragma unroll
            for (int m = 0; m < 4; ++m) { bf16* rowp = base + (size_t)(ai * HALF + m * 16) * ldc;
#pragma unroll
                for (int bj = 0; bj < 2; ++bj) { const f32x4 v0 = acc[ai][bj][m][0], v1 = acc[ai][bj][m][1];
                    u32x4 w; w.x = cvt_pk_bf16(v0[0], v0[1]); w.y = cvt_pk_bf16(v0[2], v0[3]); w.z = cvt_pk_bf16(v1[0], v1[1]); w.w = cvt_pk_bf16(v1[2], v1[3]);
                    *(u32x4*)(rowp + bj * HALF) = w;
                    if (m == 3 && wr == 1 && fr >= 13 && u.pn >= 4 && u.pn < 10) {
                        const int row = u.pm * BM + ai * HALF + 125 + (fr - 13), col = u.pn * BM + bj * HALF + wc * 32 + 8 * fq - 1024;
                        *(u32x4*)(HALO + ((size_t)(row >> 7) * 3 + (fr - 13)) * CONVCH + col) = w; } } }
    }
};
struct EpiResid {
    static constexpr bool PERM = true, KSEG = true, UBEGIN = true; const float* base; float* out; bf16* HB; const float* RSG; const float* RATT; LAS float* tab;
    __device__ __forceinline__ f32x4 unit_fetch(const Unit& u) const {
        const int tid = threadIdx.x; f32x4 r = (f32x4){1.f, 1.f, 1.f, 0.f};
        if (tid < 256) { const size_t row = (size_t)(u.pm * BM + tid); r[0] = RSG[row * 2]; r[1] = RSG[row * 2 + 1]; r[2] = RATT[row]; }
        return r;
    }
    __device__ __forceinline__ void unit_commit(const Unit& u, const f32x4 r) const {
        const int tid = threadIdx.x;
        if (tid < 256) { LAS float* tb = tab + u.par * 768; tb[tid] = r[0] * __builtin_amdgcn_rcpf(r[1]); tb[256 + tid] = r[1] * __builtin_amdgcn_rcpf(r[2]); tb[512 + tid] = r[2]; }
    }
    __device__ __forceinline__ void kseg(f32x4 (&acc)[2][2][4][2], const Unit& u, int t, int wr, int fr) const {
        const LAS float* tb = tab + u.par * 768 + (t == 8 ? 0 : 256) + wr * 64 + fr;
#pragma unroll
        for (int ai = 0; ai < 2; ++ai)
#pragma unroll
            for (int m = 0; m < 4; ++m) { const float rt = tb[ai * HALF + m * 16];
#pragma unroll
                for (int bj = 0; bj < 2; ++bj)
#pragma unroll
                    for (int n = 0; n < 2; ++n) acc[ai][bj][m][n] *= rt; }
    }
    __device__ __forceinline__ void operator()(const f32x4 (&acc)[2][2][4][2], const Unit& u, int wr, int wc, int fr, int fq) const {
        const size_t o0 = (size_t)(u.pm * BM + wr * 64 + fr) * DM + u.pn * BM + wc * 32 + 8 * fq;
#pragma unroll
        for (int ai = 0; ai < 2; ++ai) {
            f32x4 bv[4][2][2];
#pragma unroll
            for (int m = 0; m < 4; ++m)
#pragma unroll
                for (int bj = 0; bj < 2; ++bj)
#pragma unroll
                    for (int n = 0; n < 2; ++n) bv[m][bj][n] = *(const f32x4*)(base + o0 + (size_t)(ai * HALF + m * 16) * DM + bj * HALF + n * 4);
            __builtin_amdgcn_sched_barrier(0);
#pragma unroll
            for (int m = 0; m < 4; ++m)
#pragma unroll
                for (int bj = 0; bj < 2; ++bj) { const size_t off = o0 + (size_t)(ai * HALF + m * 16) * DM + bj * HALF;
                    const float sl = tab[u.par * 768 + 512 + ai * HALF + wr * 64 + m * 16 + fr];
                    const f32x4 v0 = bv[m][bj][0] + acc[ai][bj][m][0] * sl, v1 = bv[m][bj][1] + acc[ai][bj][m][1] * sl;
                    u32x4 w; w.x = cvt_pk_bf16(v0[0], v0[1]); w.y = cvt_pk_bf16(v0[2], v0[3]); w.z = cvt_pk_bf16(v1[0], v1[1]); w.w = cvt_pk_bf16(v1[2], v1[3]);
                    *(u32x4*)(HB + off) = w; }
            __builtin_amdgcn_sched_barrier(0);
        }
    }
};
struct EpiHid {
    static constexpr bool PERM = true, KSEG = false, UBEGIN = true; bf16* HID; const int* LIST; const float* RS; LAS float* tab;
    __device__ __forceinline__ f32x4 unit_fetch(const Unit& u) const {
        const int tid = threadIdx.x; f32x4 r = (f32x4){0.f, 0.f, 0.f, 0.f};
        if (tid < 256) { const int pos = u.mt * BM + tid; if (pos < u.cnt) r[0] = RS[(size_t)u.e * LISTCAP + pos]; }
        return r;
    }
    __device__ __forceinline__ void unit_commit(const Unit& u, const f32x4 r) const { const int tid = threadIdx.x; if (tid < 256) tab[u.par * 256 + tid] = r[0]; }
    __device__ __forceinline__ void operator()(const f32x4 (&acc)[2][2][4][2], const Unit& u, int wr, int wc, int fr, int fq) const {
        bf16* base = HID + (size_t)(u.rowbase + wr * 64 + fr) * FF + u.pn * 128 + wc * 32 + 8 * fq;
#pragma unroll
        for (int ai = 0; ai < 2; ++ai)
#pragma unroll
            for (int m = 0; m < 4; ++m) { f32x4 h0, h1; const int pos = u.mt * BM + ai * HALF + wr * 64 + m * 16 + fr;
                const float rs = tab[u.par * 256 + ai * HALF + wr * 64 + m * 16 + fr]; (void)pos;
#pragma unroll
                for (int i = 0; i < 4; ++i) { h0[i] = silu_f(rs * acc[ai][0][m][0][i]) * (rs * acc[ai][1][m][0][i]); h1[i] = silu_f(rs * acc[ai][0][m][1][i]) * (rs * acc[ai][1][m][1][i]); }
                u32x4 w; w.x = cvt_pk_bf16(h0[0], h0[1]); w.y = cvt_pk_bf16(h0[2], h0[3]); w.z = cvt_pk_bf16(h1[0], h1[1]); w.w = cvt_pk_bf16(h1[2], h1[3]);
                *(u32x4*)(base + (size_t)(ai * HALF + m * 16) * FF) = w; }
    }
};
struct EpiYb {
    static constexpr bool PERM = true, KSEG = false, UBEGIN = true; bf16* YB; const int* LIST; const float* TG; LAS float* tab;
    __device__ __forceinline__ f32x4 unit_fetch(const Unit& u) const {
        const int tid = threadIdx.x; f32x4 r = (f32x4){0.f, 0.f, 0.f, 0.f};
        if (tid < 256) { const int pos = u.mt * BM + tid; if (pos < u.cnt) r[0] = TG[(size_t)u.e * LISTCAP + pos]; }
        return r;
    }
    __device__ __forceinline__ void unit_commit(const Unit& u, const f32x4 r) const { const int tid = threadIdx.x; if (tid < 256) tab[u.par * 256 + tid] = r[0]; }
    __device__ __forceinline__ void operator()(const f32x4 (&acc)[2][2][4][2], const Unit& u, int wr, int wc, int fr, int fq) const {
        bf16* base = YB + (size_t)(u.rowbase + wr * 64 + fr) * DM + u.pn * BM + wc * 32 + 8 * fq;
#pragma unroll
        for (int ai = 0; ai < 2; ++ai)
#pragma unroll
            for (int m = 0; m < 4; ++m) { const int pos = u.mt * BM + ai * HALF + wr * 64 + m * 16 + fr;
                const float gt = tab[u.par * 256 + ai * HALF + wr * 64 + m * 16 + fr]; (void)pos;
#pragma unroll
                for (int bj = 0; bj < 2; ++bj) { const f32x4 v0 = acc[ai][bj][m][0] * gt, v1 = acc[ai][bj][m][1] * gt;
                    u32x4 w; w.x = cvt_pk_bf16(v0[0], v0[1]); w.y = cvt_pk_bf16(v0[2], v0[3]); w.z = cvt_pk_bf16(v1[0], v1[1]); w.w = cvt_pk_bf16(v1[2], v1[3]);
                    *(u32x4*)(base + (size_t)(ai * HALF + m * 16) * DM + bj * HALF) = w; } }
    }
};

template <class Epi, class Sched, bool ALIGN_EPI>
__device__ __forceinline__ void gemm_phase(LAS unsigned char* lds, const char* Abase, const int K, const Sched& S, const Epi& E) {
    const int tid = threadIdx.x, wid = __builtin_amdgcn_readfirstlane(tid >> 6), lane = tid & 63, wr = wid >> 2, wc = wid & 3, fr = lane & 15, fq = lane >> 4;
    const int nt = K / BK;
    int Rp[2], Cp[2]; unsigned voffB[2];
#pragma unroll
    for (int i = 0; i < 2; ++i) { int R, C; stage_rc(tid * 16 + i * 8192, R, C); Rp[i] = R; Cp[i] = C; const int Rb = Epi::PERM ? ((R & ~31) + perm32(R & 31)) : R; voffB[i] = (unsigned)(Rb * K + C) * 2u; }
    const size_t kstep = (size_t)(BK * 2);
    const size_t hstep = (size_t)HALF * K * 2;
    const unsigned ldsw = (unsigned)wid * 1024u;
    const int aoff = lds_byte(wr * 64 + fr, fq * 8), boff = lds_byte(wc * 32 + fr, fq * 8);
#define PG8_SA(b, h) (((b) * 2 + (h)) * HTB)
#define PG8_SB(b, h) ((4 + (b) * 2 + (h)) * HTB)
#define PG8_STAGE(bufoff, gbase, voff) do { _Pragma("unroll") for (int _i = 0; _i < 2; ++_i) \
        __builtin_amdgcn_global_load_lds((const unsigned*)((const char*)(gbase) + (voff)[_i]), (LAS unsigned*)(lds + (bufoff) + ldsw + _i * 8192), 16, 0, 0); } while (0)
#define PG8_LDA(dst, b, h) do { _Pragma("unroll") for (int m = 0; m < 4; ++m) _Pragma("unroll") for (int k = 0; k < 2; ++k) dst[m][k] = *(const LAS bf16x8*)(lds + PG8_SA(b, h) + aoff + m * 2048 + k * 1024); } while (0)
#define PG8_LDB(dst, b, h) do { _Pragma("unroll") for (int n = 0; n < 2; ++n) _Pragma("unroll") for (int k = 0; k < 2; ++k) dst[n][k] = *(const LAS bf16x8*)(lds + PG8_SB(b, h) + boff + n * 2048 + k * 1024); } while (0)
#define PG8_MMA(ai, bj, At, Bt) do { __builtin_amdgcn_s_setprio(1); _Pragma("unroll") for (int m = 0; m < 4; ++m) _Pragma("unroll") for (int n = 0; n < 2; ++n) _Pragma("unroll") for (int k = 0; k < 2; ++k) \
        acc[ai][bj][m][n] = __builtin_amdgcn_mfma_f32_16x16x32_bf16(Bt[n][k], At[m][k], acc[ai][bj][m][n], 0, 0, 0); __builtin_amdgcn_s_setprio(0); } while (0)
#define PG8_WAIT_V(n) asm volatile("s_waitcnt vmcnt(" #n ")" ::: "memory")
#define PG8_WAIT_L(n) asm volatile("s_waitcnt lgkmcnt(" #n ")" ::: "memory")
#define PG8_BAR __builtin_amdgcn_s_barrier()
#define PG8_SCHED __builtin_amdgcn_sched_barrier(0)
#define PG8_OFFS(dst, un) do { _Pragma("unroll") for (int _h = 0; _h < 2; ++_h) _Pragma("unroll") for (int _i = 0; _i < 2; ++_i) \
        dst[_h][_i] = (S.arow(un, _h * HALF + Rp[_i]) * (unsigned)K + (unsigned)Cp[_i]) * 2u; } while (0)
    Unit cur, nxt; int ui = 0;
    if (!S.next(0, cur)) return;
    f32x4 acc[2][2][4][2];
#pragma unroll
    for (int a = 0; a < 2; ++a)
#pragma unroll
        for (int b = 0; b < 2; ++b)
#pragma unroll
            for (int m = 0; m < 4; ++m)
#pragma unroll
                for (int n = 0; n < 2; ++n) acc[a][b][m][n] = (f32x4){0.f, 0.f, 0.f, 0.f};
    bf16x8 At[4][2], B0[2][2], B1[2][2];
    unsigned co[2][2], no[2][2];
    cur.par = 0;
    if constexpr (Epi::UBEGIN) E.unit_commit(cur, E.unit_fetch(cur));
    PG8_OFFS(co, cur);
    const char* cB = cur.bt;
    PG8_STAGE(PG8_SB(0, 0), cB, voffB); PG8_STAGE(PG8_SB(0, 1), cB + hstep, voffB); PG8_STAGE(PG8_SA(0, 0), Abase, co[0]); PG8_STAGE(PG8_SA(0, 1), Abase, co[1]);
    if (wr == 1) PG8_BAR;
    PG8_WAIT_V(2); PG8_BAR;
    PG8_STAGE(PG8_SB(1, 0), cB + kstep, voffB); PG8_STAGE(PG8_SA(1, 0), Abase + kstep, co[0]); PG8_STAGE(PG8_SB(1, 1), cB + hstep + kstep, voffB);
    PG8_WAIT_V(6); PG8_BAR;
    for (;;) {
        const bool has_next = S.next(ui + 1, nxt);
        nxt.par = (ui + 1) % 3;
        f32x4 pend = (f32x4){0.f, 0.f, 0.f, 0.f};
        if constexpr (Epi::UBEGIN) { if (has_next) pend = E.unit_fetch(nxt); }
        if (has_next) { PG8_OFFS(no, nxt); } else {
#pragma unroll
            for (int h = 0; h < 2; ++h) { no[h][0] = co[h][0]; no[h][1] = co[h][1]; } }
        const char* nB = has_next ? nxt.bt : cB;
        for (int t = 0; t < nt; t += 2) {
            const bool last = (t == nt - 2);
            const char* a1 = Abase + (size_t)(t + 1) * kstep;
            const char* a2 = last ? Abase : Abase + (size_t)(t + 2) * kstep; const char* b2 = last ? nB : cB + (size_t)(t + 2) * kstep;
            const char* a3 = a2 + kstep; const char* b3 = b2 + kstep;
            unsigned s2[2][2];
#pragma unroll
            for (int h = 0; h < 2; ++h) { s2[h][0] = last ? no[h][0] : co[h][0]; s2[h][1] = last ? no[h][1] : co[h][1]; }
            if constexpr (Epi::KSEG) { if (t == 8 || t == 16) E.kseg(acc, cur, t, wr, fr); }
            PG8_LDB(B0, 0, 0); PG8_LDB(B1, 0, 1); PG8_SCHED; PG8_LDA(At, 0, 0); PG8_STAGE(PG8_SA(1, 1), a1, co[1]);
            PG8_WAIT_V(8); PG8_WAIT_L(0); PG8_BAR; PG8_MMA(0, 0, At, B0); PG8_MMA(0, 1, At, B1); PG8_BAR; PG8_SCHED;
            PG8_LDA(At, 0, 1); PG8_STAGE(PG8_SB(0, 0), b2, voffB); PG8_STAGE(PG8_SB(0, 1), b2 + hstep, voffB); PG8_STAGE(PG8_SA(0, 0), a2, s2[0]);
            PG8_WAIT_V(8); PG8_WAIT_L(0); PG8_BAR; PG8_MMA(1, 0, At, B0); PG8_MMA(1, 1, At, B1); PG8_BAR; PG8_SCHED;
            PG8_LDB(B0, 1, 0); PG8_LDB(B1, 1, 1); PG8_SCHED; PG8_LDA(At, 1, 0); PG8_STAGE(PG8_SA(0, 1), a2, s2[1]);
            PG8_WAIT_V(8); PG8_WAIT_L(0); PG8_BAR; PG8_MMA(0, 0, At, B0); PG8_MMA(0, 1, At, B1); PG8_BAR; PG8_SCHED;
            PG8_LDA(At, 1, 1); PG8_STAGE(PG8_SB(1, 0), b3, voffB); PG8_STAGE(PG8_SB(1, 1), b3 + hstep, voffB); PG8_STAGE(PG8_SA(1, 0), a3, s2[0]);
            PG8_WAIT_V(8); PG8_WAIT_L(0); PG8_BAR; PG8_MMA(1, 0, At, B0); PG8_MMA(1, 1, At, B1); PG8_BAR; PG8_SCHED;
        }
        if constexpr (ALIGN_EPI) { if (wr == 0) PG8_BAR; }
        E(acc, cur, wr, wc, fr, fq);
        if (!has_next) break;
        if constexpr (Epi::UBEGIN) E.unit_commit(nxt, pend);
#pragma unroll
        for (int a = 0; a < 2; ++a)
#pragma unroll
            for (int b = 0; b < 2; ++b)
#pragma unroll
                for (int m = 0; m < 4; ++m)
#pragma unroll
                    for (int n = 0; n < 2; ++n) acc[a][b][m][n] = (f32x4){0.f, 0.f, 0.f, 0.f};
        cur = nxt; cB = nB; ++ui;
#pragma unroll
        for (int h = 0; h < 2; ++h) { co[h][0] = no[h][0]; co[h][1] = no[h][1]; }
        if constexpr (ALIGN_EPI) { if (wr == 1) PG8_BAR; }
    }
    PG8_WAIT_V(0);
    if constexpr (!ALIGN_EPI) { if (wr == 0) PG8_BAR; }
    PG8_BAR;
#undef PG8_SA
#undef PG8_SB
#undef PG8_STAGE
#undef PG8_LDA
#undef PG8_LDB
#undef PG8_MMA
#undef PG8_WAIT_V
#undef PG8_WAIT_L
#undef PG8_BAR
#undef PG8_SCHED
#undef PG8_OFFS
}
}

__device__ __forceinline__ void transpose_load(const float* W, int ldw, int k0, int n0, int lane, const float* kscale, float (&tv)[32], f32x4 (&ks)[2]) {
#pragma unroll
    for (int i = 0; i < 32; ++i) { const int kk = 2 * i + (lane >> 5); tv[i] = W[(size_t)(k0 + kk) * ldw + n0 + (lane & 31)]; }
    ks[0] = (f32x4){1.f, 1.f, 1.f, 1.f}; ks[1] = ks[0];
    if (kscale) { ks[0] = *(const f32x4*)(kscale + k0 + 8 * (lane & 7)); ks[1] = *(const f32x4*)(kscale + k0 + 8 * (lane & 7) + 4); }
}
__device__ __forceinline__ void transpose_store(const float (&tv)[32], const f32x4 (&ks)[2], bf16* WT, int K, int drow0, int k0, LAS float* scr, int lane) {
#pragma unroll
    for (int i = 0; i < 32; ++i) { const int kk = 2 * i + (lane >> 5); scr[kk * 33 + (lane & 31)] = tv[i]; }
    asm volatile("s_waitcnt lgkmcnt(0)" ::: "memory");
    const int c = lane & 7;
#pragma unroll
    for (int j = 0; j < 4; ++j) { const int n = (lane >> 3) + 8 * j; const LAS float* s = scr + (8 * c) * 33 + n;
        u32x4 o; o.x = pk2(s[0 * 33] * ks[0][0], s[1 * 33] * ks[0][1]); o.y = pk2(s[2 * 33] * ks[0][2], s[3 * 33] * ks[0][3]); o.z = pk2(s[4 * 33] * ks[1][0], s[5 * 33] * ks[1][1]); o.w = pk2(s[6 * 33] * ks[1][2], s[7 * 33] * ks[1][3]);
        *(u32x4*)(WT + (size_t)(drow0 + n) * K + k0 + 8 * c) = o; }
    asm volatile("s_waitcnt lgkmcnt(0)" ::: "memory");
}
__device__ __forceinline__ void transpose_item(const float* W, int ldw, int k0, int n0, bf16* WT, int K, int drow0, LAS float* scr, int lane, const float* kscale = nullptr) {
    float tv[32]; f32x4 ks[2];
    transpose_load(W, ldw, k0, n0, lane, kscale, tv, ks);
    transpose_store(tv, ks, WT, K, drow0, k0, scr, lane);
}

__device__ __forceinline__ void phase_prologue(Ctx& C) {
    constexpr int WRS = 2064;
    TSTART(1000);
    LAS unsigned char* WH = (LAS unsigned char*)C.lds;
    LAS unsigned char* WLo = WH + 33024;
    LAS float* PD = (LAS float*)(WH + 66048);
    {   float wv[32];
#pragma unroll
        for (int i = 0; i < 32; ++i) { const int idx = C.tid + NTHREADS * i, kk = idx >> 4, j = idx & 15; wv[i] = C.w_in[(size_t)kk * INDIM + DT0 + j]; }
#pragma unroll
        for (int i = 0; i < 32; ++i) { const int idx = C.tid + NTHREADS * i, kk = idx >> 4, j = idx & 15; const float v = wv[i];
            const unsigned hi = f2bf(v); *(LAS bf16*)(WH + j * WRS + kk * 2) = (bf16)hi; *(LAS bf16*)(WLo + j * WRS + kk * 2) = (bf16)f2bf(v - bf2f(hi)); } }
    __syncthreads();
    TSTOP(1000); TSTART(1001);
    const int gw = C.bid * NWAVES + C.wave, NGW = C.G * NWAVES;
    const int lane = C.lane, r32 = lane & 31, h = lane >> 5, w = C.wave, tt = w & 3, kh = w >> 2;
    for (int rb = C.bid; rb < M / 128; rb += C.G) {
        const int row0 = rb * 128 + w;
        f32x4 gn[4], ring[4][4];
#pragma unroll
        for (int j = 0; j < 4; ++j) gn[j] = ((const f32x4*)C.norm_mix)[lane + 64 * j];
#pragma unroll
        for (int s = 0; s < 4; ++s)
#pragma unroll
            for (int j = 0; j < 4; ++j) ring[s][j] = ((const f32x4*)(C.x + (size_t)(row0 + 8 * s) * DM) + lane)[64 * j];
#pragma unroll
        for (int i = 0; i < 16; ++i) {
            const int row = row0 + 8 * i;
            f32x4 v[4];
#pragma unroll
            for (int j = 0; j < 4; ++j) v[j] = ring[i & 3][j];
            if (i + 4 < 16) {
#pragma unroll
                for (int j = 0; j < 4; ++j) ring[i & 3][j] = ((const f32x4*)(C.x + (size_t)(row + 32) * DM) + lane)[64 * j];
            }
            float ss = 0.f;
#pragma unroll
            for (int j = 0; j < 4; ++j) ss += v[j][0] * v[j][0] + v[j][1] * v[j][1] + v[j][2] * v[j][2] + v[j][3] * v[j][3];
            const float rstd = 1.0f / sqrtf(wave_sum(ss) * (1.0f / DM) + EPS);
            u32x2* o = (u32x2*)(C.XN + (size_t)row * DM) + lane;
#pragma unroll
            for (int j = 0; j < 4; ++j) { const f32x4 g = gn[j]; v[j] = v[j] * rstd * g; u32x2 wv; wv.x = cvtpk(v[j][0], v[j][1]); wv.y = cvtpk(v[j][2], v[j][3]); o[64 * j] = wv; }
            __builtin_amdgcn_sched_barrier(0);
        }
        __syncthreads();
        TSTOP(1001); TSTART(1002);
        f32x16 acc;
#pragma unroll
        for (int r = 0; r < 16; ++r) acc[r] = 0.f;
        const bf16* xp = C.XN + (size_t)(rb * 128 + 32 * tt + r32) * DM + 512 * kh + 8 * h;
        LAS const unsigned char* wa = WH + (lane & 15) * WRS + (512 * kh + 8 * h) * 2;
#pragma unroll 1
        for (int kb = 0; kb < 4; ++kb) {
            bf16x8 xf[8];
#pragma unroll
            for (int i = 0; i < 8; ++i) xf[i] = *(const bf16x8*)(xp + (kb * 8 + i) * 16);
            __builtin_amdgcn_sched_barrier(0);
#pragma unroll
            for (int i = 0; i < 8; ++i) { const bf16x8 ah = *(LAS const bf16x8*)(wa + (kb * 8 + i) * 32), al = *(LAS const bf16x8*)(wa + 33024 + (kb * 8 + i) * 32);
                acc = MFMA32(ah, xf[i], acc); acc = MFMA32(al, xf[i], acc); }
            __builtin_amdgcn_sched_barrier(0);
        }
        if (kh == 1) {
#pragma unroll
            for (int r = 0; r < 8; ++r) PD[(tt * 8 + r) * 64 + lane] = acc[r];
        }
        __syncthreads();
        if (kh == 0) {
#pragma unroll
            for (int r = 0; r < 8; ++r) { const int col = (r & 3) + 8 * (r >> 2) + 4 * h;
                const float dv = acc[r] + PD[(tt * 8 + r) * 64 + lane] + C.dt_bias[col];
                C.DT[(size_t)(rb * 128 + 32 * tt + r32) * 16 + col] = softplus_f(dv); }
        }
        __syncthreads();
    }
    TSTOP(1002); TSTART(1003);
    __syncthreads();
    for (int idx = C.bid * NTHREADS + C.tid; idx < 96 * 1024; idx += C.G * NTHREADS) {
        const int e = idx >> 10, kk = idx & 1023;
        float v = 0.f; if (e < 64) v = C.w_re[kk * 64 + e]; else if (e < 72) v = C.w_rg[kk * 8 + (e - 64)];
        v *= C.norm_ffn[kk];
        const unsigned hi = f2bf(v); C.WRH[idx] = (bf16)hi; C.WRL[idx] = (bf16)f2bf(v - bf2f(hi));
    }
    LAS float* scr = (LAS float*)((LAS unsigned char*)C.lds + C.wave * 8704);
    for (int it = gw; it < 1920 + 1024; it += NGW) {
        if (it < 1920) { const int kb = it / 120, nb = it % 120, n0 = nb * 32; transpose_item(C.w_in, INDIM, kb * 64, n0 < DT0 ? n0 : n0 + 16, C.WIN, DM, n0, scr, C.lane); }
        else { const int r = it - 1920, kb = r >> 5, nb = r & 31; transpose_item(C.w_out, DM, kb * 64, nb * 32, C.WOUT, 2048, nb * 32, scr, C.lane, kb < 16 ? C.ssd_norm : C.attn_norm - 1024); }
    }
    TSTOP(1003);
}

__device__ __forceinline__ void phase_gemm1(Ctx& C) {
    pg8::DenseOrder S; S.init(M, NPROJ, DM, C.WIN, C.G - NCONV, C.bid - NCONV);
    pg8::EpiProj E{C.PROJ, NPROJ, C.HALO};
    pg8::gemm_phase<pg8::EpiProj, pg8::DenseOrder, true>((LAS unsigned char*)C.lds, (const char*)C.XN, DM, S, E);
}

constexpr int KRS = 144, VRS = 192;
__device__ __forceinline__ void attn_unit_fast(Ctx& C, int u) {
    const int blk = u & 31, b = u >> 5, t0 = blk * 128;
    LAS unsigned char* L = (LAS unsigned char*)C.lds;
    LAS unsigned char* Kimg = L;
    LAS unsigned char* Vimg = L + 36864;
    LAS float* ssq = (LAS float*)(L + 86016);
    LAS float* rsv = ssq + 16 * 128;
    const int lane = C.lane, r32 = lane & 31, h = lane >> 5, q4 = (lane & 15) >> 2, p4 = lane & 3, b16 = (lane >> 4) & 1;
    const float c2 = 0.125f * 1.4426950408889634f;
    for (int kv = 0; kv < 2; ++kv) {
        TSTART(210);
        __syncthreads();
#pragma unroll
        for (int i = 0; i < 4; ++i) {
            const int idx = C.tid + NTHREADS * i, row = idx >> 3, ch = idx & 7, t = t0 - 128 + row;
            u32x4 kk = (u32x4){0u, 0u, 0u, 0u}, vv = (u32x4){0u, 0u, 0u, 0u};
            if (t >= 0) { const bf16* pr = C.PROJ + (size_t)(b * SEQ + t) * NPROJ; kk = *(const u32x4*)(pr + PK + kv * 64 + ch * 8); vv = *(const u32x4*)(pr + PV + kv * 64 + ch * 8); }
            *(LAS u32x4*)(Kimg + row * KRS + ch * 16) = kk; *(LAS u32x4*)(Vimg + row * VRS + ch * 16) = vv;
        }
        __syncthreads();
        TSTOP(210);
        const int hq = kv * 8 + C.wave;
        const float sink2 = C.sinks[hq] * 1.4426950408889634f;
        const bf16* qbase = C.PROJ + (size_t)(b * SEQ + t0 + r32) * NPROJ + PQ + hq * 64 + 8 * h;
        bf16x8 qf[4], qn[4];
#pragma unroll
        for (int d0 = 0; d0 < 4; ++d0) { qf[d0] = *(const bf16x8*)(qbase + 16 * d0); qn[d0] = qf[d0]; }
        for (int rb = 0; rb < 4; ++rb) {
            const int qi = 32 * rb + r32;
            if (rb < 3) {
#pragma unroll
                for (int d0 = 0; d0 < 4; ++d0) qn[d0] = *(const bf16x8*)(qbase + (size_t)(32 * (rb + 1)) * NPROJ + 16 * d0);
            }
            f32x16 o0, o1;
#pragma unroll
            for (int r = 0; r < 16; ++r) { o0[r] = 0.f; o1[r] = 0.f; }
            float m = sink2, l = (h == 0) ? 1.f : 0.f;
            const int kt0 = rb >> 1;
            const int dm = r32 - 4 * h;
            auto do_tile = [&](const int kt, const bool L0, const int M0, const bool L1, const int M1) __attribute__((always_inline)) {
                f32x16 p0, p1;
#pragma unroll
                for (int r = 0; r < 16; ++r) { p0[r] = 0.f; p1[r] = 0.f; }
                LAS const unsigned char* ka = Kimg + (kt * 64 + r32) * KRS + 16 * h;
#pragma unroll
                for (int d0 = 0; d0 < 4; ++d0) {
                    if (L0) { const bf16x8 a0 = *(LAS const bf16x8*)(ka + d0 * 32); p0 = MFMA32(a0, qf[d0], p0); }
                    if (L1) { const bf16x8 a1 = *(LAS const bf16x8*)(ka + 32 * KRS + d0 * 32); p1 = MFMA32(a1, qf[d0], p1); }
                }
                float mt = -INFINITY;
#pragma unroll
                for (int r = 0; r < 16; ++r) {
                    const int cr = (r & 3) + 8 * (r >> 2);
                    if (L0) { if (M0 == 1 && !(cr > dm)) p0[r] = -INFINITY; if (M0 == 2 && !(cr <= dm)) p0[r] = -INFINITY; mt = fmaxf(mt, p0[r]); }
                    if (L1) { if (M1 == 1 && !(cr > dm)) p1[r] = -INFINITY; if (M1 == 2 && !(cr <= dm)) p1[r] = -INFINITY; mt = fmaxf(mt, p1[r]); }
                }
                mt = fmaxf(mt, __shfl_xor(mt, 32)) * c2;
                const float mn = fmaxf(m, mt), alpha = __builtin_amdgcn_exp2f(m - mn);
                m = mn;
                float ls = 0.f;
#pragma unroll
                for (int r = 0; r < 16; ++r) {
                    if (L0) { p0[r] = __builtin_amdgcn_exp2f(__builtin_fmaf(p0[r], c2, -mn)); ls += p0[r]; }
                    if (L1) { p1[r] = __builtin_amdgcn_exp2f(__builtin_fmaf(p1[r], c2, -mn)); ls += p1[r]; }
                }
                l = l * alpha + ls;
#pragma unroll
                for (int r = 0; r < 16; ++r) { o0[r] *= alpha; o1[r] *= alpha; }
                LAS const unsigned char* va = Vimg + (kt * 64 + 4 * h + q4) * VRS + 32 * b16 + 8 * p4;
#pragma unroll
                for (int s = 0; s < 4; ++s) {
                    if ((s < 2) ? L0 : L1) {
                        const bf16x8 pf = (s < 2) ? PACK8(p0, (s & 1) * 8) : PACK8(p1, (s & 1) * 8);
                        const bf16x8 v0f = cat8(tr16(va + (16 * s) * VRS), tr16(va + (16 * s + 8) * VRS));
                        const bf16x8 v1f = cat8(tr16(va + (16 * s) * VRS + 64), tr16(va + (16 * s + 8) * VRS + 64));
                        o0 = MFMA32(v0f, pf, o0); o1 = MFMA32(v1f, pf, o1);
                    }
                }
            };
            TSTART(211);
            if (blk > 0 || kt0 + 1 >= 2) do_tile(kt0 + 1, true, 0, true, 0);
            if (rb & 1) {
                if (blk > 0 || kt0 >= 2) do_tile(kt0, false, 0, true, 1);
                do_tile(kt0 + 2, true, 0, true, 2);
            } else {
                if (blk > 0 || kt0 >= 2) do_tile(kt0, true, 1, true, 0);
                do_tile(kt0 + 2, true, 2, false, 0);
            }
            TSTOP(211); TSTART(212);
            const float ltot = l + __shfl_xor(l, 32), inv = 1.0f / ltot;
            float sq = 0.f;
#pragma unroll
            for (int r = 0; r < 16; ++r) { o0[r] *= inv; o1[r] *= inv; sq += o0[r] * o0[r] + o1[r] * o1[r]; }
            sq += __shfl_xor(sq, 32);
            if (h == 0) ssq[hq * 128 + qi] = sq;
            bf16* op = C.MIX + (size_t)(b * SEQ + t0 + qi) * 2048 + 1024 + hq * 64 + 4 * h;
#pragma unroll
            for (int g = 0; g < 4; ++g) {
                u32x2 w0; w0.x = cvtpk(o0[4 * g], o0[4 * g + 1]); w0.y = cvtpk(o0[4 * g + 2], o0[4 * g + 3]); *(u32x2*)(op + 8 * g) = w0;
                u32x2 w1; w1.x = cvtpk(o1[4 * g], o1[4 * g + 1]); w1.y = cvtpk(o1[4 * g + 2], o1[4 * g + 3]); *(u32x2*)(op + 32 + 8 * g) = w1;
            }
#pragma unroll
            for (int d0 = 0; d0 < 4; ++d0) qf[d0] = qn[d0];
            TSTOP(212);
        }
    }
    __syncthreads();
    if (C.tid < 128) { float s = 0.f;
#pragma unroll
        for (int hh = 0; hh < 16; ++hh) s += ssq[hh * 128 + C.tid];
        C.RATT[b * SEQ + t0 + C.tid] = 1.0f / sqrtf(s * (1.0f / 1024.f) + EPS); }
    __syncthreads();
}

__device__ __forceinline__ void chunk_cumsum(const Ctx& C, int rowbase, int hd, float& d0, float& d1, float& c0, float& c1, float& total) {
    const float A = -expf(C.a_log[hd]);
    d0 = C.DT[(size_t)(rowbase + 2 * C.lane) * 16 + hd]; d1 = C.DT[(size_t)(rowbase + 2 * C.lane + 1) * 16 + hd];
    const float a0 = d0 * A, a1 = d1 * A;
    float v = a0 + a1;
#pragma unroll
    for (int o = 1; o < 64; o <<= 1) { const float t = __shfl_up(v, o); if (C.lane >= o) v += t; }
    c1 = v; c0 = v - a1; total = __shfl(v, 63);
}

constexpr int X4RS = 576, BRS = 320;
__device__ __forceinline__ void ssd_states_fast(Ctx& C, int u) {
    const int g = u & 1, c = (u >> 1) & 31, b = u >> 6, t0 = c * CHK, rowbase = b * SEQ + t0;
    LAS unsigned char* L = (LAS unsigned char*)C.lds;
    LAS unsigned char* XI = L;
    LAS unsigned char* BI = L + 73728;
    LAS float* WL = (LAS float*)(L + 114688);
    const int lane = C.lane, r32 = lane & 31, h = lane >> 5, q4 = (lane & 15) >> 2, p4 = lane & 3, b16 = (lane >> 4) & 1, w = C.wave;
    __syncthreads();
    TSTART(200);
    {
        float d0, d1, c0, c1, tot; chunk_cumsum(C, rowbase, g * 8 + w, d0, d1, c0, c1, tot);
        WL[w * 128 + 2 * lane] = d0 * expf(tot - c0); WL[w * 128 + 2 * lane + 1] = d1 * expf(tot - c1);
        if (lane == 0) C.CDEC[(b * NCH + c) * NH + g * 8 + w] = expf(tot);
    }
    TSTOP(200);
    for (int ps = 0; ps < 2; ++ps) {
        TSTART(201);
        const bool task = ps == 0 || C.tid < 256;
        const int cg = ps == 0 ? (C.tid & 63) : (C.tid & 31), run = ps == 0 ? (C.tid >> 6) : (C.tid >> 5);
        const int ch = ps == 1 ? g * 512 + 256 + cg * 8 : (cg < 32 ? g * 512 + cg * 8 : (cg < 48 ? 1024 + g * 128 + (cg - 32) * 8 : 1280 + g * 128 + (cg - 48) * 8));
        const int l0 = 16 * run;
        u32x4 raw[19];
#pragma unroll
        for (int i = 0; i < 19; ++i) raw[i] = (u32x4){0u, 0u, 0u, 0u};
        if (task) {
#pragma unroll
            for (int i = 0; i < 3; ++i) {
                if (l0 > 0) raw[i] = *(const u32x4*)(C.PROJ + (size_t)(rowbase + l0 + i - 3) * NPROJ + PX + ch);
                else if (c > 0) raw[i] = *(const u32x4*)(C.HALO + ((size_t)(b * NCH + c - 1) * 3 + i) * CONVCH + ch);
            }
#pragma unroll
            for (int i = 3; i < 19; ++i) raw[i] = *(const u32x4*)(C.PROJ + (size_t)(rowbase + l0 + i - 3) * NPROJ + PX + ch);
        }
        __syncthreads();
        TSTOP(201); TSTART(202);
        if (task) {
            float cw[4][8], cbias[8];
#pragma unroll
            for (int j = 0; j < 4; ++j) { const f32x4 a = *(const f32x4*)(C.conv_w + j * CONVCH + ch), bq = *(const f32x4*)(C.conv_w + j * CONVCH + ch + 4);
                cw[j][0] = a[0]; cw[j][1] = a[1]; cw[j][2] = a[2]; cw[j][3] = a[3]; cw[j][4] = bq[0]; cw[j][5] = bq[1]; cw[j][6] = bq[2]; cw[j][7] = bq[3]; }
            { const f32x4 a = *(const f32x4*)(C.conv_b + ch), bq = *(const f32x4*)(C.conv_b + ch + 4);
              cbias[0] = a[0]; cbias[1] = a[1]; cbias[2] = a[2]; cbias[3] = a[3]; cbias[4] = bq[0]; cbias[5] = bq[1]; cbias[6] = bq[2]; cbias[7] = bq[3]; }
#pragma unroll
            for (int i = 0; i < 16; ++i) {
                float o[8];
#pragma unroll
                for (int k = 0; k < 8; ++k) o[k] = cbias[k];
#pragma unroll
                for (int j = 0; j < 4; ++j) { const u32x4 rv = raw[i + j];
                    o[0] += cw[j][0] * bf2f(rv.x); o[1] += cw[j][1] * bf2f(rv.x >> 16); o[2] += cw[j][2] * bf2f(rv.y); o[3] += cw[j][3] * bf2f(rv.y >> 16);
                    o[4] += cw[j][4] * bf2f(rv.z); o[5] += cw[j][5] * bf2f(rv.z >> 16); o[6] += cw[j][6] * bf2f(rv.w); o[7] += cw[j][7] * bf2f(rv.w >> 16); }
                u32x4 pk; pk.x = cvtpk(silu_f(o[0]), silu_f(o[1])); pk.y = cvtpk(silu_f(o[2]), silu_f(o[3])); pk.z = cvtpk(silu_f(o[4]), silu_f(o[5])); pk.w = cvtpk(silu_f(o[6]), silu_f(o[7]));
                *(u32x4*)(C.PROJ + (size_t)(rowbase + l0 + i) * NPROJ + PX + ch) = pk;
                if (ps == 1 || cg < 32) *(LAS u32x4*)(XI + (l0 + i) * X4RS + (cg & 31) * 16) = pk;
                else if (cg < 48) *(LAS u32x4*)(BI + (l0 + i) * BRS + (cg - 32) * 16) = pk;
            }
        }
        __syncthreads();
        TSTOP(202); TSTART(203);
        const int hl = w & 3, hh = ps * 4 + hl, nt0 = 2 * (w >> 2);
        f32x16 acc[2][2];
#pragma unroll
        for (int i = 0; i < 2; ++i)
#pragma unroll
            for (int pt = 0; pt < 2; ++pt)
#pragma unroll
                for (int r = 0; r < 16; ++r) acc[i][pt][r] = 0.f;
#pragma unroll 2
        for (int ks = 0; ks < 8; ++ks) {
            const f32x4 w0 = *(LAS const f32x4*)(WL + hh * 128 + 16 * ks + 8 * h), w1 = *(LAS const f32x4*)(WL + hh * 128 + 16 * ks + 8 * h + 4);
            LAS const unsigned char* xa = XI + (16 * ks + 8 * h + q4) * X4RS + (hl * 64) * 2 + 32 * b16 + 8 * p4;
            LAS const unsigned char* ba = BI + (16 * ks + 8 * h + q4) * BRS + (nt0 * 32) * 2 + 32 * b16 + 8 * p4;
            bf16x8 xf[2];
#pragma unroll
            for (int pt = 0; pt < 2; ++pt) {
                const s16x4 lo = tr16(xa + pt * 64), hi = tr16(xa + 4 * X4RS + pt * 64);
                u32x4 sc;
                sc.x = cvtpk(bf2f((unsigned short)lo[0]) * w0[0], bf2f((unsigned short)lo[1]) * w0[1]); sc.y = cvtpk(bf2f((unsigned short)lo[2]) * w0[2], bf2f((unsigned short)lo[3]) * w0[3]);
                sc.z = cvtpk(bf2f((unsigned short)hi[0]) * w1[0], bf2f((unsigned short)hi[1]) * w1[1]); sc.w = cvtpk(bf2f((unsigned short)hi[2]) * w1[2], bf2f((unsigned short)hi[3]) * w1[3]);
                xf[pt] = __builtin_bit_cast(bf16x8, sc);
            }
#pragma unroll
            for (int i = 0; i < 2; ++i) {
                const bf16x8 bfr = cat8(tr16(ba + i * 64), tr16(ba + 4 * BRS + i * 64));
                acc[i][0] = MFMA32(bfr, xf[0], acc[i][0]); acc[i][1] = MFMA32(bfr, xf[1], acc[i][1]);
            }
        }
        bf16* st = C.ST + ((size_t)((b * NCH + c) * NH + g * 8 + hh)) * (HD * NST);
#pragma unroll
        for (int i = 0; i < 2; ++i)
#pragma unroll
            for (int pt = 0; pt < 2; ++pt)
#pragma unroll
                for (int gq = 0; gq < 4; ++gq) { u32x2 wv; wv.x = cvtpk(acc[i][pt][4 * gq], acc[i][pt][4 * gq + 1]); wv.y = cvtpk(acc[i][pt][4 * gq + 2], acc[i][pt][4 * gq + 3]);
                    *(u32x2*)(st + (32 * pt + r32) * NST + 32 * (nt0 + i) + 8 * gq + 4 * h) = wv; }
        TSTOP(203);
    }
    __syncthreads();
}

__device__ __forceinline__ void phase_scan_fast(Ctx& C) {
    const int total = NB * NH * HD * NST / 8;
    for (int e = C.bid * NTHREADS + C.tid; e < total; e += C.G * NTHREADS) {
        const int pn = e & 1023, hd = (e >> 10) & 15, b = e >> 14;
        float carry[8];
#pragma unroll
        for (int k = 0; k < 8; ++k) carry[k] = 0.f;
        u32x4* p = (u32x4*)(C.ST + ((size_t)(b * NCH * NH + hd)) * (HD * NST)) + pn;
        const float* dc = C.CDEC + b * NCH * NH + hd;
        for (int c0 = 0; c0 < NCH; c0 += 8) {
            u32x4 sv[8]; float dv[8];
#pragma unroll
            for (int i = 0; i < 8; ++i) { sv[i] = p[(size_t)(c0 + i) * NH * 1024]; dv[i] = dc[(c0 + i) * NH]; }
#pragma unroll
            for (int i = 0; i < 8; ++i) {
                const u32x4 s = sv[i]; const float dec = dv[i];
                u32x4 o; o.x = cvtpk(carry[0], carry[1]); o.y = cvtpk(carry[2], carry[3]); o.z = cvtpk(carry[4], carry[5]); o.w = cvtpk(carry[6], carry[7]);
                p[(size_t)(c0 + i) * NH * 1024] = o;
                carry[0] = carry[0] * dec + bf2f(s.x); carry[1] = carry[1] * dec + bf2f(s.x >> 16); carry[2] = carry[2] * dec + bf2f(s.y); carry[3] = carry[3] * dec + bf2f(s.y >> 16);
                carry[4] = carry[4] * dec + bf2f(s.z); carry[5] = carry[5] * dec + bf2f(s.z >> 16); carry[6] = carry[6] * dec + bf2f(s.w); carry[7] = carry[7] * dec + bf2f(s.w >> 16);
            }
        }
    }
}

constexpr int BCRS = 272;
__device__ __forceinline__ void ssd_out_fast(Ctx& C, int u) {
    const int g = u & 1, c = (u >> 1) & 31, b = u >> 6, t0 = c * CHK, rowbase = b * SEQ + t0;
    LAS unsigned char* L = (LAS unsigned char*)C.lds;
    LAS unsigned char* BI = L;
    LAS unsigned char* CI = L + 34816;
    LAS unsigned char* XI = L + 69632;
    LAS float* AC = (LAS float*)(L + 143360);
    LAS float* DL = AC + 1024;
    LAS float* ssl = DL + 1024;
    LAS float* rsl = ssl + 128;
    const int lane = C.lane, r32 = lane & 31, h = lane >> 5, q4 = (lane & 15) >> 2, p4 = lane & 3, b16 = (lane >> 4) & 1, w = C.wave;
    __syncthreads();
    TSTART(40);
    {   float d0, d1, c0, c1, tot; chunk_cumsum(C, rowbase, g * 8 + w, d0, d1, c0, c1, tot);
        AC[w * 128 + 2 * lane] = c0 * 1.4426950408889634f; AC[w * 128 + 2 * lane + 1] = c1 * 1.4426950408889634f;
        DL[w * 128 + 2 * lane] = d0; DL[w * 128 + 2 * lane + 1] = d1; }
    if (C.tid < 128) ssl[C.tid] = 0.f;
#pragma unroll
    for (int i = 0; i < 8; ++i) { const int idx = C.tid + NTHREADS * i, row = idx >> 5, cc = idx & 31;
        const u32x4 v = *(const u32x4*)(C.PROJ + (size_t)(rowbase + row) * NPROJ + PX + 1024 + (cc >> 4) * 256 + g * 128 + (cc & 15) * 8);
        *(LAS u32x4*)((cc < 16 ? BI : CI) + row * BCRS + (cc & 15) * 16) = v; }
    TSTOP(40);
    for (int ps = 0; ps < 2; ++ps) {
        TSTART(41);
        __syncthreads();
#pragma unroll
        for (int i = 0; i < 8; ++i) { const int idx = C.tid + NTHREADS * i, row = idx >> 5, cc = idx & 31;
            *(LAS u32x4*)(XI + row * X4RS + cc * 16) = *(const u32x4*)(C.PROJ + (size_t)(rowbase + row) * NPROJ + PX + g * 512 + ps * 256 + cc * 8); }
        __syncthreads();
        TSTOP(41);
        const int hl = w & 3, hh = ps * 4 + hl, hd = g * 8 + hh;
        const float dsk = C.d_skip[hd];
        const bf16* prev = C.ST + ((size_t)((b * NCH + c) * NH + hd)) * (HD * NST);
        for (int li = 0; li < 2; ++li) {
            const int lt = (w >> 2) ? (1 + li) : (3 * li);
            const int l = 32 * lt + r32;
            f32x16 acc[2];
#pragma unroll
            for (int r = 0; r < 16; ++r) { acc[0][r] = 0.f; acc[1][r] = 0.f; }
            TSTART(42);
            const size_t grow = (size_t)(rowbase + l);
            u32x2 zr[2][4];
#pragma unroll
            for (int pt = 0; pt < 2; ++pt)
#pragma unroll
                for (int gq = 0; gq < 4; ++gq) zr[pt][gq] = *(const u32x2*)(C.PROJ + grow * NPROJ + PZ + hd * 64 + 32 * pt + 8 * gq + 4 * h);
            bf16x8 cf[8];
#pragma unroll
            for (int ks = 0; ks < 8; ++ks) cf[ks] = *(LAS const bf16x8*)(CI + l * BCRS + (16 * ks + 8 * h) * 2);
            {   bf16x8 pf[2][8];
#pragma unroll
                for (int pt = 0; pt < 2; ++pt)
#pragma unroll
                    for (int ks = 0; ks < 8; ++ks) pf[pt][ks] = *(const bf16x8*)(prev + (32 * pt + r32) * NST + 16 * ks + 8 * h);
                __builtin_amdgcn_sched_barrier(0);
#pragma unroll
                for (int pt = 0; pt < 2; ++pt)
#pragma unroll
                    for (int ks = 0; ks < 8; ++ks) acc[pt] = MFMA32(pf[pt][ks], cf[ks], acc[pt]);
            }
            const float al = AC[hh * 128 + l], el = __builtin_amdgcn_exp2f(al);
#pragma unroll
            for (int r = 0; r < 16; ++r) { acc[0][r] *= el; acc[1][r] *= el; }
            TSTOP(42); TSTART(43);
            for (int st = 0; st <= lt; ++st) {
                f32x16 X;
#pragma unroll
                for (int r = 0; r < 16; ++r) X[r] = 0.f;
#pragma unroll
                for (int ks = 0; ks < 8; ++ks) { const bf16x8 bfr = *(LAS const bf16x8*)(BI + (32 * st + r32) * BCRS + (16 * ks + 8 * h) * 2); X = MFMA32(bfr, cf[ks], X); }
#pragma unroll
                for (int gq = 0; gq < 4; ++gq) {
                    const int s0 = 32 * st + 8 * gq + 4 * h;
                    const f32x4 as = *(LAS const f32x4*)(AC + hh * 128 + s0), ds = *(LAS const f32x4*)(DL + hh * 128 + s0);
#pragma unroll
                    for (int i = 0; i < 4; ++i) { const float e = __builtin_amdgcn_exp2f(fminf(al - as[i], 0.f)) * ds[i]; X[4 * gq + i] = (s0 + i <= l) ? X[4 * gq + i] * e : 0.f; }
                }
                LAS const unsigned char* xa = XI + (32 * st + 4 * h + q4) * X4RS + (hl * 64) * 2 + 32 * b16 + 8 * p4;
#pragma unroll
                for (int tq = 0; tq < 2; ++tq) {
                    const bf16x8 mf = (tq == 0) ? PACK8(X, 0) : PACK8(X, 8);
#pragma unroll
                    for (int pt = 0; pt < 2; ++pt) { const bf16x8 xf = cat8(tr16(xa + (16 * tq) * X4RS + pt * 64), tr16(xa + (16 * tq + 8) * X4RS + pt * 64)); acc[pt] = MFMA32(xf, mf, acc[pt]); }
                }
            }
            TSTOP(43); TSTART(44);
            float sq = 0.f;
#pragma unroll
            for (int pt = 0; pt < 2; ++pt)
#pragma unroll
                for (int gq = 0; gq < 4; ++gq) {
                    const int p0 = 32 * pt + 8 * gq + 4 * h;
                    const u32x2 xv = *(LAS const u32x2*)(XI + l * X4RS + (hl * 64 + p0) * 2);
                    const u32x2 zv = zr[pt][gq];
                    const float y0 = (acc[pt][4 * gq] + dsk * bf2f(xv.x)) * silu_f(bf2f(zv.x)), y1 = (acc[pt][4 * gq + 1] + dsk * bf2f(xv.x >> 16)) * silu_f(bf2f(zv.x >> 16));
                    const float y2 = (acc[pt][4 * gq + 2] + dsk * bf2f(xv.y)) * silu_f(bf2f(zv.y)), y3 = (acc[pt][4 * gq + 3] + dsk * bf2f(xv.y >> 16)) * silu_f(bf2f(zv.y >> 16));
                    sq += y0 * y0 + y1 * y1 + y2 * y2 + y3 * y3;
                    u32x2 o; o.x = cvtpk(y0, y1); o.y = cvtpk(y2, y3);
                    *(u32x2*)(C.MIX + grow * 2048 + hd * 64 + p0) = o;
                }
            sq += __shfl_xor(sq, 32);
            if (h == 0) atomicAdd((float*)(ssl + l), sq);
            TSTOP(44);
        }
    }
    __syncthreads();
    if (C.tid < 128) C.RSG[(size_t)(rowbase + C.tid) * 2 + g] = 1.0f / sqrtf(ssl[C.tid] * (1.0f / 512.f) + EPS);
    __syncthreads();
}

__device__ __forceinline__ void phase_gemm2(Ctx& C) {
    pg8::DenseOrder S; S.init(M, DM, 2048, C.WOUT, C.G, C.bid);
    pg8::EpiResid E{C.x, C.out, C.XN, C.RSG, C.RATT, (LAS float*)((LAS unsigned char*)C.lds + 135168)};
    pg8::gemm_phase<pg8::EpiResid, pg8::DenseOrder, true>((LAS unsigned char*)C.lds, (const char*)C.MIX, 2048, S, E);
}

struct MoeItem { const float* W; int ldw, k0, n0; bf16* WT; int K, drow0; const float* ks; };
__device__ __forceinline__ MoeItem moe_item(const Ctx& C, int it) {
    MoeItem I; const int e = it / 768; int r = it % 768;
    if (r < 512) { const bool up = r >= 256; r &= 255; const int kb = r >> 4, nb = r & 15, n0 = nb * 32;
        I.W = (up ? C.w_up : C.w_gate) + (size_t)e * DM * FF; I.ldw = FF; I.k0 = kb * 64; I.n0 = n0; I.WT = C.WGU + (size_t)e * 1024 * 1024; I.K = DM; I.drow0 = (n0 >> 7) * 256 + (n0 & 127) + (up ? 128 : 0); I.ks = C.norm_ffn; }
    else { r -= 512; const int kb = r >> 5, nb = r & 31;
        I.W = C.w_down + (size_t)e * FF * DM; I.ldw = DM; I.k0 = kb * 64; I.n0 = nb * 32; I.WT = C.WD + (size_t)e * 1024 * FF; I.K = FF; I.drow0 = nb * 32; I.ks = nullptr; }
    return I;
}
__device__ __forceinline__ void moe_convert_item(Ctx& C, int it, LAS float* scr) {
    const int e = it / 768; int r = it % 768;
    if (r < 512) { const bool up = r >= 256; r &= 255; const int kb = r >> 4, nb = r & 15, n0 = nb * 32;
        transpose_item((up ? C.w_up : C.w_gate) + (size_t)e * DM * FF, FF, kb * 64, n0, C.WGU + (size_t)e * 1024 * 1024, DM, (n0 >> 7) * 256 + (n0 & 127) + (up ? 128 : 0), scr, C.lane, C.norm_ffn); }
    else { r -= 512; const int kb = r >> 5, nb = r & 31; transpose_item(C.w_down + (size_t)e * FF * DM, DM, kb * 64, nb * 32, C.WD + (size_t)e * 1024 * FF, FF, nb * 32, scr, C.lane); }
}
constexpr int NREM = (NE - E1) * 512 + (NE - E7) * 256;
__device__ __forceinline__ int rem_item(int j) { if (j < (NE - E1) * 512) return (E1 + j / 512) * 768 + (j % 512); j -= (NE - E1) * 512; return (E7 + j / 256) * 768 + 512 + (j % 256); }
template <class ItemOf> __device__ __forceinline__ void conv_stream(Ctx& C, int j0, int step, int nitems, ItemOf item_of) {
    LAS float* scr = (LAS float*)((LAS unsigned char*)C.lds + C.wave * 8704);
    if (j0 >= nitems) return;
    float ta[32], tb[32]; f32x4 ka[2], kb2[2];
    MoeItem A = moe_item(C, item_of(j0)), B = A;
    transpose_load(A.W, A.ldw, A.k0, A.n0, C.lane, A.ks, ta, ka);
    for (int j = j0; j < nitems; j += 2 * step) {
        const bool hb = j + step < nitems, ha = j + 2 * step < nitems;
        if (hb) { B = moe_item(C, item_of(j + step)); transpose_load(B.W, B.ldw, B.k0, B.n0, C.lane, B.ks, tb, kb2); }
        transpose_store(ta, ka, A.WT, A.K, A.drow0, A.k0, scr, C.lane);
        if (ha) { A = moe_item(C, item_of(j + 2 * step)); transpose_load(A.W, A.ldw, A.k0, A.n0, C.lane, A.ks, ta, ka); }
        if (hb) transpose_store(tb, kb2, B.WT, B.K, B.drow0, B.k0, scr, C.lane);
    }
}
__device__ __forceinline__ void conv_gateup_early(Ctx& C) { conv_stream(C, C.bid * NWAVES + C.wave, NCONV * NWAVES, E1 * 512, [](int j) { return (j / 512) * 768 + (j % 512); }); }
__device__ __forceinline__ void conv_down_early(Ctx& C) { conv_stream(C, C.bid * NWAVES + C.wave, NCONV * NWAVES, E7 * 256, [](int j) { return (j / 256) * 768 + 512 + (j % 256); }); }
__device__ __forceinline__ void phase_router_fast(Ctx& C) {
    LAS float* scr = (LAS float*)((LAS unsigned char*)C.lds + C.wave * 8704);
    LAS float* PA = (LAS float*)((LAS unsigned char*)C.lds + 71680);
    int cit = C.bid * NWAVES + C.wave;
    const int lane = C.lane, r32 = lane & 31, h = lane >> 5, w = C.wave, tt = w & 3, kh = w >> 2;
    const int gw = C.bid * NWAVES + C.wave, NGW = C.G * NWAVES;
    unsigned* cnt = C.ctl + CW_CNT;
    LAS unsigned* hist = (LAS unsigned*)(PA + 4 * 49 * 64);
    LAS unsigned* hbase = hist + 64;
    TSTART(60);
    for (int rb = C.bid; rb < M / 128; rb += C.G) {
        const int row = rb * 128 + 32 * tt + r32;
        if (C.tid < 64) hist[C.tid] = 0u;
        const bf16* hp = C.XN + (size_t)row * DM + 512 * kh + 8 * h;
        const bf16* whp = C.WRH + (size_t)r32 * DM + 512 * kh + 8 * h;
        const bf16* wlp = C.WRL + (size_t)r32 * DM + 512 * kh + 8 * h;
        f32x16 acc[3];
#pragma unroll
        for (int t = 0; t < 3; ++t)
#pragma unroll
            for (int r = 0; r < 16; ++r) acc[t][r] = 0.f;
        float ss = 0.f;
#pragma unroll 1
        for (int kb = 0; kb < 8; ++kb) {
            u32x4 hv[4]; bf16x8 wh[4][3], wl[4][3];
#pragma unroll
            for (int i = 0; i < 4; ++i) hv[i] = *(const u32x4*)(hp + (kb * 4 + i) * 16);
#pragma unroll
            for (int i = 0; i < 4; ++i)
#pragma unroll
                for (int t = 0; t < 3; ++t) { wh[i][t] = *(const bf16x8*)(whp + (size_t)t * 32 * DM + (kb * 4 + i) * 16); wl[i][t] = *(const bf16x8*)(wlp + (size_t)t * 32 * DM + (kb * 4 + i) * 16); }
            __builtin_amdgcn_sched_barrier(0);
            if (cit < NREM) { moe_convert_item(C, rem_item(cit), scr); cit += NGW; }
            __builtin_amdgcn_sched_barrier(0);
#pragma unroll
            for (int i = 0; i < 4; ++i) {
                const u32x4 a = hv[i];
                const float f0 = bf2f(a.x), f1 = bf2f(a.x >> 16), f2 = bf2f(a.y), f3 = bf2f(a.y >> 16), f4 = bf2f(a.z), f5 = bf2f(a.z >> 16), f6 = bf2f(a.w), f7 = bf2f(a.w >> 16);
                ss += f0 * f0 + f1 * f1 + f2 * f2 + f3 * f3 + f4 * f4 + f5 * f5 + f6 * f6 + f7 * f7;
                const bf16x8 thf = __builtin_bit_cast(bf16x8, a);
#pragma unroll
                for (int t = 0; t < 3; ++t) { acc[t] = MFMA32(wh[i][t], thf, acc[t]); acc[t] = MFMA32(wl[i][t], thf, acc[t]); }
            }
            __builtin_amdgcn_sched_barrier(0);
        }
        __syncthreads();
        if (kh == 1) {
#pragma unroll
            for (int t = 0; t < 3; ++t)
#pragma unroll
                for (int r = 0; r < 16; ++r) PA[(tt * 49 + t * 16 + r) * 64 + lane] = acc[t][r];
            PA[(tt * 49 + 48) * 64 + lane] = ss;
        }
        __syncthreads();
        int es0 = 0, es1 = 0; float gs0 = 0.f, gs1 = 0.f, rstd_s = 0.f; unsigned lp0 = 0u, lp1 = 0u;
        if (kh == 0) {
#pragma unroll
            for (int t = 0; t < 3; ++t)
#pragma unroll
                for (int r = 0; r < 16; ++r) acc[t][r] += PA[(tt * 49 + t * 16 + r) * 64 + lane];
            ss += PA[(tt * 49 + 48) * 64 + lane];
            ss += __shfl_xor(ss, 32);
            const float rstd = 1.0f / sqrtf(ss * (1.0f / DM) + EPS);
            if (h == 0) C.RS[row] = rstd;
            float gm[4], go[4], gl[8];
#pragma unroll
            for (int i = 0; i < 4; ++i) { gm[i] = acc[2][i] * rstd; go[i] = __shfl_xor(gm[i], 32); }
#pragma unroll
            for (int i = 0; i < 4; ++i) { gl[i] = h ? go[i] : gm[i]; gl[4 + i] = h ? gm[i] : go[i]; }
            int gsel = 0; float gmax = gl[0];
#pragma unroll
            for (int c2 = 1; c2 < 8; ++c2) if (gl[c2] > gmax) { gmax = gl[c2]; gsel = c2; }
            float gsum = 0.f;
#pragma unroll
            for (int c2 = 0; c2 < 8; ++c2) gsum += expf(gl[c2] - gmax);
            const float pgrp = 1.0f / gsum;
            float em[4], eo[4], el[8];
#pragma unroll
            for (int i = 0; i < 4; ++i) { float v = acc[0][i];
#pragma unroll
                for (int gg = 1; gg < 8; ++gg) v = (gsel == gg) ? acc[gg >> 2][4 * (gg & 3) + i] : v;
                em[i] = v * rstd; eo[i] = __shfl_xor(em[i], 32); }
#pragma unroll
            for (int i = 0; i < 4; ++i) { el[i] = h ? eo[i] : em[i]; el[4 + i] = h ? em[i] : eo[i]; }
            int i0 = 0; float l0 = el[0];
#pragma unroll
            for (int i = 1; i < 8; ++i) if (el[i] > l0) { l0 = el[i]; i0 = i; }
            int i1 = -1; float l1 = -INFINITY;
#pragma unroll
            for (int i = 0; i < 8; ++i) if (i != i0 && el[i] > l1) { l1 = el[i]; i1 = i; }
            const float e1 = expf(l1 - l0), g0 = pgrp / (1.0f + e1), g1 = pgrp * e1 / (1.0f + e1);
            es0 = gsel * 8 + i0; es1 = gsel * 8 + i1; gs0 = g0; gs1 = g1; rstd_s = rstd;
            if (h == 0) { lp0 = atomicAdd((unsigned*)(hist + es0), 1u); lp1 = atomicAdd((unsigned*)(hist + es1), 1u); }
        }
        __syncthreads();
        if (w == 0) { const unsigned n = hist[lane]; unsigned bs = 0u; if (n) bs = atomicAdd(&cnt[lane], n); hbase[lane] = bs; }
        __syncthreads();
        if (kh == 0 && h == 0) {
            const unsigned p0 = hbase[es0] + lp0, p1 = hbase[es1] + lp1;
            C.TE[row * 2] = es0; C.TP[row * 2] = (int)p0; C.LIST[(size_t)es0 * LISTCAP + p0] = row * 2; C.LG[(size_t)es0 * LISTCAP + p0] = gs0; C.LRS[(size_t)es0 * LISTCAP + p0] = rstd_s;
            C.TE[row * 2 + 1] = es1; C.TP[row * 2 + 1] = (int)p1; C.LIST[(size_t)es1 * LISTCAP + p1] = row * 2 + 1; C.LG[(size_t)es1 * LISTCAP + p1] = gs1; C.LRS[(size_t)es1 * LISTCAP + p1] = rstd_s;
        }
    }
    __syncthreads();
    TSTOP(60); TSTART(61);
    conv_stream(C, cit, NGW, NREM, [](int j) { return rem_item(j); });
    TSTOP(61);
}

struct MoeTab { int* cnt; int* pstart; int* tstart; };
__device__ __forceinline__ MoeTab moe_tables(Ctx& C, int off) {
    MoeTab T; T.cnt = (int*)(C.lds + off); T.pstart = T.cnt + 64; T.tstart = T.pstart + 65;
    __syncthreads();
    if (C.tid < 64) T.cnt[C.tid] = (int)__hip_atomic_load(C.ctl + CW_CNT + C.tid, __ATOMIC_RELAXED, __HIP_MEMORY_SCOPE_AGENT);
    __syncthreads();
    if (C.tid == 0) { int ps = 0, ts = 0; for (int e = 0; e < 64; ++e) { T.pstart[e] = ps; T.tstart[e] = ts; ps += ((T.cnt[e] + 255) >> 8) << 8; ts += (T.cnt[e] + 255) >> 8; } T.pstart[64] = ps; T.tstart[64] = ts; }
    __syncthreads();
    return T;
}

constexpr int MOE_TAB_OFF = 132096;
__device__ __forceinline__ void phase_moe_a(Ctx& C) {
    const MoeTab T = moe_tables(C, MOE_TAB_OFF);
    if (C.bid < NCONV) { conv_down_early(C); return; }
    const int G2 = C.G - NCONV, b2 = C.bid - NCONV, vcu2 = (G2 % 8 == 0) ? (b2 % 8) * (G2 / 8) + b2 / 8 : b2;
    pg8::MoeOrder<true> S{T.cnt, T.pstart, T.tstart, C.LIST, (const char*)C.WGU, (size_t)1024 * 1024 * 2, DM, 4, T.tstart[64], G2, vcu2};
    pg8::EpiHid E{C.HID, C.LIST, C.LRS, (LAS float*)((LAS unsigned char*)C.lds + 135168)};
    pg8::gemm_phase<pg8::EpiHid, pg8::MoeOrder<true>, true>((LAS unsigned char*)C.lds, (const char*)C.XN, DM, S, E);
}
__device__ __forceinline__ void phase_moe_b(Ctx& C) {
    const MoeTab T = moe_tables(C, MOE_TAB_OFF);
    pg8::MoeOrder<false> S{T.cnt, T.pstart, T.tstart, C.LIST, (const char*)C.WD, (size_t)1024 * FF * 2, FF, 4, T.tstart[64], C.G, C.vcu};
    pg8::EpiYb E{C.YB, C.LIST, C.LG, (LAS float*)((LAS unsigned char*)C.lds + 135168)};
    pg8::gemm_phase<pg8::EpiYb, pg8::MoeOrder<false>, true>((LAS unsigned char*)C.lds, (const char*)C.HID, FF, S, E);
}
__device__ __forceinline__ void phase_final(Ctx& C) {
    const MoeTab T = moe_tables(C, 0);
    const int gw = C.bid * NWAVES + C.wave, NGW = C.G * NWAVES;
    f32x4 hn[4], gfin[4]; u32x2 an[4], cn[4];
#pragma unroll
    for (int j = 0; j < 4; ++j) gfin[j] = ((const f32x4*)C.norm_final)[C.lane + 64 * j];
#define FIN_LOAD(r) do { const size_t s0_ = (size_t)T.pstart[C.TE[(r) * 2]] + C.TP[(r) * 2], s1_ = (size_t)T.pstart[C.TE[(r) * 2 + 1]] + C.TP[(r) * 2 + 1]; \
        _Pragma("unroll") for (int j = 0; j < 4; ++j) { { const u32x2 hb_ = ((const u32x2*)(C.XN + (size_t)(r) * DM) + C.lane)[64 * j]; hn[j][0] = bf2f(hb_.x); hn[j][1] = bf2f(hb_.x >> 16); hn[j][2] = bf2f(hb_.y); hn[j][3] = bf2f(hb_.y >> 16); } an[j] = ((const u32x2*)(C.YB + s0_ * DM) + C.lane)[64 * j]; cn[j] = ((const u32x2*)(C.YB + s1_ * DM) + C.lane)[64 * j]; } } while (0)
    for (int rb = C.bid; rb < M / 128; rb += C.G) {
        const int row0 = rb * 128 + C.wave * 16;
        FIN_LOAD(row0);
#pragma unroll
        for (int i = 0; i < 16; ++i) {
            const int row = row0 + i;
            f32x4 v[4]; u32x2 ya[4], yc[4];
#pragma unroll
            for (int j = 0; j < 4; ++j) { v[j] = hn[j]; ya[j] = an[j]; yc[j] = cn[j]; }
            FIN_LOAD(row0 + ((i + 1) & 15));
            float ss = 0.f;
#pragma unroll
            for (int j = 0; j < 4; ++j) { const u32x2 a = ya[j], c = yc[j];
                v[j][0] += bf2f(a.x) + bf2f(c.x); v[j][1] += bf2f(a.x >> 16) + bf2f(c.x >> 16); v[j][2] += bf2f(a.y) + bf2f(c.y); v[j][3] += bf2f(a.y >> 16) + bf2f(c.y >> 16);
                ss += v[j][0] * v[j][0] + v[j][1] * v[j][1] + v[j][2] * v[j][2] + v[j][3] * v[j][3]; }
            const float rstd = 1.0f / sqrtf(wave_sum(ss) * (1.0f / DM) + EPS);
            f32x4* hr = (f32x4*)(C.out + (size_t)row * DM) + C.lane;
#pragma unroll
            for (int j = 0; j < 4; ++j) hr[64 * j] = v[j] * rstd * gfin[j];
            __builtin_amdgcn_sched_barrier(0);
        }
    }
#undef FIN_LOAD
}

constexpr int NPHASE = 10;
__global__ void __launch_bounds__(NTHREADS, 2) fwd_kernel(Args args) {
    extern __shared__ __attribute__((aligned(16))) unsigned char lds[];
    Ctx C;
    C.tph0 = 0; C.tphd = 0;
    C.lds = lds; C.tid = threadIdx.x; C.lane = C.tid & 63; C.wave = __builtin_amdgcn_readfirstlane(C.tid >> 6); C.G = gridDim.x; C.bid = blockIdx.x;
    C.x = args.in[0]; C.norm_mix = args.in[1]; C.w_in = args.in[2]; C.conv_w = args.in[3]; C.conv_b = args.in[4]; C.dt_bias = args.in[5]; C.a_log = args.in[6]; C.d_skip = args.in[7];
    C.ssd_norm = args.in[8]; C.sinks = args.in[9]; C.attn_norm = args.in[10]; C.w_out = args.in[11]; C.norm_ffn = args.in[12]; C.w_rg = args.in[13]; C.w_re = args.in[14];
    C.w_gate = args.in[15]; C.w_up = args.in[16]; C.w_down = args.in[17]; C.norm_final = args.in[18];
    C.out = args.out; C.ws = args.ws;
    unsigned char* ws = args.ws;
    C.ctl = (unsigned*)(ws + WS_CTL);
    C.XN = (bf16*)(ws + WS_XN); C.DT = (float*)(ws + WS_DT); C.PROJ = (bf16*)(ws + WS_PROJ); C.HID = (bf16*)(ws + WS_HID); C.YB = (bf16*)(ws + WS_YB);
    C.ST = (bf16*)(ws + WS_ST); C.MIX = (bf16*)(ws + WS_MIX); C.CDEC = (float*)(ws + WS_CDEC); C.TE = (int*)(ws + WS_TE); C.TP = (int*)(ws + WS_TP); C.TG = (float*)(ws + WS_TG);
    C.LIST = (int*)(ws + WS_LIST); C.WIN = (bf16*)(ws + WS_WIN); C.WOUT = (bf16*)(ws + WS_WOUT); C.WGU = (bf16*)args.out;            C.WD = (bf16*)(ws + WS_WD); C.HALO = (bf16*)(ws + WS_HALO); C.WRH = (bf16*)(ws + WS_WRH); C.WRL = (bf16*)(ws + WS_WRL); C.RS = (float*)(ws + WS_RS); C.RATT = C.RS + M; C.RSG = C.RS + 2 * M; C.LRS = (float*)(ws + WS_WGU); C.LG = C.LRS + (size_t)NE * LISTCAP;
    C.vcu = (C.G % 8 == 0) ? (C.bid % 8) * (C.G / 8) + C.bid / 8 : C.bid;
    TSTART(9999);
    volatile LAS unsigned* MISC = (volatile LAS unsigned*)((LAS unsigned char*)lds + MISC_OFF);
    if (C.tid < 64) MISC[C.tid] = 0u;
    __syncthreads();
    XcdBarrier bar; bar.bar = C.ctl + CW_BAR; bar.x = 0; bar.st = nullptr;
#if ONE_LAUNCH
    bar = xcd_barrier_post(C.ctl + CW_BAR, MISC + 8);
#define GRID_BAR() xcd_barrier(bar)
#else
#define GRID_BAR() do {} while (0)
#endif
    const int lo = args.ph_lo, hi = args.ph_hi;
#define IN(k) (lo <= (k) && (k) < hi)
#define SEAM(k) do { if (IN(k) && IN((k) + 1)) GRID_BAR(); } while (0)
#define REP(k) for (int _rep = 0; _rep < ((k) == RPH ? 2 : 1); ++_rep)
    TSTART(0); if (IN(0)) { REP(0) phase_prologue(C); } SEAM(0); TSTOP(0);
    TSTART(1); if (IN(1)) { if (C.bid < NCONV) conv_gateup_early(C); else phase_gemm1(C); } SEAM(1); TSTOP(1);
    TSTART(2); if (IN(2)) { TSTART(20); for (int u = C.bid; u < NB * NCH * 2; u += C.G) ssd_states_fast(C, u); TSTOP(20); TSTART(21); REP(20) for (int u = C.bid; u < NB * 32; u += C.G) attn_unit_fast(C, u); TSTOP(21); } SEAM(2); TSTOP(2);
    TSTART(3); if (IN(3)) { phase_scan_fast(C); } SEAM(3); TSTOP(3);
    TSTART(4); if (IN(4)) { REP(4) for (int u = C.bid; u < NB * NCH * 2; u += C.G) ssd_out_fast(C, u); } SEAM(4); TSTOP(4);
    TSTART(5); if (IN(5)) { REP(5) phase_gemm2(C); } SEAM(5); TSTOP(5);
    TSTART(6); if (IN(6)) { phase_router_fast(C); } SEAM(6); TSTOP(6);
    TSTART(7); if (IN(7)) { REP(7) phase_moe_a(C); } SEAM(7); TSTOP(7);
    TSTART(8); if (IN(8)) { REP(8) phase_moe_b(C); } SEAM(8); TSTOP(8);
    TSTART(9); if (IN(9)) { phase_final(C); } TSTOP(9); TSTOP(9999);
#ifdef TPH
    if (C.tid == 0) { const unsigned long long te = __builtin_amdgcn_s_memrealtime(); while (__builtin_amdgcn_s_memrealtime() - te < C.tphd) __builtin_amdgcn_s_sleep(8); }
#endif
}

extern "C" void kernel_launch(void* const* d_in, const int* in_sizes, int n_in, void* d_out, int out_size, void* d_ws, size_t ws_size, hipStream_t stream) {
    static int grid = 0;
    if (grid == 0) {
        if (n_in != 19 || in_sizes[0] != M * DM || out_size != M * DM || ws_size < WS_END) { fprintf(stderr, "kernel_launch: unexpected shapes (n_in %d, in0 %d, out %d, ws %zu)\n", n_in, n_in > 0 ? in_sizes[0] : -1, out_size, ws_size); grid = -1; return; }
        int dev = 0, cus = 0, per_cu = 0;
        if (hipGetDevice(&dev) != hipSuccess || hipDeviceGetAttribute(&cus, hipDeviceAttributeMultiprocessorCount, dev) != hipSuccess) { grid = -1; return; }
        if (hipFuncSetAttribute((const void*)fwd_kernel, hipFuncAttributeMaxDynamicSharedMemorySize, LDS_BYTES) != hipSuccess) { fprintf(stderr, "kernel_launch: hipFuncSetAttribute failed\n"); grid = -1; return; }
        if (hipOccupancyMaxActiveBlocksPerMultiprocessor(&per_cu, (const void*)fwd_kernel, NTHREADS, LDS_BYTES) != hipSuccess || per_cu < 1) { fprintf(stderr, "kernel_launch: occupancy query says %d\n", per_cu); (void)hipGetLastError(); per_cu = 1; }
        grid = cus;
    }
    if (grid < 0) return;
    (void)hipMemsetAsync((char*)d_ws + WS_CTL, 0, CTL_BYTES, stream);
    Args a{};
    for (int i = 0; i < 19; ++i) a.in[i] = (const float*)d_in[i];
    a.out = (float*)d_out; a.ws = (unsigned char*)d_ws;
#if ONE_LAUNCH
    a.ph_lo = 0; a.ph_hi = NPHASE;
    hipLaunchKernelGGL(fwd_kernel, dim3(grid), dim3(NTHREADS), LDS_BYTES, stream, a);
#else
    for (int p = 0; p < NPHASE; ++p) { a.ph_lo = p; a.ph_hi = p + 1; hipLaunchKernelGGL(fwd_kernel, dim3(grid), dim3(NTHREADS), LDS_BYTES, stream, a); }
#endif
}
```

```cpp
#include <hip/hip_runtime.h>
#include <cstdio>
#include <cstdint>

#ifndef RPH
#define RPH -1
#endif
#ifndef ONE_LAUNCH
#define ONE_LAUNCH 1
#endif

#define LAS __attribute__((address_space(3)))
typedef unsigned short bf16;
typedef float f32x4 __attribute__((ext_vector_type(4)));
typedef unsigned u32x4 __attribute__((ext_vector_type(4)));
typedef unsigned u32x2 __attribute__((ext_vector_type(2)));

constexpr int NB = 8, SEQ = 4096, DM = 1024, M = NB * SEQ;
constexpr int INDIM = 3856;
constexpr int NPROJ = 3840;
constexpr int PZ = 0, PX = 1024, PQ = 2560, PK = 3584, PV = 3712;
constexpr int DT0 = 2560;
constexpr int CONVCH = 1536;
constexpr int NH = 16, HD = 64, NST = 128, CHK = 128, NCH = SEQ / CHK;
constexpr int NE = 64, FF = 512, LISTCAP = 32768;
constexpr int SLOT_MAX = 81920;
constexpr float EPS = 1e-6f;
constexpr int NCONV = 16, E1 = 14, E7 = 32;

constexpr size_t MiB = 1u << 20;
constexpr size_t WS_CTL = 0, CTL_BYTES = 64 * 1024;
constexpr size_t WS_XN = 1 * MiB;
constexpr size_t WS_DT = 65 * MiB;
constexpr size_t WS_PROJ = 67 * MiB;
constexpr size_t WS_HID = WS_PROJ;
constexpr size_t WS_YB = WS_PROJ + 80 * MiB;
constexpr size_t WS_ST = 307 * MiB;
constexpr size_t WS_MIX = 371 * MiB;
constexpr size_t WS_WGU = 307 * MiB;
constexpr size_t WS_WD = 435 * MiB;
constexpr size_t WS_WIN = 499 * MiB;
constexpr size_t WS_WOUT = 507 * MiB;
constexpr size_t WS_MISC = 511 * MiB;
constexpr size_t WS_CDEC = WS_MISC;
constexpr size_t WS_TE = WS_MISC + 1 * MiB;
constexpr size_t WS_TP = WS_TE + 256 * 1024;
constexpr size_t WS_TG = WS_TP + 256 * 1024;
constexpr size_t WS_LIST = WS_MISC + 2 * MiB;
constexpr size_t WS_HALO = WS_LIST + 8 * MiB;
constexpr size_t WS_WRH = WS_HALO + 3 * MiB;
constexpr size_t WS_WRL = WS_WRH + 256 * 1024;
constexpr size_t WS_RS = WS_WRL + 256 * 1024;
constexpr size_t WS_END = WS_RS + 512 * 1024;
constexpr int CW_BAR = 4096;
constexpr int CW_CNT = 8192;
constexpr int CW_TIME = 8448;

constexpr int NTHREADS = 512, NWAVES = 8;
constexpr int LDS_BYTES = 159744;
constexpr int MISC_OFF = LDS_BYTES - 256;

__device__ __forceinline__ unsigned f2bf(float f) { unsigned u = __builtin_bit_cast(unsigned, f); return (u + 0x7fffu + ((u >> 16) & 1u)) >> 16; }
__device__ __forceinline__ float bf2f(unsigned b) { return __builtin_bit_cast(float, (b & 0xffffu) << 16); }
__device__ __forceinline__ unsigned pk2(float lo, float hi) { return f2bf(lo) | (f2bf(hi) << 16); }
__device__ __forceinline__ float wave_sum(float v) {
#pragma unroll
    for (int o = 1; o < 64; o <<= 1) v += __shfl_xor(v, o);
    return v;
}
__device__ __forceinline__ float silu_f(float x) { return x * __builtin_amdgcn_rcpf(1.0f + __expf(-x)); }
__device__ __forceinline__ float softplus_f(float x) { return x > 20.f ? x : log1pf(expf(x)); }

typedef short bf16x8 __attribute__((ext_vector_type(8)));
typedef short s16x4 __attribute__((ext_vector_type(4)));
typedef float f32x16 __attribute__((ext_vector_type(16)));
typedef float f32x2_t __attribute__((ext_vector_type(2)));
typedef __bf16 bf16x2_t __attribute__((ext_vector_type(2)));
#define MFMA32(a, b, c) __builtin_amdgcn_mfma_f32_32x32x16_bf16((a), (b), (c), 0, 0, 0)
__device__ __forceinline__ unsigned cvtpk(float lo, float hi) { f32x2_t v = {lo, hi}; bf16x2_t b = __builtin_convertvector(v, bf16x2_t); return __builtin_bit_cast(unsigned, b); }
__device__ __forceinline__ s16x4 tr16(LAS const unsigned char* p) { return __builtin_bit_cast(s16x4, __builtin_amdgcn_ds_read_tr16_b64_v4i16((LAS s16x4*)p)); }
__device__ __forceinline__ bf16x8 cat8(s16x4 lo, s16x4 hi) { return __builtin_shufflevector(lo, hi, 0, 1, 2, 3, 4, 5, 6, 7); }
#define PACK8(x, o) __builtin_bit_cast(bf16x8, (u32x4){cvtpk((x)[(o)], (x)[(o) + 1]), cvtpk((x)[(o) + 2], (x)[(o) + 3]), cvtpk((x)[(o) + 4], (x)[(o) + 5]), cvtpk((x)[(o) + 6], (x)[(o) + 7])})

#define XB_TMO      128
#define XB_XCNT(j)  (256  + 64 * (j))
#define XB_XSUB(j)  (1280 + 64 * (j))
#define XB_XGEN(j)  (2304 + 64 * (j))
#define XB_TOP      3328
#define XB_TOPGEN   3392
#define XCD_BAR_WORDS 3456
#define XB_SPIN_CAP (1u << 27)
__device__ __forceinline__ unsigned xb_ld(unsigned* p)              { return __hip_atomic_load(p, __ATOMIC_RELAXED, __HIP_MEMORY_SCOPE_AGENT); }
__device__ __forceinline__ unsigned xb_add(unsigned* p, unsigned v) { return __hip_atomic_fetch_add(p, v, __ATOMIC_RELAXED, __HIP_MEMORY_SCOPE_AGENT); }
__device__ __forceinline__ unsigned xb_xcc_id() { return (unsigned)__builtin_amdgcn_s_getreg((3 << 11) | 20) & 0xFu; }
#define XB_SPIN(cond, bar) do { unsigned _sp = 0; while (cond) { __builtin_amdgcn_s_sleep(1); \
    if ((++_sp & 255u) == 0u) { if (xb_ld(&(bar)[XB_TMO])) break; if (_sp > XB_SPIN_CAP) { atomicAdd(&(bar)[XB_TMO], 1u); break; } } } } while (0)
struct XcdBarrier { unsigned* bar; unsigned x; volatile LAS unsigned* st; };
__device__ __forceinline__ XcdBarrier xcd_barrier_post(unsigned* bar, volatile LAS unsigned* st) {
    XcdBarrier b; b.bar = bar; b.x = xb_xcc_id(); b.st = st;
    if (threadIdx.x == 0) (void)xb_add(&bar[XB_XCNT(b.x)], 1u);
    return b;
}
__device__ __forceinline__ void xcd_barrier_complete(unsigned* bar, unsigned x, unsigned& nloc, unsigned& nx) {
    const unsigned G = gridDim.x * gridDim.y * gridDim.z;
    unsigned sum, cnt, mine, sp = 0u;
    for (;;) {
        sum = 0u; cnt = 0u; mine = 0u;
#pragma unroll
        for (unsigned j = 0; j < 16; ++j) { const unsigned c = xb_ld(&bar[XB_XCNT(j)]); sum += c; cnt += (c > 0u) ? 1u : 0u; mine = (j == x) ? c : mine; }
        if (sum == G) break;
        __builtin_amdgcn_s_sleep(1);
        if ((++sp & 255u) == 0u) { if (xb_ld(&bar[XB_TMO])) break; if (sp > XB_SPIN_CAP) { atomicAdd(&bar[XB_TMO], 1u); break; } }
    }
    nloc = mine > 0u ? mine : 1u; nx = cnt > 0u ? cnt : 1u;
}
__device__ __forceinline__ void xcd_barrier(const XcdBarrier& b) {
    asm volatile("s_waitcnt vmcnt(0)" ::: "memory");
    __syncthreads();
    if (threadIdx.x == 0) {
        unsigned* bar = b.bar;
        __builtin_amdgcn_s_waitcnt(0);
        unsigned nloc = b.st[0], nx = b.st[1];
        if (nloc == 0u) { xcd_barrier_complete(bar, b.x, nloc, nx); b.st[0] = nloc; b.st[1] = nx; }
        const unsigned old = xb_add(&bar[XB_XSUB(b.x)], 1u);
        const unsigned gen = old / nloc;
        if (old + 1u == (gen + 1u) * nloc) {
            __builtin_amdgcn_fence(__ATOMIC_RELEASE, "agent");
            asm volatile("s_waitcnt vmcnt(0)" ::: "memory");
            const unsigned og = xb_add(&bar[XB_TOP], 1u);
            const unsigned tg = og / nx;
            if (og + 1u == (tg + 1u) * nx) xb_add(&bar[XB_TOPGEN], 1u);
            else XB_SPIN(xb_ld(&bar[XB_TOPGEN]) == tg, bar);
            __builtin_amdgcn_fence(__ATOMIC_ACQUIRE, "agent");
            xb_add(&bar[XB_XGEN(b.x)], 1u);
            asm volatile("s_waitcnt vmcnt(0)" ::: "memory");
        } else {
            XB_SPIN(xb_ld(&bar[XB_XGEN(b.x)]) == gen, bar);
            __builtin_amdgcn_fence(__ATOMIC_ACQUIRE, "agent");
            asm volatile("s_waitcnt vmcnt(0)" ::: "memory");
        }
    }
    __syncthreads();
}

struct Args { const float* in[19]; float* out; unsigned char* ws; int ph_lo, ph_hi; };
#ifdef TPH
#define TSTART(k) do { if ((k) == TPH) C.tph0 = __builtin_amdgcn_s_memrealtime(); } while (0)
#define TSTOP(k) do { if ((k) == TPH) C.tphd += __builtin_amdgcn_s_memrealtime() - C.tph0; } while (0)
#else
#define TSTART(k) do {} while (0)
#define TSTOP(k) do {} while (0)
#endif
struct Ctx {
    unsigned long long tph0, tphd;
    unsigned char* lds; int tid, lane, wave, G, bid;
    const float *x, *norm_mix, *w_in, *conv_w, *conv_b, *dt_bias, *a_log, *d_skip, *ssd_norm, *sinks, *attn_norm, *w_out, *norm_ffn, *w_rg, *w_re, *w_gate, *w_up, *w_down, *norm_final;
    float* out; unsigned char* ws;
    bf16 *XN, *PROJ, *HID, *YB, *ST, *MIX, *WIN, *WOUT, *WGU, *WD, *HALO, *WRH, *WRL; float *RS, *RATT, *RSG, *LRS, *LG; int vcu; float *DT, *CDEC, *TG; int *TE, *TP, *LIST; unsigned* ctl;
};

namespace pg8 {
typedef short bf16x8 __attribute__((ext_vector_type(8)));
constexpr int BM = 256, BK = 64, HALF = 128, HTB = HALF * BK * 2, STAGE_BYTES = 8 * HTB, NXCD = 8, WGM = 8;
__device__ __forceinline__ int lds_byte(int r, int c) { const int st = (r >> 4) * 2 + (c >> 5), rr = r & 15, cc = c & 31, ob = rr * 64 + cc * 2; return st * 1024 + (ob ^ (((ob >> 9) & 1) << 5)); }
__device__ __forceinline__ void stage_rc(int b, int& R, int& C) { const int st = b / 1024, sb = b % 1024, swz = sb ^ (((sb >> 9) & 1) << 5); R = (st >> 1) * 16 + swz / 64; C = (st & 1) * 32 + (swz % 64) / 2; }
__device__ __forceinline__ int perm32(int rho) { const int n = rho >> 4, i = rho & 15; return 8 * (i >> 2) + 4 * n + (i & 3); }
__device__ __forceinline__ unsigned cvt_pk_bf16(float lo, float hi) { unsigned r; asm volatile("v_cvt_pk_bf16_f32 %0, %1, %2" : "=v"(r) : "v"(lo), "v"(hi)); return r; }

struct Unit { int pm, pn, e, mt, rowbase, cnt, par; const char* bt; };

struct DenseOrder {
    int nM, nN, nwg, G, c, K; const char* Bt;
    __device__ void init(int M, int N, int K_, const bf16* Bt_, int G_, int c_) { nM = M / BM; nN = N / BM; nwg = nM * nN; G = G_; c = c_; K = K_; Bt = (const char*)Bt_; }
    __device__ __forceinline__ bool next(int i, Unit& u) const {
        const long L = (long)i * G + c; if (L >= nwg) return false;
        int wgid = (int)L; { const int q = nwg / NXCD, r = nwg % NXCD, xcd = wgid % NXCD, off = wgid / NXCD; wgid = (xcd < r ? xcd * (q + 1) : r * (q + 1) + (xcd - r) * q) + off; }
        const int nig = WGM * nN, gid = wgid / nig, fm = gid * WGM, gsz = (nM - fm) < WGM ? (nM - fm) : WGM;
        u.pm = fm + ((wgid % nig) % gsz); u.pn = (wgid % nig) / gsz; u.e = 0; u.mt = 0; u.rowbase = u.pm * BM; u.cnt = BM;
        u.bt = Bt + (size_t)u.pn * BM * K * 2; return true;
    }
    __device__ __forceinline__ unsigned arow(const Unit& u, int R) const { return (unsigned)(u.rowbase + R); }
};
template <bool GATHER> struct MoeOrder {
    const int *cnt, *pstart, *tstart; const int* LIST; const char* W; size_t wstride; int K, npn, ntiles, G, c;
    __device__ __forceinline__ bool next(int i, Unit& u) const {
        const long L = (long)i * G + c; if (L >= (long)ntiles * npn) return false;
        const int tile = (int)(L / npn); u.pn = (int)(L % npn); u.pm = tile;
        int e = 0; while (tstart[e + 1] <= tile) ++e;
        u.e = e; u.mt = tile - tstart[e]; u.rowbase = pstart[e] + u.mt * BM; u.cnt = cnt[e];
        u.bt = W + (size_t)e * wstride + (size_t)u.pn * BM * K * 2; return true;
    }
    __device__ __forceinline__ unsigned arow(const Unit& u, int R) const {
        if (GATHER) { const int pos = u.mt * BM + R; return pos < u.cnt ? (unsigned)(LIST[(size_t)u.e * LISTCAP + pos] >> 1) : 0u; }
        return (unsigned)(u.rowbase + R);
    }
};

struct EpiProj {
    static constexpr bool PERM = true, KSEG = false, UBEGIN = false; bf16* O; int ldc; bf16* HALO;
    __device__ __forceinline__ void operator()(const f32x4 (&acc)[2][2][4][2], const Unit& u, int wr, int wc, int fr, int fq) const {
        bf16* base = O + (size_t)(u.pm * BM + wr * 64 + fr) * ldc + u.pn * BM + wc * 32 + 8 * fq;
#pragma unroll
        for (int ai = 0; ai < 2; ++ai)
#pragma unroll
            for (int m = 0; m < 4; ++m) { bf16* rowp = base + (size_t)(ai * HALF + m * 16) * ldc;
#pragma unroll
                for (int bj = 0; bj < 2; ++bj) { const f32x4 v0 = acc[ai][bj][m][0], v1 = acc[ai][bj][m][1];
                    u32x4 w; w.x = cvt_pk_bf16(v0[0], v0[1]); w.y = cvt_pk_bf16(v0[2], v0[3]); w.z = cvt_pk_bf16(v1[0], v1[1]); w.w = cvt_pk_bf16(v1[2], v1[3]);
                    *(u32x4*)(rowp + bj * HALF) = w;
                    if (m == 3 && wr == 1 && fr >= 13 && u.pn >= 4 && u.pn < 10) {
                        const int row = u.pm * BM + ai * HALF + 125 + (fr - 13), col = u.pn * BM + bj * HALF + wc * 32 + 8 * fq - 1024;
                        *(u32x4*)(HALO + ((size_t)(row >> 7) * 3 + (fr - 13)) * CONVCH + col) = w; } } }
    }
};
struct EpiResid {
    static constexpr bool PERM = true, KSEG = true, UBEGIN = true; const float* base; float* out; bf16* HB; const float* RSG; const float* RATT; LAS float* tab;
    __device__ __forceinline__ f32x4 unit_fetch(const Unit& u) const {
        const int tid = threadIdx.x; f32x4 r = (f32x4){1.f, 1.f, 1.f, 0.f};
        if (tid < 256) { const size_t row = (size_t)(u.pm * BM + tid); r[0] = RSG[row * 2]; r[1] = RSG[row * 2 + 1]; r[2] = RATT[row]; }
        return r;
    }
    __device__ __forceinline__ void unit_commit(const Unit& u, const f32x4 r) const {
        const int tid = threadIdx.x;
        if (tid < 256) { LAS float* tb = tab + u.par * 768; tb[tid] = r[0] * __builtin_amdgcn_rcpf(r[1]); tb[256 + tid] = r[1] * __builtin_amdgcn_rcpf(r[2]); tb[512 + tid] = r[2]; }
    }
    __device__ __forceinline__ void kseg(f32x4 (&acc)[2][2][4][2], const Unit& u, int t, int wr, int fr) const {
        const LAS float* tb = tab + u.par * 768 + (t == 8 ? 0 : 256) + wr * 64 + fr;
#pragma unroll
        for (int ai = 0; ai < 2; ++ai)
#pragma unroll
            for (int m = 0; m < 4; ++m) { const float rt = tb[ai * HALF + m * 16];
#pragma unroll
                for (int bj = 0; bj < 2; ++bj)
#pragma unroll
                    for (int n = 0; n < 2; ++n) acc[ai][bj][m][n] *= rt; }
    }
    __device__ __forceinline__ void operator()(const f32x4 (&acc)[2][2][4][2], const Unit& u, int wr, int wc, int fr, int fq) const {
        const size_t o0 = (size_t)(u.pm * BM + wr * 64 + fr) * DM + u.pn * BM + wc * 32 + 8 * fq;
#pragma unroll
        for (int ai = 0; ai < 2; ++ai) {
            f32x4 bv[4][2][2];
#pragma unroll
            for (int m = 0; m < 4; ++m)
#pragma unroll
                for (int bj = 0; bj < 2; ++bj)
#pragma unroll
                    for (int n = 0; n < 2; ++n) bv[m][bj][n] = *(const f32x4*)(base + o0 + (size_t)(ai * HALF + m * 16) * DM + bj * HALF + n * 4);
            __builtin_amdgcn_sched_barrier(0);
#pragma unroll
            for (int m = 0; m < 4; ++m)
#pragma unroll
                for (int bj = 0; bj < 2; ++bj) { const size_t off = o0 + (size_t)(ai * HALF + m * 16) * DM + bj * HALF;
                    const float sl = tab[u.par * 768 + 512 + ai * HALF + wr * 64 + m * 16 + fr];
                    const f32x4 v0 = bv[m][bj][0] + acc[ai][bj][m][0] * sl, v1 = bv[m][bj][1] + acc[ai][bj][m][1] * sl;
                    u32x4 w; w.x = cvt_pk_bf16(v0[0], v0[1]); w.y = cvt_pk_bf16(v0[2], v0[3]); w.z = cvt_pk_bf16(v1[0], v1[1]); w.w = cvt_pk_bf16(v1[2], v1[3]);
                    *(u32x4*)(HB + off) = w; }
            __builtin_amdgcn_sched_barrier(0);
        }
    }
};
struct EpiHid {
    static constexpr bool PERM = true, KSEG = false, UBEGIN = true; bf16* HID; const int* LIST; const float* RS; LAS float* tab;
    __device__ __forceinline__ f32x4 unit_fetch(const Unit& u) const {
        const int tid = threadIdx.x; f32x4 r = (f32x4){0.f, 0.f, 0.f, 0.f};
        if (tid < 256) { const int pos = u.mt * BM + tid; if (pos < u.cnt) r[0] = RS[(size_t)u.e * LISTCAP + pos]; }
        return r;
    }
    __device__ __forceinline__ void unit_commit(const Unit& u, const f32x4 r) const { const int tid = threadIdx.x; if (tid < 256) tab[u.par * 256 + tid] = r[0]; }
    __device__ __forceinline__ void operator()(const f32x4 (&acc)[2][2][4][2], const Unit& u, int wr, int wc, int fr, int fq) const {
        bf16* base = HID + (size_t)(u.rowbase + wr * 64 + fr) * FF + u.pn * 128 + wc * 32 + 8 * fq;
#pragma unroll
        for (int ai = 0; ai < 2; ++ai)
#pragma unroll
            for (int m = 0; m < 4; ++m) { f32x4 h0, h1; const int pos = u.mt * BM + ai * HALF + wr * 64 + m * 16 + fr;
                const float rs = tab[u.par * 256 + ai * HALF + wr * 64 + m * 16 + fr]; (void)pos;
#pragma unroll
                for (int i = 0; i < 4; ++i) { h0[i] = silu_f(rs * acc[ai][0][m][0][i]) * (rs * acc[ai][1][m][0][i]); h1[i] = silu_f(rs * acc[ai][0][m][1][i]) * (rs * acc[ai][1][m][1][i]); }
                u32x4 w; w.x = cvt_pk_bf16(h0[0], h0[1]); w.y = cvt_pk_bf16(h0[2], h0[3]); w.z = cvt_pk_bf16(h1[0], h1[1]); w.w = cvt_pk_bf16(h1[2], h1[3]);
                *(u32x4*)(base + (size_t)(ai * HALF + m * 16) * FF) = w; }
    }
};
struct EpiYb {
    static constexpr bool PERM = true, KSEG = false, UBEGIN = true; bf16* YB; const int* LIST; const float* TG; LAS float* tab;
    __device__ __forceinline__ f32x4 unit_fetch(const Unit& u) const {
        const int tid = threadIdx.x; f32x4 r = (f32x4){0.f, 0.f, 0.f, 0.f};
        if (tid < 256) { const int pos = u.mt * BM + tid; if (pos < u.cnt) r[0] = TG[(size_t)u.e * LISTCAP + pos]; }
        return r;
    }
    __device__ __forceinline__ void unit_commit(const Unit& u, const f32x4 r) const { const int tid = threadIdx.x; if (tid < 256) tab[u.par * 256 + tid] = r[0]; }
    __device__ __forceinline__ void operator()(const f32x4 (&acc)[2][2][4][2], const Unit& u, int wr, int wc, int fr, int fq) const {
        bf16* base = YB + (size_t)(u.rowbase + wr * 64 + fr) * DM + u.pn * BM + wc * 32 + 8 * fq;
#pragma unroll
        for (int ai = 0; ai < 2; ++ai)
#pragma unroll
            for (int m = 0; m < 4; ++m) { const int pos = u.mt * BM + ai * HALF + wr * 64 + m * 16 + fr;
                const float gt = tab[u.par * 256 + ai * HALF + wr * 64 + m * 16 + fr]; (void)pos;
#pragma unroll
                for (int bj = 0; bj < 2; ++bj) { const f32x4 v0 = acc[ai][bj][m][0] * gt, v1 = acc[ai][bj][m][1] * gt;
                    u32x4 w; w.x = cvt_pk_bf16(v0[0], v0[1]); w.y = cvt_pk_bf16(v0[2], v0[3]); w.z = cvt_pk_bf16(v1[0], v1[1]); w.w = cvt_pk_bf16(v1[2], v1[3]);
                    *(u32x4*)(base + (size_t)(ai * HALF + m * 16) * DM + bj * HALF) = w; } }
    }
};

template <class Epi, class Sched, bool ALIGN_EPI>
__device__ __forceinline__ void gemm_phase(LAS unsigned char* lds, const char* Abase, const int K, const Sched& S, const Epi& E) {
    const int tid = threadIdx.x, wid = __builtin_amdgcn_readfirstlane(tid >> 6), lane = tid & 63, wr = wid >> 2, wc = wid & 3, fr = lane & 15, fq = lane >> 4;
    const int nt = K / BK;
    int Rp[2], Cp[2]; unsigned voffB[2];
#pragma unroll
    for (int i = 0; i < 2; ++i) { int R, C; stage_rc(tid * 16 + i * 8192, R, C); Rp[i] = R; Cp[i] = C; const int Rb = Epi::PERM ? ((R & ~31) + perm32(R & 31)) : R; voffB[i] = (unsigned)(Rb * K + C) * 2u; }
    const size_t kstep = (size_t)(BK * 2);
    const size_t hstep = (size_t)HALF * K * 2;
    const unsigned ldsw = (unsigned)wid * 1024u;
    const int aoff = lds_byte(wr * 64 + fr, fq * 8), boff = lds_byte(wc * 32 + fr, fq * 8);
#define PG8_SA(b, h) (((b) * 2 + (h)) * HTB)
#define PG8_SB(b, h) ((4 + (b) * 2 + (h)) * HTB)
#define PG8_STAGE(bufoff, gbase, voff) do { _Pragma("unroll") for (int _i = 0; _i < 2; ++_i) \
        __builtin_amdgcn_global_load_lds((const unsigned*)((const char*)(gbase) + (voff)[_i]), (LAS unsigned*)(lds + (bufoff) + ldsw + _i * 8192), 16, 0, 0); } while (0)
#define PG8_LDA(dst, b, h) do { _Pragma("unroll") for (int m = 0; m < 4; ++m) _Pragma("unroll") for (int k = 0; k < 2; ++k) dst[m][k] = *(const LAS bf16x8*)(lds + PG8_SA(b, h) + aoff + m * 2048 + k * 1024); } while (0)
#define PG8_LDB(dst, b, h) do { _Pragma("unroll") for (int n = 0; n < 2; ++n) _Pragma("unroll") for (int k = 0; k < 2; ++k) dst[n][k] = *(const LAS bf16x8*)(lds + PG8_SB(b, h) + boff + n * 2048 + k * 1024); } while (0)
#define PG8_MMA(ai, bj, At, Bt) do { __builtin_amdgcn_s_setprio(1); _Pragma("unroll") for (int m = 0; m < 4; ++m) _Pragma("unroll") for (int n = 0; n < 2; ++n) _Pragma("unroll") for (int k = 0; k < 2; ++k) \
        acc[ai][bj][m][n] = __builtin_amdgcn_mfma_f32_16x16x32_bf16(Bt[n][k], At[m][k], acc[ai][bj][m][n], 0, 0, 0); __builtin_amdgcn_s_setprio(0); } while (0)
#define PG8_WAIT_V(n) asm volatile("s_waitcnt vmcnt(" #n ")" ::: "memory")
#define PG8_WAIT_L(n) asm volatile("s_waitcnt lgkmcnt(" #n ")" ::: "memory")
#define PG8_BAR __builtin_amdgcn_s_barrier()
#define PG8_SCHED __builtin_amdgcn_sched_barrier(0)
#define PG8_OFFS(dst, un) do { _Pragma("unroll") for (int _h = 0; _h < 2; ++_h) _Pragma("unroll") for (int _i = 0; _i < 2; ++_i) \
        dst[_h][_i] = (S.arow(un, _h * HALF + Rp[_i]) * (unsigned)K + (unsigned)Cp[_i]) * 2u; } while (0)
    Unit cur, nxt; int ui = 0;
    if (!S.next(0, cur)) return;
    f32x4 acc[2][2][4][2];
#pragma unroll
    for (int a = 0; a < 2; ++a)
#pragma unroll
        for (int b = 0; b < 2; ++b)
#pragma unroll
            for (int m = 0; m < 4; ++m)
#pragma unroll
                for (int n = 0; n < 2; ++n) acc[a][b][m][n] = (f32x4){0.f, 0.f, 0.f, 0.f};
    bf16x8 At[4][2], B0[2][2], B1[2][2];
    unsigned co[2][2], no[2][2];
    cur.par = 0;
    if constexpr (Epi::UBEGIN) E.unit_commit(cur, E.unit_fetch(cur));
    PG8_OFFS(co, cur);
    const char* cB = cur.bt;
    PG8_STAGE(PG8_SB(0, 0), cB, voffB); PG8_STAGE(PG8_SB(0, 1), cB + hstep, voffB); PG8_STAGE(PG8_SA(0, 0), Abase, co[0]); PG8_STAGE(PG8_SA(0, 1), Abase, co[1]);
    if (wr == 1) PG8_BAR;
    PG8_WAIT_V(2); PG8_BAR;
    PG8_STAGE(PG8_SB(1, 0), cB + kstep, voffB); PG8_STAGE(PG8_SA(1, 0), Abase + kstep, co[0]); PG8_STAGE(PG8_SB(1, 1), cB + hstep + kstep, voffB);
    PG8_WAIT_V(6); PG8_BAR;
    for (;;) {
        const bool has_next = S.next(ui + 1, nxt);
        nxt.par = (ui + 1) % 3;
        f32x4 pend = (f32x4){0.f, 0.f, 0.f, 0.f};
        if constexpr (Epi::UBEGIN) { if (has_next) pend = E.unit_fetch(nxt); }
        if (has_next) { PG8_OFFS(no, nxt); } else {
#pragma unroll
            for (int h = 0; h < 2; ++h) { no[h][0] = co[h][0]; no[h][1] = co[h][1]; } }
        const char* nB = has_next ? nxt.bt : cB;
        for (int t = 0; t < nt; t += 2) {
            const bool last = (t == nt - 2);
            const char* a1 = Abase + (size_t)(t + 1) * kstep;
            const char* a2 = last ? Abase : Abase + (size_t)(t + 2) * kstep; const char* b2 = last ? nB : cB + (size_t)(t + 2) * kstep;
            const char* a3 = a2 + kstep; const char* b3 = b2 + kstep;
            unsigned s2[2][2];
#pragma unroll
            for (int h = 0; h < 2; ++h) { s2[h][0] = last ? no[h][0] : co[h][0]; s2[h][1] = last ? no[h][1] : co[h][1]; }
            if constexpr (Epi::KSEG) { if (t == 8 || t == 16) E.kseg(acc, cur, t, wr, fr); }
            PG8_LDB(B0, 0, 0); PG8_LDB(B1, 0, 1); PG8_SCHED; PG8_LDA(At, 0, 0); PG8_STAGE(PG8_SA(1, 1), a1, co[1]);
            PG8_WAIT_V(8); PG8_WAIT_L(0); PG8_BAR; PG8_MMA(0, 0, At, B0); PG8_MMA(0, 1, At, B1); PG8_BAR; PG8_SCHED;
            PG8_LDA(At, 0, 1); PG8_STAGE(PG8_SB(0, 0), b2, voffB); PG8_STAGE(PG8_SB(0, 1), b2 + hstep, voffB); PG8_STAGE(PG8_SA(0, 0), a2, s2[0]);
            PG8_WAIT_V(8); PG8_WAIT_L(0); PG8_BAR; PG8_MMA(1, 0, At, B0); PG8_MMA(1, 1, At, B1); PG8_BAR; PG8_SCHED;
            PG8_LDB(B0, 1, 0); PG8_LDB(B1, 1, 1); PG8_SCHED; PG8_LDA(At, 1, 0); PG8_STAGE(PG8_SA(0, 1), a2, s2[1]);
            PG8_WAIT_V(8); PG8_WAIT_L(0); PG8_BAR; PG8_MMA(0, 0, At, B0); PG8_MMA(0, 1, At, B1); PG8_BAR; PG8_SCHED;
            PG8_LDA(At, 1, 1); PG8_STAGE(PG8_SB(1, 0), b3, voffB); PG8_STAGE(PG8_SB(1, 1), b3 + hstep, voffB); PG8_STAGE(PG8_SA(1, 0), a3, s2[0]);
            PG8_WAIT_V(8); PG8_WAIT_L(0); PG8_BAR; PG8_MMA(1, 0, At, B0); PG8_MMA(1, 1, At, B1); PG8_BAR; PG8_SCHED;
        }
        if constexpr (ALIGN_EPI) { if (wr == 0) PG8_BAR; }
        E(acc, cur, wr, wc, fr, fq);
        if (!has_next) break;
        if constexpr (Epi::UBEGIN) E.unit_commit(nxt, pend);
#pragma unroll
        for (int a = 0; a < 2; ++a)
#pragma unroll
            for (int b = 0; b < 2; ++b)
#pragma unroll
                for (int m = 0; m < 4; ++m)
#pragma unroll
                    for (int n = 0; n < 2; ++n) acc[a][b][m][n] = (f32x4){0.f, 0.f, 0.f, 0.f};
        cur = nxt; cB = nB; ++ui;
#pragma unroll
        for (int h = 0; h < 2; ++h) { co[h][0] = no[h][0]; co[h][1] = no[h][1]; }
        if constexpr (ALIGN_EPI) { if (wr == 1) PG8_BAR; }
    }
    PG8_WAIT_V(0);
    if constexpr (!ALIGN_EPI) { if (wr == 0) PG8_BAR; }
    PG8_BAR;
#undef PG8_SA
#undef PG8_SB
#undef PG8_STAGE
#undef PG8_LDA
#undef PG8_LDB
#undef PG8_MMA
#undef PG8_WAIT_V
#undef PG8_WAIT_L
#undef PG8_BAR
#undef PG8_SCHED
#undef PG8_OFFS
}
}

__device__ __forceinline__ void transpose_load(const float* W, int ldw, int k0, int n0, int lane, const float* kscale, float (&tv)[32], f32x4 (&ks)[2]) {
#pragma unroll
    for (int i = 0; i < 32; ++i) { const int kk = 2 * i + (lane >> 5); tv[i] = W[(size_t)(k0 + kk) * ldw + n0 + (lane & 31)]; }
    ks[0] = (f32x4){1.f, 1.f, 1.f, 1.f}; ks[1] = ks[0];
    if (kscale) { ks[0] = *(const f32x4*)(kscale + k0 + 8 * (lane & 7)); ks[1] = *(const f32x4*)(kscale + k0 + 8 * (lane & 7) + 4); }
}
__device__ __forceinline__ void transpose_store(const float (&tv)[32], const f32x4 (&ks)[2], bf16* WT, int K, int drow0, int k0, LAS float* scr, int lane) {
#pragma unroll
    for (int i = 0; i < 32; ++i) { const int kk = 2 * i + (lane >> 5); scr[kk * 33 + (lane & 31)] = tv[i]; }
    asm volatile("s_waitcnt lgkmcnt(0)" ::: "memory");
    const int c = lane & 7;
#pragma unroll
    for (int j = 0; j < 4; ++j) { const int n = (lane >> 3) + 8 * j; const LAS float* s = scr + (8 * c) * 33 + n;
        u32x4 o; o.x = pk2(s[0 * 33] * ks[0][0], s[1 * 33] * ks[0][1]); o.y = pk2(s[2 * 33] * ks[0][2], s[3 * 33] * ks[0][3]); o.z = pk2(s[4 * 33] * ks[1][0], s[5 * 33] * ks[1][1]); o.w = pk2(s[6 * 33] * ks[1][2], s[7 * 33] * ks[1][3]);
        *(u32x4*)(WT + (size_t)(drow0 + n) * K + k0 + 8 * c) = o; }
    asm volatile("s_waitcnt lgkmcnt(0)" ::: "memory");
}
__device__ __forceinline__ void transpose_item(const float* W, int ldw, int k0, int n0, bf16* WT, int K, int drow0, LAS float* scr, int lane, const float* kscale = nullptr) {
    float tv[32]; f32x4 ks[2];
    transpose_load(W, ldw, k0, n0, lane, kscale, tv, ks);
    transpose_store(tv, ks, WT, K, drow0, k0, scr, lane);
}

__device__ __forceinline__ void phase_prologue(Ctx& C) {
    constexpr int WRS = 2064;
    TSTART(1000);
    LAS unsigned char* WH = (LAS unsigned char*)C.lds;
    LAS unsigned char* WLo = WH + 33024;
    LAS float* PD = (LAS float*)(WH + 66048);
    {   float wv[32];
#pragma unroll
        for (int i = 0; i < 32; ++i) { const int idx = C.tid + NTHREADS * i, kk = idx >> 4, j = idx & 15; wv[i] = C.w_in[(size_t)kk * INDIM + DT0 + j]; }
#pragma unroll
        for (int i = 0; i < 32; ++i) { const int idx = C.tid + NTHREADS * i, kk = idx >> 4, j = idx & 15; const float v = wv[i];
            const unsigned hi = f2bf(v); *(LAS bf16*)(WH + j * WRS + kk * 2) = (bf16)hi; *(LAS bf16*)(WLo + j * WRS + kk * 2) = (bf16)f2bf(v - bf2f(hi)); } }
    __syncthreads();
    TSTOP(1000); TSTART(1001);
    const int gw = C.bid * NWAVES + C.wave, NGW = C.G * NWAVES;
    const int lane = C.lane, r32 = lane & 31, h = lane >> 5, w = C.wave, tt = w & 3, kh = w >> 2;
    for (int rb = C.bid; rb < M / 128; rb += C.G) {
        const int row0 = rb * 128 + w;
        f32x4 gn[4], ring[4][4];
#pragma unroll
        for (int j = 0; j < 4; ++j) gn[j] = ((const f32x4*)C.norm_mix)[lane + 64 * j];
#pragma unroll
        for (int s = 0; s < 4; ++s)
#pragma unroll
            for (int j = 0; j < 4; ++j) ring[s][j] = ((const f32x4*)(C.x + (size_t)(row0 + 8 * s) * DM) + lane)[64 * j];
#pragma unroll
        for (int i = 0; i < 16; ++i) {
            const int row = row0 + 8 * i;
            f32x4 v[4];
#pragma unroll
            for (int j = 0; j < 4; ++j) v[j] = ring[i & 3][j];
            if (i + 4 < 16) {
#pragma unroll
                for (int j = 0; j < 4; ++j) ring[i & 3][j] = ((const f32x4*)(C.x + (size_t)(row + 32) * DM) + lane)[64 * j];
            }
            float ss = 0.f;
#pragma unroll
            for (int j = 0; j < 4; ++j) ss += v[j][0] * v[j][0] + v[j][1] * v[j][1] + v[j][2] * v[j][2] + v[j][3] * v[j][3];
            const float rstd = 1.0f / sqrtf(wave_sum(ss) * (1.0f / DM) + EPS);
            u32x2* o = (u32x2*)(C.XN + (size_t)row * DM) + lane;
#pragma unroll
            for (int j = 0; j < 4; ++j) { const f32x4 g = gn[j]; v[j] = v[j] * rstd * g; u32x2 wv; wv.x = cvtpk(v[j][0], v[j][1]); wv.y = cvtpk(v[j][2], v[j][3]); o[64 * j] = wv; }
            __builtin_amdgcn_sched_barrier(0);
        }
        __syncthreads();
        TSTOP(1001); TSTART(1002);
        f32x16 acc;
#pragma unroll
        for (int r = 0; r < 16; ++r) acc[r] = 0.f;
        const bf16* xp = C.XN + (size_t)(rb * 128 + 32 * tt + r32) * DM + 512 * kh + 8 * h;
        LAS const unsigned char* wa = WH + (lane & 15) * WRS + (512 * kh + 8 * h) * 2;
#pragma unroll 1
        for (int kb = 0; kb < 4; ++kb) {
            bf16x8 xf[8];
#pragma unroll
            for (int i = 0; i < 8; ++i) xf[i] = *(const bf16x8*)(xp + (kb * 8 + i) * 16);
            __builtin_amdgcn_sched_barrier(0);
#pragma unroll
            for (int i = 0; i < 8; ++i) { const bf16x8 ah = *(LAS const bf16x8*)(wa + (kb * 8 + i) * 32), al = *(LAS const bf16x8*)(wa + 33024 + (kb * 8 + i) * 32);
                acc = MFMA32(ah, xf[i], acc); acc = MFMA32(al, xf[i], acc); }
            __builtin_amdgcn_sched_barrier(0);
        }
        if (kh == 1) {
#pragma unroll
            for (int r = 0; r < 8; ++r) PD[(tt * 8 + r) * 64 + lane] = acc[r];
        }
        __syncthreads();
        if (kh == 0) {
#pragma unroll
            for (int r = 0; r < 8; ++r) { const int col = (r & 3) + 8 * (r >> 2) + 4 * h;
                const float dv = acc[r] + PD[(tt * 8 + r) * 64 + lane] + C.dt_bias[col];
                C.DT[(size_t)(rb * 128 + 32 * tt + r32) * 16 + col] = softplus_f(dv); }
        }
        __syncthreads();
    }
    TSTOP(1002); TSTART(1003);
    __syncthreads();
    for (int idx = C.bid * NTHREADS + C.tid; idx < 96 * 1024; idx += C.G * NTHREADS) {
        const int e = idx >> 10, kk = idx & 1023;
        float v = 0.f; if (e < 64) v = C.w_re[kk * 64 + e]; else if (e < 72) v = C.w_rg[kk * 8 + (e - 64)];
        v *= C.norm_ffn[kk];
        const unsigned hi = f2bf(v); C.WRH[idx] = (bf16)hi; C.WRL[idx] = (bf16)f2bf(v - bf2f(hi));
    }
    LAS float* scr = (LAS float*)((LAS unsigned char*)C.lds + C.wave * 8704);
    for (int it = gw; it < 1920 + 1024; it += NGW) {
        if (it < 1920) { const int kb = it / 120, nb = it % 120, n0 = nb * 32; transpose_item(C.w_in, INDIM, kb * 64, n0 < DT0 ? n0 : n0 + 16, C.WIN, DM, n0, scr, C.lane); }
        else { const int r = it - 1920, kb = r >> 5, nb = r & 31; transpose_item(C.w_out, DM, kb * 64, nb * 32, C.WOUT, 2048, nb * 32, scr, C.lane, kb < 16 ? C.ssd_norm : C.attn_norm - 1024); }
    }
    TSTOP(1003);
}

__device__ __forceinline__ void phase_gemm1(Ctx& C) {
    pg8::DenseOrder S; S.init(M, NPROJ, DM, C.WIN, C.G - NCONV, C.bid - NCONV);
    pg8::EpiProj E{C.PROJ, NPROJ, C.HALO};
    pg8::gemm_phase<pg8::EpiProj, pg8::DenseOrder, true>((LAS unsigned char*)C.lds, (const char*)C.XN, DM, S, E);
}

constexpr int KRS = 144, VRS = 192;
__device__ __forceinline__ void attn_unit_fast(Ctx& C, int u) {
    const int blk = u & 31, b = u >> 5, t0 = blk * 128;
    LAS unsigned char* L = (LAS unsigned char*)C.lds;
    LAS unsigned char* Kimg = L;
    LAS unsigned char* Vimg = L + 36864;
    LAS float* ssq = (LAS float*)(L + 86016);
    LAS float* rsv = ssq + 16 * 128;
    const int lane = C.lane, r32 = lane & 31, h = lane >> 5, q4 = (lane & 15) >> 2, p4 = lane & 3, b16 = (lane >> 4) & 1;
    const float c2 = 0.125f * 1.4426950408889634f;
    for (int kv = 0; kv < 2; ++kv) {
        TSTART(210);
        __syncthreads();
#pragma unroll
        for (int i = 0; i < 4; ++i) {
            const int idx = C.tid + NTHREADS * i, row = idx >> 3, ch = idx & 7, t = t0 - 128 + row;
            u32x4 kk = (u32x4){0u, 0u, 0u, 0u}, vv = (u32x4){0u, 0u, 0u, 0u};
            if (t >= 0) { const bf16* pr = C.PROJ + (size_t)(b * SEQ + t) * NPROJ; kk = *(const u32x4*)(pr + PK + kv * 64 + ch * 8); vv = *(const u32x4*)(pr + PV + kv * 64 + ch * 8); }
            *(LAS u32x4*)(Kimg + row * KRS + ch * 16) = kk; *(LAS u32x4*)(Vimg + row * VRS + ch * 16) = vv;
        }
        __syncthreads();
        TSTOP(210);
        const int hq = kv * 8 + C.wave;
        const float sink2 = C.sinks[hq] * 1.4426950408889634f;
        const bf16* qbase = C.PROJ + (size_t)(b * SEQ + t0 + r32) * NPROJ + PQ + hq * 64 + 8 * h;
        bf16x8 qf[4], qn[4];
#pragma unroll
        for (int d0 = 0; d0 < 4; ++d0) { qf[d0] = *(const bf16x8*)(qbase + 16 * d0); qn[d0] = qf[d0]; }
        for (int rb = 0; rb < 4; ++rb) {
            const int qi = 32 * rb + r32;
            if (rb < 3) {
#pragma unroll
                for (int d0 = 0; d0 < 4; ++d0) qn[d0] = *(const bf16x8*)(qbase + (size_t)(32 * (rb + 1)) * NPROJ + 16 * d0);
            }
            f32x16 o0, o1;
#pragma unroll
            for (int r = 0; r < 16; ++r) { o0[r] = 0.f; o1[r] = 0.f; }
            float m = sink2, l = (h == 0) ? 1.f : 0.f;
            const int kt0 = rb >> 1;
            const int dm = r32 - 4 * h;
            auto do_tile = [&](const int kt, const bool L0, const int M0, const bool L1, const int M1) __attribute__((always_inline)) {
                f32x16 p0, p1;
#pragma unroll
                for (int r = 0; r < 16; ++r) { p0[r] = 0.f; p1[r] = 0.f; }
                LAS const unsigned char* ka = Kimg + (kt * 64 + r32) * KRS + 16 * h;
#pragma unroll
                for (int d0 = 0; d0 < 4; ++d0) {
                    if (L0) { const bf16x8 a0 = *(LAS const bf16x8*)(ka + d0 * 32); p0 = MFMA32(a0, qf[d0], p0); }
                    if (L1) { const bf16x8 a1 = *(LAS const bf16x8*)(ka + 32 * KRS + d0 * 32); p1 = MFMA32(a1, qf[d0], p1); }
                }
                float mt = -INFINITY;
#pragma unroll
                for (int r = 0; r < 16; ++r) {
                    const int cr = (r & 3) + 8 * (r >> 2);
                    if (L0) { if (M0 == 1 && !(cr > dm)) p0[r] = -INFINITY; if (M0 == 2 && !(cr <= dm)) p0[r] = -INFINITY; mt = fmaxf(mt, p0[r]); }
                    if (L1) { if (M1 == 1 && !(cr > dm)) p1[r] = -INFINITY; if (M1 == 2 && !(cr <= dm)) p1[r] = -INFINITY; mt = fmaxf(mt, p1[r]); }
                }
                mt = fmaxf(mt, __shfl_xor(mt, 32)) * c2;
                const float mn = fmaxf(m, mt), alpha = __builtin_amdgcn_exp2f(m - mn);
                m = mn;
                float ls = 0.f;
#pragma unroll
                for (int r = 0; r < 16; ++r) {
                    if (L0) { p0[r] = __builtin_amdgcn_exp2f(__builtin_fmaf(p0[r], c2, -mn)); ls += p0[r]; }
                    if (L1) { p1[r] = __builtin_amdgcn_exp2f(__builtin_fmaf(p1[r], c2, -mn)); ls += p1[r]; }
                }
                l = l * alpha + ls;
#pragma unroll
                for (int r = 0; r < 16; ++r) { o0[r] *= alpha; o1[r] *= alpha; }
                LAS const unsigned char* va = Vimg + (kt * 64 + 4 * h + q4) * VRS + 32 * b16 + 8 * p4;
#pragma unroll
                for (int s = 0; s < 4; ++s) {
                    if ((s < 2) ? L0 : L1) {
                        const bf16x8 pf = (s < 2) ? PACK8(p0, (s & 1) * 8) : PACK8(p1, (s & 1) * 8);
                        const bf16x8 v0f = cat8(tr16(va + (16 * s) * VRS), tr16(va + (16 * s + 8) * VRS));
                        const bf16x8 v1f = cat8(tr16(va + (16 * s) * VRS + 64), tr16(va + (16 * s + 8) * VRS + 64));
                        o0 = MFMA32(v0f, pf, o0); o1 = MFMA32(v1f, pf, o1);
                    }
                }
            };
            TSTART(211);
            if (blk > 0 || kt0 + 1 >= 2) do_tile(kt0 + 1, true, 0, true, 0);
            if (rb & 1) {
                if (blk > 0 || kt0 >= 2) do_tile(kt0, false, 0, true, 1);
                do_tile(kt0 + 2, true, 0, true, 2);
            } else {
                if (blk > 0 || kt0 >= 2) do_tile(kt0, true, 1, true, 0);
                do_tile(kt0 + 2, true, 2, false, 0);
            }
            TSTOP(211); TSTART(212);
            const float ltot = l + __shfl_xor(l, 32), inv = 1.0f / ltot;
            float sq = 0.f;
#pragma unroll
            for (int r = 0; r < 16; ++r) { o0[r] *= inv; o1[r] *= inv; sq += o0[r] * o0[r] + o1[r] * o1[r]; }
            sq += __shfl_xor(sq, 32);
            if (h == 0) ssq[hq * 128 + qi] = sq;
            bf16* op = C.MIX + (size_t)(b * SEQ + t0 + qi) * 2048 + 1024 + hq * 64 + 4 * h;
#pragma unroll
            for (int g = 0; g < 4; ++g) {
                u32x2 w0; w0.x = cvtpk(o0[4 * g], o0[4 * g + 1]); w0.y = cvtpk(o0[4 * g + 2], o0[4 * g + 3]); *(u32x2*)(op + 8 * g) = w0;
                u32x2 w1; w1.x = cvtpk(o1[4 * g], o1[4 * g + 1]); w1.y = cvtpk(o1[4 * g + 2], o1[4 * g + 3]); *(u32x2*)(op + 32 + 8 * g) = w1;
            }
#pragma unroll
            for (int d0 = 0; d0 < 4; ++d0) qf[d0] = qn[d0];
            TSTOP(212);
        }
    }
    __syncthreads();
    if (C.tid < 128) { float s = 0.f;
#pragma unroll
        for (int hh = 0; hh < 16; ++hh) s += ssq[hh * 128 + C.tid];
        C.RATT[b * SEQ + t0 + C.tid] = 1.0f / sqrtf(s * (1.0f / 1024.f) + EPS); }
    __syncthreads();
}

__device__ __forceinline__ void chunk_cumsum(const Ctx& C, int rowbase, int hd, float& d0, float& d1, float& c0, float& c1, float& total) {
    const float A = -expf(C.a_log[hd]);
    d0 = C.DT[(size_t)(rowbase + 2 * C.lane) * 16 + hd]; d1 = C.DT[(size_t)(rowbase + 2 * C.lane + 1) * 16 + hd];
    const float a0 = d0 * A, a1 = d1 * A;
    float v = a0 + a1;
#pragma unroll
    for (int o = 1; o < 64; o <<= 1) { const float t = __shfl_up(v, o); if (C.lane >= o) v += t; }
    c1 = v; c0 = v - a1; total = __shfl(v, 63);
}

constexpr int X4RS = 576, BRS = 320;
__device__ __forceinline__ void ssd_states_fast(Ctx& C, int u) {
    const int g = u & 1, c = (u >> 1) & 31, b = u >> 6, t0 = c * CHK, rowbase = b * SEQ + t0;
    LAS unsigned char* L = (LAS unsigned char*)C.lds;
    LAS unsigned char* XI = L;
    LAS unsigned char* BI = L + 73728;
    LAS float* WL = (LAS float*)(L + 114688);
    const int lane = C.lane, r32 = lane & 31, h = lane >> 5, q4 = (lane & 15) >> 2, p4 = lane & 3, b16 = (lane >> 4) & 1, w = C.wave;
    __syncthreads();
    TSTART(200);
    {
        float d0, d1, c0, c1, tot; chunk_cumsum(C, rowbase, g * 8 + w, d0, d1, c0, c1, tot);
        WL[w * 128 + 2 * lane] = d0 * expf(tot - c0); WL[w * 128 + 2 * lane + 1] = d1 * expf(tot - c1);
        if (lane == 0) C.CDEC[(b * NCH + c) * NH + g * 8 + w] = expf(tot);
    }
    TSTOP(200);
    for (int ps = 0; ps < 2; ++ps) {
        TSTART(201);
        const bool task = ps == 0 || C.tid < 256;
        const int cg = ps == 0 ? (C.tid & 63) : (C.tid & 31), run = ps == 0 ? (C.tid >> 6) : (C.tid >> 5);
        const int ch = ps == 1 ? g * 512 + 256 + cg * 8 : (cg < 32 ? g * 512 + cg * 8 : (cg < 48 ? 1024 + g * 128 + (cg - 32) * 8 : 1280 + g * 128 + (cg - 48) * 8));
        const int l0 = 16 * run;
        u32x4 raw[19];
#pragma unroll
        for (int i = 0; i < 19; ++i) raw[i] = (u32x4){0u, 0u, 0u, 0u};
        if (task) {
#pragma unroll
            for (int i = 0; i < 3; ++i) {
                if (l0 > 0) raw[i] = *(const u32x4*)(C.PROJ + (size_t)(rowbase + l0 + i - 3) * NPROJ + PX + ch);
                else if (c > 0) raw[i] = *(const u32x4*)(C.HALO + ((size_t)(b * NCH + c - 1) * 3 + i) * CONVCH + ch);
            }
#pragma unroll
            for (int i = 3; i < 19; ++i) raw[i] = *(const u32x4*)(C.PROJ + (size_t)(rowbase + l0 + i - 3) * NPROJ + PX + ch);
        }
        __syncthreads();
        TSTOP(201); TSTART(202);
        if (task) {
            float cw[4][8], cbias[8];
#pragma unroll
            for (int j = 0; j < 4; ++j) { const f32x4 a = *(const f32x4*)(C.conv_w + j * CONVCH + ch), bq = *(const f32x4*)(C.conv_w + j * CONVCH + ch + 4);
                cw[j][0] = a[0]; cw[j][1] = a[1]; cw[j][2] = a[2]; cw[j][3] = a[3]; cw[j][4] = bq[0]; cw[j][5] = bq[1]; cw[j][6] = bq[2]; cw[j][7] = bq[3]; }
            { const f32x4 a = *(const f32x4*)(C.conv_b + ch), bq = *(const f32x4*)(C.conv_b + ch + 4);
              cbias[0] = a[0]; cbias[1] = a[1]; cbias[2] = a[2]; cbias[3] = a[3]; cbias[4] = bq[0]; cbias[5] = bq[1]; cbias[6] = bq[2]; cbias[7] = bq[3]; }
#pragma unroll
            for (int i = 0; i < 16; ++i) {
                float o[8];
#pragma unroll
                for (int k = 0; k < 8; ++k) o[k] = cbias[k];
#pragma unroll
                for (int j = 0; j < 4; ++j) { const u32x4 rv = raw[i + j];
                    o[0] += cw[j][0] * bf2f(rv.x); o[1] += cw[j][1] * bf2f(rv.x >> 16); o[2] += cw[j][2] * bf2f(rv.y); o[3] += cw[j][3] * bf2f(rv.y >> 16);
                    o[4] += cw[j][4] * bf2f(rv.z); o[5] += cw[j][5] * bf2f(rv.z >> 16); o[6] += cw[j][6] * bf2f(rv.w); o[7] += cw[j][7] * bf2f(rv.w >> 16); }
                u32x4 pk; pk.x = cvtpk(silu_f(o[0]), silu_f(o[1])); pk.y = cvtpk(silu_f(o[2]), silu_f(o[3])); pk.z = cvtpk(silu_f(o[4]), silu_f(o[5])); pk.w = cvtpk(silu_f(o[6]), silu_f(o[7]));
                *(u32x4*)(C.PROJ + (size_t)(rowbase + l0 + i) * NPROJ + PX + ch) = pk;
                if (ps == 1 || cg < 32) *(LAS u32x4*)(XI + (l0 + i) * X4RS + (cg & 31) * 16) = pk;
                else if (cg < 48) *(LAS u32x4*)(BI + (l0 + i) * BRS + (cg - 32) * 16) = pk;
            }
        }
        __syncthreads();
        TSTOP(202); TSTART(203);
        const int hl = w & 3, hh = ps * 4 + hl, nt0 = 2 * (w >> 2);
        f32x16 acc[2][2];
#pragma unroll
        for (int i = 0; i < 2; ++i)
#pragma unroll
            for (int pt = 0; pt < 2; ++pt)
#pragma unroll
                for (int r = 0; r < 16; ++r) acc[i][pt][r] = 0.f;
#pragma unroll 2
        for (int ks = 0; ks < 8; ++ks) {
            const f32x4 w0 = *(LAS const f32x4*)(WL + hh * 128 + 16 * ks + 8 * h), w1 = *(LAS const f32x4*)(WL + hh * 128 + 16 * ks + 8 * h + 4);
            LAS const unsigned char* xa = XI + (16 * ks + 8 * h + q4) * X4RS + (hl * 64) * 2 + 32 * b16 + 8 * p4;
            LAS const unsigned char* ba = BI + (16 * ks + 8 * h + q4) * BRS + (nt0 * 32) * 2 + 32 * b16 + 8 * p4;
            bf16x8 xf[2];
#pragma unroll
            for (int pt = 0; pt < 2; ++pt) {
                const s16x4 lo = tr16(xa + pt * 64), hi = tr16(xa + 4 * X4RS + pt * 64);
                u32x4 sc;
                sc.x = cvtpk(bf2f((unsigned short)lo[0]) * w0[0], bf2f((unsigned short)lo[1]) * w0[1]); sc.y = cvtpk(bf2f((unsigned short)lo[2]) * w0[2], bf2f((unsigned short)lo[3]) * w0[3]);
                sc.z = cvtpk(bf2f((unsigned short)hi[0]) * w1[0], bf2f((unsigned short)hi[1]) * w1[1]); sc.w = cvtpk(bf2f((unsigned short)hi[2]) * w1[2], bf2f((unsigned short)hi[3]) * w1[3]);
                xf[pt] = __builtin_bit_cast(bf16x8, sc);
            }
#pragma unroll
            for (int i = 0; i < 2; ++i) {
                const bf16x8 bfr = cat8(tr16(ba + i * 64), tr16(ba + 4 * BRS + i * 64));
                acc[i][0] = MFMA32(bfr, xf[0], acc[i][0]); acc[i][1] = MFMA32(bfr, xf[1], acc[i][1]);
            }
        }
        bf16* st = C.ST + ((size_t)((b * NCH + c) * NH + g * 8 + hh)) * (HD * NST);
#pragma unroll
        for (int i = 0; i < 2; ++i)
#pragma unroll
            for (int pt = 0; pt < 2; ++pt)
#pragma unroll
                for (int gq = 0; gq < 4; ++gq) { u32x2 wv; wv.x = cvtpk(acc[i][pt][4 * gq], acc[i][pt][4 * gq + 1]); wv.y = cvtpk(acc[i][pt][4 * gq + 2], acc[i][pt][4 * gq + 3]);
                    *(u32x2*)(st + (32 * pt + r32) * NST + 32 * (nt0 + i) + 8 * gq + 4 * h) = wv; }
        TSTOP(203);
    }
    __syncthreads();
}

__device__ __forceinline__ void phase_scan_fast(Ctx& C) {
    const int total = NB * NH * HD * NST / 8;
    for (int e = C.bid * NTHREADS + C.tid; e < total; e += C.G * NTHREADS) {
        const int pn = e & 1023, hd = (e >> 10) & 15, b = e >> 14;
        float carry[8];
#pragma unroll
        for (int k = 0; k < 8; ++k) carry[k] = 0.f;
        u32x4* p = (u32x4*)(C.ST + ((size_t)(b * NCH * NH + hd)) * (HD * NST)) + pn;
        const float* dc = C.CDEC + b * NCH * NH + hd;
        for (int c0 = 0; c0 < NCH; c0 += 8) {
            u32x4 sv[8]; float dv[8];
#pragma unroll
            for (int i = 0; i < 8; ++i) { sv[i] = p[(size_t)(c0 + i) * NH * 1024]; dv[i] = dc[(c0 + i) * NH]; }
#pragma unroll
            for (int i = 0; i < 8; ++i) {
                const u32x4 s = sv[i]; const float dec = dv[i];
                u32x4 o; o.x = cvtpk(carry[0], carry[1]); o.y = cvtpk(carry[2], carry[3]); o.z = cvtpk(carry[4], carry[5]); o.w = cvtpk(carry[6], carry[7]);
                p[(size_t)(c0 + i) * NH * 1024] = o;
                carry[0] = carry[0] * dec + bf2f(s.x); carry[1] = carry[1] * dec + bf2f(s.x >> 16); carry[2] = carry[2] * dec + bf2f(s.y); carry[3] = carry[3] * dec + bf2f(s.y >> 16);
                carry[4] = carry[4] * dec + bf2f(s.z); carry[5] = carry[5] * dec + bf2f(s.z >> 16); carry[6] = carry[6] * dec + bf2f(s.w); carry[7] = carry[7] * dec + bf2f(s.w >> 16);
            }
        }
    }
}

constexpr int BCRS = 272;
__device__ __forceinline__ void ssd_out_fast(Ctx& C, int u) {
    const int g = u & 1, c = (u >> 1) & 31, b = u >> 6, t0 = c * CHK, rowbase = b * SEQ + t0;
    LAS unsigned char* L = (LAS unsigned char*)C.lds;
    LAS unsigned char* BI = L;
    LAS unsigned char* CI = L + 34816;
    LAS unsigned char* XI = L + 69632;
    LAS float* AC = (LAS float*)(L + 143360);
    LAS float* DL = AC + 1024;
    LAS float* ssl = DL + 1024;
    LAS float* rsl = ssl + 128;
    const int lane = C.lane, r32 = lane & 31, h = lane >> 5, q4 = (lane & 15) >> 2, p4 = lane & 3, b16 = (lane >> 4) & 1, w = C.wave;
    __syncthreads();
    TSTART(40);
    {   float d0, d1, c0, c1, tot; chunk_cumsum(C, rowbase, g * 8 + w, d0, d1, c0, c1, tot);
        AC[w * 128 + 2 * lane] = c0 * 1.4426950408889634f; AC[w * 128 + 2 * lane + 1] = c1 * 1.4426950408889634f;
        DL[w * 128 + 2 * lane] = d0; DL[w * 128 + 2 * lane + 1] = d1; }
    if (C.tid < 128) ssl[C.tid] = 0.f;
#pragma unroll
    for (int i = 0; i < 8; ++i) { const int idx = C.tid + NTHREADS * i, row = idx >> 5, cc = idx & 31;
        const u32x4 v = *(const u32x4*)(C.PROJ + (size_t)(rowbase + row) * NPROJ + PX + 1024 + (cc >> 4) * 256 + g * 128 + (cc & 15) * 8);
        *(LAS u32x4*)((cc < 16 ? BI : CI) + row * BCRS + (cc & 15) * 16) = v; }
    TSTOP(40);
    for (int ps = 0; ps < 2; ++ps) {
        TSTART(41);
        __syncthreads();
#pragma unroll
        for (int i = 0; i < 8; ++i) { const int idx = C.tid + NTHREADS * i, row = idx >> 5, cc = idx & 31;
            *(LAS u32x4*)(XI + row * X4RS + cc * 16) = *(const u32x4*)(C.PROJ + (size_t)(rowbase + row) * NPROJ + PX + g * 512 + ps * 256 + cc * 8); }
        __syncthreads();
        TSTOP(41);
        const int hl = w & 3, hh = ps * 4 + hl, hd = g * 8 + hh;
        const float dsk = C.d_skip[hd];
        const bf16* prev = C.ST + ((size_t)((b * NCH + c) * NH + hd)) * (HD * NST);
        for (int li = 0; li < 2; ++li) {
            const int lt = (w >> 2) ? (1 + li) : (3 * li);
            const int l = 32 * lt + r32;
            f32x16 acc[2];
#pragma unroll
            for (int r = 0; r < 16; ++r) { acc[0][r] = 0.f; acc[1][r] = 0.f; }
            TSTART(42);
            const size_t grow = (size_t)(rowbase + l);
            u32x2 zr[2][4];
#pragma unroll
            for (int pt = 0; pt < 2; ++pt)
#pragma unroll
                for (int gq = 0; gq < 4; ++gq) zr[pt][gq] = *(const u32x2*)(C.PROJ + grow * NPROJ + PZ + hd * 64 + 32 * pt + 8 * gq + 4 * h);
            bf16x8 cf[8];
#pragma unroll
            for (int ks = 0; ks < 8; ++ks) cf[ks] = *(LAS const bf16x8*)(CI + l * BCRS + (16 * ks + 8 * h) * 2);
            {   bf16x8 pf[2][8];
#pragma unroll
                for (int pt = 0; pt < 2; ++pt)
#pragma unroll
                    for (int ks = 0; ks < 8; ++ks) pf[pt][ks] = *(const bf16x8*)(prev + (32 * pt + r32) * NST + 16 * ks + 8 * h);
                __builtin_amdgcn_sched_barrier(0);
#pragma unroll
                for (int pt = 0; pt < 2; ++pt)
#pragma unroll
                    for (int ks = 0; ks < 8; ++ks) acc[pt] = MFMA32(pf[pt][ks], cf[ks], acc[pt]);
            }
            const float al = AC[hh * 128 + l], el = __builtin_amdgcn_exp2f(al);
#pragma unroll
            for (int r = 0; r < 16; ++r) { acc[0][r] *= el; acc[1][r] *= el; }
            TSTOP(42); TSTART(43);
            for (int st = 0; st <= lt; ++st) {
                f32x16 X;
#pragma unroll
                for (int r = 0; r < 16; ++r) X[r] = 0.f;
#pragma unroll
                for (int ks = 0; ks < 8; ++ks) { const bf16x8 bfr = *(LAS const bf16x8*)(BI + (32 * st + r32) * BCRS + (16 * ks + 8 * h) * 2); X = MFMA32(bfr, cf[ks], X); }
#pragma unroll
                for (int gq = 0; gq < 4; ++gq) {
                    const int s0 = 32 * st + 8 * gq + 4 * h;
                    const f32x4 as = *(LAS const f32x4*)(AC + hh * 128 + s0), ds = *(LAS const f32x4*)(DL + hh * 128 + s0);
#pragma unroll
                    for (int i = 0; i < 4; ++i) { const float e = __builtin_amdgcn_exp2f(fminf(al - as[i], 0.f)) * ds[i]; X[4 * gq + i] = (s0 + i <= l) ? X[4 * gq + i] * e : 0.f; }
                }
                LAS const unsigned char* xa = XI + (32 * st + 4 * h + q4) * X4RS + (hl * 64) * 2 + 32 * b16 + 8 * p4;
#pragma unroll
                for (int tq = 0; tq < 2; ++tq) {
                    const bf16x8 mf = (tq == 0) ? PACK8(X, 0) : PACK8(X, 8);
#pragma unroll
                    for (int pt = 0; pt < 2; ++pt) { const bf16x8 xf = cat8(tr16(xa + (16 * tq) * X4RS + pt * 64), tr16(xa + (16 * tq + 8) * X4RS + pt * 64)); acc[pt] = MFMA32(xf, mf, acc[pt]); }
                }
            }
            TSTOP(43); TSTART(44);
            float sq = 0.f;
#pragma unroll
            for (int pt = 0; pt < 2; ++pt)
#pragma unroll
                for (int gq = 0; gq < 4; ++gq) {
                    const int p0 = 32 * pt + 8 * gq + 4 * h;
                    const u32x2 xv = *(LAS const u32x2*)(XI + l * X4RS + (hl * 64 + p0) * 2);
                    const u32x2 zv = zr[pt][gq];
                    const float y0 = (acc[pt][4 * gq] + dsk * bf2f(xv.x)) * silu_f(bf2f(zv.x)), y1 = (acc[pt][4 * gq + 1] + dsk * bf2f(xv.x >> 16)) * silu_f(bf2f(zv.x >> 16));
                    const float y2 = (acc[pt][4 * gq + 2] + dsk * bf2f(xv.y)) * silu_f(bf2f(zv.y)), y3 = (acc[pt][4 * gq + 3] + dsk * bf2f(xv.y >> 16)) * silu_f(bf2f(zv.y >> 16));
                    sq += y0 * y0 + y1 * y1 + y2 * y2 + y3 * y3;
                    u32x2 o; o.x = cvtpk(y0, y1); o.y = cvtpk(y2, y3);
                    *(u32x2*)(C.MIX + grow * 2048 + hd * 64 + p0) = o;
                }
            sq += __shfl_xor(sq, 32);
            if (h == 0) atomicAdd((float*)(ssl + l), sq);
            TSTOP(44);
        }
    }
    __syncthreads();
    if (C.tid < 128) C.RSG[(size_t)(rowbase + C.tid) * 2 + g] = 1.0f / sqrtf(ssl[C.tid] * (1.0f / 512.f) + EPS);
    __syncthreads();
}

__device__ __forceinline__ void phase_gemm2(Ctx& C) {
    pg8::DenseOrder S; S.init(M, DM, 2048, C.WOUT, C.G, C.bid);
    pg8::EpiResid E{C.x, C.out, C.XN, C.RSG, C.RATT, (LAS float*)((LAS unsigned char*)C.lds + 135168)};
    pg8::gemm_phase<pg8::EpiResid, pg8::DenseOrder, true>((LAS unsigned char*)C.lds, (const char*)C.MIX, 2048, S, E);
}

struct MoeItem { const float* W; int ldw, k0, n0; bf16* WT; int K, drow0; const float* ks; };
__device__ __forceinline__ MoeItem moe_item(const Ctx& C, int it) {
    MoeItem I; const int e = it / 768; int r = it % 768;
    if (r < 512) { const bool up = r >= 256; r &= 255; const int kb = r >> 4, nb = r & 15, n0 = nb * 32;
        I.W = (up ? C.w_up : C.w_gate) + (size_t)e * DM * FF; I.ldw = FF; I.k0 = kb * 64; I.n0 = n0; I.WT = C.WGU + (size_t)e * 1024 * 1024; I.K = DM; I.drow0 = (n0 >> 7) * 256 + (n0 & 127) + (up ? 128 : 0); I.ks = C.norm_ffn; }
    else { r -= 512; const int kb = r >> 5, nb = r & 31;
        I.W = C.w_down + (size_t)e * FF * DM; I.ldw = DM; I.k0 = kb * 64; I.n0 = nb * 32; I.WT = C.WD + (size_t)e * 1024 * FF; I.K = FF; I.drow0 = nb * 32; I.ks = nullptr; }
    return I;
}
__device__ __forceinline__ void moe_convert_item(Ctx& C, int it, LAS float* scr) {
    const int e = it / 768; int r = it % 768;
    if (r < 512) { const bool up = r >= 256; r &= 255; const int kb = r >> 4, nb = r & 15, n0 = nb * 32;
        transpose_item((up ? C.w_up : C.w_gate) + (size_t)e * DM * FF, FF, kb * 64, n0, C.WGU + (size_t)e * 1024 * 1024, DM, (n0 >> 7) * 256 + (n0 & 127) + (up ? 128 : 0), scr, C.lane, C.norm_ffn); }
    else { r -= 512; const int kb = r >> 5, nb = r & 31; transpose_item(C.w_down + (size_t)e * FF * DM, DM, kb * 64, nb * 32, C.WD + (size_t)e * 1024 * FF, FF, nb * 32, scr, C.lane); }
}
constexpr int NREM = (NE - E1) * 512 + (NE - E7) * 256;
__device__ __forceinline__ int rem_item(int j) { if (j < (NE - E1) * 512) return (E1 + j / 512) * 768 + (j % 512); j -= (NE - E1) * 512; return (E7 + j / 256) * 768 + 512 + (j % 256); }
template <class ItemOf> __device__ __forceinline__ void conv_stream(Ctx& C, int j0, int step, int nitems, ItemOf item_of) {
    LAS float* scr = (LAS float*)((LAS unsigned char*)C.lds + C.wave * 8704);
    if (j0 >= nitems) return;
    float ta[32], tb[32]; f32x4 ka[2], kb2[2];
    MoeItem A = moe_item(C, item_of(j0)), B = A;
    transpose_load(A.W, A.ldw, A.k0, A.n0, C.lane, A.ks, ta, ka);
    for (int j = j0; j < nitems; j += 2 * step) {
        const bool hb = j + step < nitems, ha = j + 2 * step < nitems;
        if (hb) { B = moe_item(C, item_of(j + step)); transpose_load(B.W, B.ldw, B.k0, B.n0, C.lane, B.ks, tb, kb2); }
        transpose_store(ta, ka, A.WT, A.K, A.drow0, A.k0, scr, C.lane);
        if (ha) { A = moe_item(C, item_of(j + 2 * step)); transpose_load(A.W, A.ldw, A.k0, A.n0, C.lane, A.ks, ta, ka); }
        if (hb) transpose_store(tb, kb2, B.WT, B.K, B.drow0, B.k0, scr, C.lane);
    }
}
__device__ __forceinline__ void conv_gateup_early(Ctx& C) { conv_stream(C, C.bid * NWAVES + C.wave, NCONV * NWAVES, E1 * 512, [](int j) { return (j / 512) * 768 + (j % 512); }); }
__device__ __forceinline__ void conv_down_early(Ctx& C) { conv_stream(C, C.bid * NWAVES + C.wave, NCONV * NWAVES, E7 * 256, [](int j) { return (j / 256) * 768 + 512 + (j % 256); }); }
__device__ __forceinline__ void phase_router_fast(Ctx& C) {
    LAS float* scr = (LAS float*)((LAS unsigned char*)C.lds + C.wave * 8704);
    LAS float* PA = (LAS float*)((LAS unsigned char*)C.lds + 71680);
    int cit = C.bid * NWAVES + C.wave;
    const int lane = C.lane, r32 = lane & 31, h = lane >> 5, w = C.wave, tt = w & 3, kh = w >> 2;
    const int gw = C.bid * NWAVES + C.wave, NGW = C.G * NWAVES;
    unsigned* cnt = C.ctl + CW_CNT;
    LAS unsigned* hist = (LAS unsigned*)(PA + 4 * 49 * 64);
    LAS unsigned* hbase = hist + 64;
    TSTART(60);
    for (int rb = C.bid; rb < M / 128; rb += C.G) {
        const int row = rb * 128 + 32 * tt + r32;
        if (C.tid < 64) hist[C.tid] = 0u;
        const bf16* hp = C.XN + (size_t)row * DM + 512 * kh + 8 * h;
        const bf16* whp = C.WRH + (size_t)r32 * DM + 512 * kh + 8 * h;
        const bf16* wlp = C.WRL + (size_t)r32 * DM + 512 * kh + 8 * h;
        f32x16 acc[3];
#pragma unroll
        for (int t = 0; t < 3; ++t)
#pragma unroll
            for (int r = 0; r < 16; ++r) acc[t][r] = 0.f;
        float ss = 0.f;
#pragma unroll 1
        for (int kb = 0; kb < 8; ++kb) {
            u32x4 hv[4]; bf16x8 wh[4][3], wl[4][3];
#pragma unroll
            for (int i = 0; i < 4; ++i) hv[i] = *(const u32x4*)(hp + (kb * 4 + i) * 16);
#pragma unroll
            for (int i = 0; i < 4; ++i)
#pragma unroll
                for (int t = 0; t < 3; ++t) { wh[i][t] = *(const bf16x8*)(whp + (size_t)t * 32 * DM + (kb * 4 + i) * 16); wl[i][t] = *(const bf16x8*)(wlp + (size_t)t * 32 * DM + (kb * 4 + i) * 16); }
            __builtin_amdgcn_sched_barrier(0);
            if (cit < NREM) { moe_convert_item(C, rem_item(cit), scr); cit += NGW; }
            __builtin_amdgcn_sched_barrier(0);
#pragma unroll
            for (int i = 0; i < 4; ++i) {
                const u32x4 a = hv[i];
                const float f0 = bf2f(a.x), f1 = bf2f(a.x >> 16), f2 = bf2f(a.y), f3 = bf2f(a.y >> 16), f4 = bf2f(a.z), f5 = bf2f(a.z >> 16), f6 = bf2f(a.w), f7 = bf2f(a.w >> 16);
                ss += f0 * f0 + f1 * f1 + f2 * f2 + f3 * f3 + f4 * f4 + f5 * f5 + f6 * f6 + f7 * f7;
                const bf16x8 thf = __builtin_bit_cast(bf16x8, a);
#pragma unroll
                for (int t = 0; t < 3; ++t) { acc[t] = MFMA32(wh[i][t], thf, acc[t]); acc[t] = MFMA32(wl[i][t], thf, acc[t]); }
            }
            __builtin_amdgcn_sched_barrier(0);
        }
        __syncthreads();
        if (kh == 1) {
#pragma unroll
            for (int t = 0; t < 3; ++t)
#pragma unroll
                for (int r = 0; r < 16; ++r) PA[(tt * 49 + t * 16 + r) * 64 + lane] = acc[t][r];
            PA[(tt * 49 + 48) * 64 + lane] = ss;
        }
        __syncthreads();
        int es0 = 0, es1 = 0; float gs0 = 0.f, gs1 = 0.f, rstd_s = 0.f; unsigned lp0 = 0u, lp1 = 0u;
        if (kh == 0) {
#pragma unroll
            for (int t = 0; t < 3; ++t)
#pragma unroll
                for (int r = 0; r < 16; ++r) acc[t][r] += PA[(tt * 49 + t * 16 + r) * 64 + lane];
            ss += PA[(tt * 49 + 48) * 64 + lane];
            ss += __shfl_xor(ss, 32);
            const float rstd = 1.0f / sqrtf(ss * (1.0f / DM) + EPS);
            if (h == 0) C.RS[row] = rstd;
            float gm[4], go[4], gl[8];
#pragma unroll
            for (int i = 0; i < 4; ++i) { gm[i] = acc[2][i] * rstd; go[i] = __shfl_xor(gm[i], 32); }
#pragma unroll
            for (int i = 0; i < 4; ++i) { gl[i] = h ? go[i] : gm[i]; gl[4 + i] = h ? gm[i] : go[i]; }
            int gsel = 0; float gmax = gl[0];
#pragma unroll
            for (int c2 = 1; c2 < 8; ++c2) if (gl[c2] > gmax) { gmax = gl[c2]; gsel = c2; }
            float gsum = 0.f;
#pragma unroll
            for (int c2 = 0; c2 < 8; ++c2) gsum += expf(gl[c2] - gmax);
            const float pgrp = 1.0f / gsum;
            float em[4], eo[4], el[8];
#pragma unroll
            for (int i = 0; i < 4; ++i) { float v = acc[0][i];
#pragma unroll
                for (int gg = 1; gg < 8; ++gg) v = (gsel == gg) ? acc[gg >> 2][4 * (gg & 3) + i] : v;
                em[i] = v * rstd; eo[i] = __shfl_xor(em[i], 32); }
#pragma unroll
            for (int i = 0; i < 4; ++i) { el[i] = h ? eo[i] : em[i]; el[4 + i] = h ? em[i] : eo[i]; }
            int i0 = 0; float l0 = el[0];
#pragma unroll
            for (int i = 1; i < 8; ++i) if (el[i] > l0) { l0 = el[i]; i0 = i; }
            int i1 = -1; float l1 = -INFINITY;
#pragma unroll
            for (int i = 0; i < 8; ++i) if (i != i0 && el[i] > l1) { l1 = el[i]; i1 = i; }
            const float e1 = expf(l1 - l0), g0 = pgrp / (1.0f + e1), g1 = pgrp * e1 / (1.0f + e1);
            es0 = gsel * 8 + i0; es1 = gsel * 8 + i1; gs0 = g0; gs1 = g1; rstd_s = rstd;
            if (h == 0) { lp0 = atomicAdd((unsigned*)(hist + es0), 1u); lp1 = atomicAdd((unsigned*)(hist + es1), 1u); }
        }
        __syncthreads();
        if (w == 0) { const unsigned n = hist[lane]; unsigned bs = 0u; if (n) bs = atomicAdd(&cnt[lane], n); hbase[lane] = bs; }
        __syncthreads();
        if (kh == 0 && h == 0) {
            const unsigned p0 = hbase[es0] + lp0, p1 = hbase[es1] + lp1;
            C.TE[row * 2] = es0; C.TP[row * 2] = (int)p0; C.LIST[(size_t)es0 * LISTCAP + p0] = row * 2; C.LG[(size_t)es0 * LISTCAP + p0] = gs0; C.LRS[(size_t)es0 * LISTCAP + p0] = rstd_s;
            C.TE[row * 2 + 1] = es1; C.TP[row * 2 + 1] = (int)p1; C.LIST[(size_t)es1 * LISTCAP + p1] = row * 2 + 1; C.LG[(size_t)es1 * LISTCAP + p1] = gs1; C.LRS[(size_t)es1 * LISTCAP + p1] = rstd_s;
        }
    }
    __syncthreads();
    TSTOP(60); TSTART(61);
    conv_stream(C, cit, NGW, NREM, [](int j) { return rem_item(j); });
    TSTOP(61);
}

struct MoeTab { int* cnt; int* pstart; int* tstart; };
__device__ __forceinline__ MoeTab moe_tables(Ctx& C, int off) {
    MoeTab T; T.cnt = (int*)(C.lds + off); T.pstart = T.cnt + 64; T.tstart = T.pstart + 65;
    __syncthreads();
    if (C.tid < 64) T.cnt[C.tid] = (int)__hip_atomic_load(C.ctl + CW_CNT + C.tid, __ATOMIC_RELAXED, __HIP_MEMORY_SCOPE_AGENT);
    __syncthreads();
    if (C.tid == 0) { int ps = 0, ts = 0; for (int e = 0; e < 64; ++e) { T.pstart[e] = ps; T.tstart[e] = ts; ps += ((T.cnt[e] + 255) >> 8) << 8; ts += (T.cnt[e] + 255) >> 8; } T.pstart[64] = ps; T.tstart[64] = ts; }
    __syncthreads();
    return T;
}

constexpr int MOE_TAB_OFF = 132096;
__device__ __forceinline__ void phase_moe_a(Ctx& C) {
    const MoeTab T = moe_tables(C, MOE_TAB_OFF);
    if (C.bid < NCONV) { conv_down_early(C); return; }
    const int G2 = C.G - NCONV, b2 = C.bid - NCONV, vcu2 = (G2 % 8 == 0) ? (b2 % 8) * (G2 / 8) + b2 / 8 : b2;
    pg8::MoeOrder<true> S{T.cnt, T.pstart, T.tstart, C.LIST, (const char*)C.WGU, (size_t)1024 * 1024 * 2, DM, 4, T.tstart[64], G2, vcu2};
    pg8::EpiHid E{C.HID, C.LIST, C.LRS, (LAS float*)((LAS unsigned char*)C.lds + 135168)};
    pg8::gemm_phase<pg8::EpiHid, pg8::MoeOrder<true>, true>((LAS unsigned char*)C.lds, (const char*)C.XN, DM, S, E);
}
__device__ __forceinline__ void phase_moe_b(Ctx& C) {
    const MoeTab T = moe_tables(C, MOE_TAB_OFF);
    pg8::MoeOrder<false> S{T.cnt, T.pstart, T.tstart, C.LIST, (const char*)C.WD, (size_t)1024 * FF * 2, FF, 4, T.tstart[64], C.G, C.vcu};
    pg8::EpiYb E{C.YB, C.LIST, C.LG, (LAS float*)((LAS unsigned char*)C.lds + 135168)};
    pg8::gemm_phase<pg8::EpiYb, pg8::MoeOrder<false>, true>((LAS unsigned char*)C.lds, (const char*)C.HID, FF, S, E);
}
__device__ __forceinline__ void phase_final(Ctx& C) {
    const MoeTab T = moe_tables(C, 0);
    const int gw = C.bid * NWAVES + C.wave, NGW = C.G * NWAVES;
    f32x4 hn[4], gfin[4]; u32x2 an[4], cn[4];
#pragma unroll
    for (int j = 0; j < 4; ++j) gfin[j] = ((const f32x4*)C.norm_final)[C.lane + 64 * j];
#define FIN_LOAD(r) do { const size_t s0_ = (size_t)T.pstart[C.TE[(r) * 2]] + C.TP[(r) * 2], s1_ = (size_t)T.pstart[C.TE[(r) * 2 + 1]] + C.TP[(r) * 2 + 1]; \
        _Pragma("unroll") for (int j = 0; j < 4; ++j) { { const u32x2 hb_ = ((const u32x2*)(C.XN + (size_t)(r) * DM) + C.lane)[64 * j]; hn[j][0] = bf2f(hb_.x); hn[j][1] = bf2f(hb_.x >> 16); hn[j][2] = bf2f(hb_.y); hn[j][3] = bf2f(hb_.y >> 16); } an[j] = ((const u32x2*)(C.YB + s0_ * DM) + C.lane)[64 * j]; cn[j] = ((const u32x2*)(C.YB + s1_ * DM) + C.lane)[64 * j]; } } while (0)
    for (int rb = C.bid; rb < M / 128; rb += C.G) {
        const int row0 = rb * 128 + C.wave * 16;
        FIN_LOAD(row0);
#pragma unroll
        for (int i = 0; i < 16; ++i) {
            const int row = row0 + i;
            f32x4 v[4]; u32x2 ya[4], yc[4];
#pragma unroll
            for (int j = 0; j < 4; ++j) { v[j] = hn[j]; ya[j] = an[j]; yc[j] = cn[j]; }
            FIN_LOAD(row0 + ((i + 1) & 15));
            float ss = 0.f;
#pragma unroll
            for (int j = 0; j < 4; ++j) { const u32x2 a = ya[j], c = yc[j];
                v[j][0] += bf2f(a.x) + bf2f(c.x); v[j][1] += bf2f(a.x >> 16) + bf2f(c.x >> 16); v[j][2] += bf2f(a.y) + bf2f(c.y); v[j][3] += bf2f(a.y >> 16) + bf2f(c.y >> 16);
                ss += v[j][0] * v[j][0] + v[j][1] * v[j][1] + v[j][2] * v[j][2] + v[j][3] * v[j][3]; }
            const float rstd = 1.0f / sqrtf(wave_sum(ss) * (1.0f / DM) + EPS);
            f32x4* hr = (f32x4*)(C.out + (size_t)row * DM) + C.lane;
#pragma unroll
            for (int j = 0; j < 4; ++j) hr[64 * j] = v[j] * rstd * gfin[j];
            __builtin_amdgcn_sched_barrier(0);
        }
    }
#undef FIN_LOAD
}

constexpr int NPHASE = 10;
__global__ void __launch_bounds__(NTHREADS, 2) fwd_kernel(Args args) {
    extern __shared__ __attribute__((aligned(16))) unsigned char lds[];
    Ctx C;
    C.tph0 = 0; C.tphd = 0;
    C.lds = lds; C.tid = threadIdx.x; C.lane = C.tid & 63; C.wave = __builtin_amdgcn_readfirstlane(C.tid >> 6); C.G = gridDim.x; C.bid = blockIdx.x;
    C.x = args.in[0]; C.norm_mix = args.in[1]; C.w_in = args.in[2]; C.conv_w = args.in[3]; C.conv_b = args.in[4]; C.dt_bias = args.in[5]; C.a_log = args.in[6]; C.d_skip = args.in[7];
    C.ssd_norm = args.in[8]; C.sinks = args.in[9]; C.attn_norm = args.in[10]; C.w_out = args.in[11]; C.norm_ffn = args.in[12]; C.w_rg = args.in[13]; C.w_re = args.in[14];
    C.w_gate = args.in[15]; C.w_up = args.in[16]; C.w_down = args.in[17]; C.norm_final = args.in[18];
    C.out = args.out; C.ws = args.ws;
    unsigned char* ws = args.ws;
    C.ctl = (unsigned*)(ws + WS_CTL);
    C.XN = (bf16*)(ws + WS_XN); C.DT = (float*)(ws + WS_DT); C.PROJ = (bf16*)(ws + WS_PROJ); C.HID = (bf16*)(ws + WS_HID); C.YB = (bf16*)(ws + WS_YB);
    C.ST = (bf16*)(ws + WS_ST); C.MIX = (bf16*)(ws + WS_MIX); C.CDEC = (float*)(ws + WS_CDEC); C.TE = (int*)(ws + WS_TE); C.TP = (int*)(ws + WS_TP); C.TG = (float*)(ws + WS_TG);
    C.LIST = (int*)(ws + WS_LIST); C.WIN = (bf16*)(ws + WS_WIN); C.WOUT = (bf16*)(ws + WS_WOUT); C.WGU = (bf16*)args.out;            C.WD = (bf16*)(ws + WS_WD); C.HALO = (bf16*)(ws + WS_HALO); C.WRH = (bf16*)(ws + WS_WRH); C.WRL = (bf16*)(ws + WS_WRL); C.RS = (float*)(ws + WS_RS); C.RATT = C.RS + M; C.RSG = C.RS + 2 * M; C.LRS = (float*)(ws + WS_WGU); C.LG = C.LRS + (size_t)NE * LISTCAP;
    C.vcu = (C.G % 8 == 0) ? (C.bid % 8) * (C.G / 8) + C.bid / 8 : C.bid;
    TSTART(9999);
    volatile LAS unsigned* MISC = (volatile LAS unsigned*)((LAS unsigned char*)lds + MISC_OFF);
    if (C.tid < 64) MISC[C.tid] = 0u;
    __syncthreads();
    XcdBarrier bar; bar.bar = C.ctl + CW_BAR; bar.x = 0; bar.st = nullptr;
#if ONE_LAUNCH
    bar = xcd_barrier_post(C.ctl + CW_BAR, MISC + 8);
#define GRID_BAR() xcd_barrier(bar)
#else
#define GRID_BAR() do {} while (0)
#endif
    const int lo = args.ph_lo, hi = args.ph_hi;
#define IN(k) (lo <= (k) && (k) < hi)
#define SEAM(k) do { if (IN(k) && IN((k) + 1)) GRID_BAR(); } while (0)
#define REP(k) for (int _rep = 0; _rep < ((k) == RPH ? 2 : 1); ++_rep)
    TSTART(0); if (IN(0)) { REP(0) phase_prologue(C); } SEAM(0); TSTOP(0);
    TSTART(1); if (IN(1)) { if (C.bid < NCONV) conv_gateup_early(C); else phase_gemm1(C); } SEAM(1); TSTOP(1);
    TSTART(2); if (IN(2)) { TSTART(20); for (int u = C.bid; u < NB * NCH * 2; u += C.G) ssd_states_fast(C, u); TSTOP(20); TSTART(21); REP(20) for (int u = C.bid; u < NB * 32; u += C.G) attn_unit_fast(C, u); TSTOP(21); } SEAM(2); TSTOP(2);
    TSTART(3); if (IN(3)) { phase_scan_fast(C); } SEAM(3); TSTOP(3);
    TSTART(4); if (IN(4)) { REP(4) for (int u = C.bid; u < NB * NCH * 2; u += C.G) ssd_out_fast(C, u); } SEAM(4); TSTOP(4);
    TSTART(5); if (IN(5)) { REP(5) phase_gemm2(C); } SEAM(5); TSTOP(5);
    TSTART(6); if (IN(6)) { phase_router_fast(C); } SEAM(6); TSTOP(6);
    TSTART(7); if (IN(7)) { REP(7) phase_moe_a(C); } SEAM(7); TSTOP(7);
    TSTART(8); if (IN(8)) { REP(8) phase_moe_b(C); } SEAM(8); TSTOP(8);
    TSTART(9); if (IN(9)) { phase_final(C); } TSTOP(9); TSTOP(9999);
#ifdef TPH
    if (C.tid == 0) { const unsigned long long te = __builtin_amdgcn_s_memrealtime(); while (__builtin_amdgcn_s_memrealtime() - te < C.tphd) __builtin_amdgcn_s_sleep(8); }
#endif
}

extern "C" void kernel_launch(void* const* d_in, const int* in_sizes, int n_in, void* d_out, int out_size, void* d_ws, size_t ws_size, hipStream_t stream) {
    static int grid = 0;
    if (grid == 0) {
        if (n_in != 19 || in_sizes[0] != M * DM || out_size != M * DM || ws_size < WS_END) { fprintf(stderr, "kernel_launch: unexpected shapes (n_in %d, in0 %d, out %d, ws %zu)\n", n_in, n_in > 0 ? in_sizes[0] : -1, out_size, ws_size); grid = -1; return; }
        int dev = 0, cus = 0, per_cu = 0;
        if (hipGetDevice(&dev) != hipSuccess || hipDeviceGetAttribute(&cus, hipDeviceAttributeMultiprocessorCount, dev) != hipSuccess) { grid = -1; return; }
        if (hipFuncSetAttribute((const void*)fwd_kernel, hipFuncAttributeMaxDynamicSharedMemorySize, LDS_BYTES) != hipSuccess) { fprintf(stderr, "kernel_launch: hipFuncSetAttribute failed\n"); grid = -1; return; }
        if (hipOccupancyMaxActiveBlocksPerMultiprocessor(&per_cu, (const void*)fwd_kernel, NTHREADS, LDS_BYTES) != hipSuccess || per_cu < 1) { fprintf(stderr, "kernel_launch: occupancy query says %d\n", per_cu); (void)hipGetLastError(); per_cu = 1; }
        grid = cus;
    }
    if (grid < 0) return;
    (void)hipMemsetAsync((char*)d_ws + WS_CTL, 0, CTL_BYTES, stream);
    Args a{};
    for (int i = 0; i < 19; ++i) a.in[i] = (const float*)d_in[i];
    a.out = (float*)d_out; a.ws = (unsigned char*)d_ws;
#if ONE_LAUNCH
    a.ph_lo = 0; a.ph_hi = NPHASE;
    hipLaunchKernelGGL(fwd_kernel, dim3(grid), dim3(NTHREADS), LDS_BYTES, stream, a);
#else
    for (int p = 0; p < NPHASE; ++p) { a.ph_lo = p; a.ph_hi = p + 1; hipLaunchKernelGGL(fwd_kernel, dim3(grid), dim3(NTHREADS), LDS_BYTES, stream, a); }
#endif
}
```

```cpp
#include <hip/hip_runtime.h>
#include <cstdio>
#include <cstdint>

#ifndef RPH
#define RPH -1
#endif
#ifndef ONE_LAUNCH
#define ONE_LAUNCH 1
#endif

#define LAS __attribute__((address_space(3)))
typedef unsigned short bf16;
typedef float f32x4 __attribute__((ext_vector_type(4)));
typedef unsigned u32x4 __attribute__((ext_vector_type(4)));
typedef unsigned u32x2 __attribute__((ext_vector_type(2)));

constexpr int NB = 8, SEQ = 4096, DM = 1024, M = NB * SEQ;
constexpr int INDIM = 3856;
constexpr int NIN = 3840;
constexpr int XUW = 256, XUNIT = 3 * 128 * 256;
constexpr size_t KV_OFF = (size_t)M * 1536;
constexpr int DT0 = 2560;
constexpr int CONVCH = 1536;
constexpr int NH = 16, HD = 64, NST = 128, CHK = 128, NCH = SEQ / CHK;
constexpr int NE = 64, FF = 512, LISTCAP = 32768;
constexpr int SLOT_MAX = 81920;
constexpr float EPS = 1e-6f;
constexpr int NCONV = 16, E1 = 10, E7 = 24;

constexpr size_t MiB = 1u << 20;
constexpr size_t WS_CTL = 0, CTL_BYTES = 64 * 1024;
constexpr size_t WS_XN = 1 * MiB;
constexpr size_t WS_DT = 65 * MiB;
constexpr size_t WS_PROJ = 67 * MiB;
constexpr size_t WS_ZF = 179 * MiB;
constexpr size_t WS_QF = 243 * MiB;
constexpr size_t WS_HID = WS_PROJ;
constexpr size_t WS_YB = WS_PROJ + 80 * MiB;
constexpr size_t WS_ST = 307 * MiB;
constexpr size_t WS_MIX = 371 * MiB;
constexpr size_t WS_WGU = 307 * MiB;
constexpr size_t WS_WD = 435 * MiB;
constexpr size_t WS_WIN = 499 * MiB;
constexpr size_t WS_WOUT = 507 * MiB;
constexpr size_t WS_MISC = 511 * MiB;
constexpr size_t WS_CDEC = WS_MISC;
constexpr size_t WS_TE = WS_MISC + 1 * MiB;
constexpr size_t WS_TP = WS_TE + 256 * 1024;
constexpr size_t WS_TG = WS_TP + 256 * 1024;
constexpr size_t WS_LIST = WS_MISC + 2 * MiB;
constexpr size_t WS_HALO = WS_LIST + 8 * MiB;
constexpr size_t WS_WRH = WS_HALO + 3 * MiB;
constexpr size_t WS_WRL = WS_WRH + 256 * 1024;
constexpr size_t WS_RS = WS_WRL + 256 * 1024;
constexpr size_t WS_END = WS_RS + 512 * 1024;
constexpr int CW_BAR = 4096;
constexpr int CW_CNT = 8192;
constexpr int CW_TIME = 8448;

constexpr int NTHREADS = 512, NWAVES = 8;
constexpr int LDS_BYTES = 159744;
constexpr int MISC_OFF = LDS_BYTES - 256;

__device__ __forceinline__ unsigned f2bf(float f) { unsigned u = __builtin_bit_cast(unsigned, f); return (u + 0x7fffu + ((u >> 16) & 1u)) >> 16; }
__device__ __forceinline__ float bf2f(unsigned b) { return __builtin_bit_cast(float, (b & 0xffffu) << 16); }
__device__ __forceinline__ unsigned pk2(float lo, float hi) { return f2bf(lo) | (f2bf(hi) << 16); }
__device__ __forceinline__ float wave_sum(float v) {
#pragma unroll
    for (int o = 1; o < 64; o <<= 1) v += __shfl_xor(v, o);
    return v;
}
__device__ __forceinline__ float silu_f(float x) { return x * __builtin_amdgcn_rcpf(1.0f + __expf(-x)); }
__device__ __forceinline__ float softplus_f(float x) { return x > 20.f ? x : log1pf(expf(x)); }

typedef short bf16x8 __attribute__((ext_vector_type(8)));
typedef short s16x4 __attribute__((ext_vector_type(4)));
typedef float f32x16 __attribute__((ext_vector_type(16)));
typedef float f32x2_t __attribute__((ext_vector_type(2)));
typedef __bf16 bf16x2_t __attribute__((ext_vector_type(2)));
#define MFMA32(a, b, c) __builtin_amdgcn_mfma_f32_32x32x16_bf16((a), (b), (c), 0, 0, 0)
__device__ __forceinline__ unsigned cvtpk(float lo, float hi) { f32x2_t v = {lo, hi}; bf16x2_t b = __builtin_convertvector(v, bf16x2_t); return __builtin_bit_cast(unsigned, b); }
__device__ __forceinline__ s16x4 tr16(LAS const unsigned char* p) { return __builtin_bit_cast(s16x4, __builtin_amdgcn_ds_read_tr16_b64_v4i16((LAS s16x4*)p)); }
__device__ __forceinline__ bf16x8 cat8(s16x4 lo, s16x4 hi) { return __builtin_shufflevector(lo, hi, 0, 1, 2, 3, 4, 5, 6, 7); }
__device__ __forceinline__ u32x4 widen16(u32x2 a, u32x2 b) {
    const auto rx = __builtin_amdgcn_permlane32_swap(a.x, b.x, false, false), ry = __builtin_amdgcn_permlane32_swap(a.y, b.y, false, false);
    return (u32x4){rx[0], ry[0], rx[1], ry[1]};
}
#define PACK8(x, o) __builtin_bit_cast(bf16x8, (u32x4){cvtpk((x)[(o)], (x)[(o) + 1]), cvtpk((x)[(o) + 2], (x)[(o) + 3]), cvtpk((x)[(o) + 4], (x)[(o) + 5]), cvtpk((x)[(o) + 6], (x)[(o) + 7])})

#define XB_TMO      128
#define XB_XCNT(j)  (256  + 64 * (j))
#define XB_XSUB(j)  (1280 + 64 * (j))
#define XB_XGEN(j)  (2304 + 64 * (j))
#define XB_TOP      3328
#define XB_TOPGEN   3392
#define XCD_BAR_WORDS 3456
#define XB_SPIN_CAP (1u << 27)
__device__ __forceinline__ unsigned xb_ld(unsigned* p)              { return __hip_atomic_load(p, __ATOMIC_RELAXED, __HIP_MEMORY_SCOPE_AGENT); }
__device__ __forceinline__ unsigned xb_add(unsigned* p, unsigned v) { return __hip_atomic_fetch_add(p, v, __ATOMIC_RELAXED, __HIP_MEMORY_SCOPE_AGENT); }
__device__ __forceinline__ unsigned xb_xcc_id() { return (unsigned)__builtin_amdgcn_s_getreg((3 << 11) | 20) & 0xFu; }
#define XB_SPIN(cond, bar) do { unsigned _sp = 0; while (cond) { __builtin_amdgcn_s_sleep(1); \
    if ((++_sp & 255u) == 0u) { if (xb_ld(&(bar)[XB_TMO])) break; if (_sp > XB_SPIN_CAP) { atomicAdd(&(bar)[XB_TMO], 1u); break; } } } } while (0)
struct XcdBarrier { unsigned* bar; unsigned x; volatile LAS unsigned* st; };
__device__ __forceinline__ XcdBarrier xcd_barrier_post(unsigned* bar, volatile LAS unsigned* st) {
    XcdBarrier b; b.bar = bar; b.x = xb_xcc_id(); b.st = st;
    if (threadIdx.x == 0) (void)xb_add(&bar[XB_XCNT(b.x)], 1u);
    return b;
}
__device__ __forceinline__ void xcd_barrier_complete(unsigned* bar, unsigned x, unsigned& nloc, unsigned& nx) {
    const unsigned G = gridDim.x * gridDim.y * gridDim.z;
    unsigned sum, cnt, mine, sp = 0u;
    for (;;) {
        sum = 0u; cnt = 0u; mine = 0u;
#pragma unroll
        for (unsigned j = 0; j < 16; ++j) { const unsigned c = xb_ld(&bar[XB_XCNT(j)]); sum += c; cnt += (c > 0u) ? 1u : 0u; mine = (j == x) ? c : mine; }
        if (sum == G) break;
        __builtin_amdgcn_s_sleep(1);
        if ((++sp & 255u) == 0u) { if (xb_ld(&bar[XB_TMO])) break; if (sp > XB_SPIN_CAP) { atomicAdd(&bar[XB_TMO], 1u); break; } }
    }
    nloc = mine > 0u ? mine : 1u; nx = cnt > 0u ? cnt : 1u;
}
__device__ __forceinline__ void xcd_barrier(const XcdBarrier& b) {
    asm volatile("s_waitcnt vmcnt(0)" ::: "memory");
    __syncthreads();
    if (threadIdx.x == 0) {
        unsigned* bar = b.bar;
        __builtin_amdgcn_s_waitcnt(0);
        unsigned nloc = b.st[0], nx = b.st[1];
        if (nloc == 0u) { xcd_barrier_complete(bar, b.x, nloc, nx); b.st[0] = nloc; b.st[1] = nx; }
        const unsigned old = xb_add(&bar[XB_XSUB(b.x)], 1u);
        const unsigned gen = old / nloc;
        if (old + 1u == (gen + 1u) * nloc) {
            __builtin_amdgcn_fence(__ATOMIC_RELEASE, "agent");
            asm volatile("s_waitcnt vmcnt(0)" ::: "memory");
            const unsigned og = xb_add(&bar[XB_TOP], 1u);
            const unsigned tg = og / nx;
            if (og + 1u == (tg + 1u) * nx) xb_add(&bar[XB_TOPGEN], 1u);
            else XB_SPIN(xb_ld(&bar[XB_TOPGEN]) == tg, bar);
            __builtin_amdgcn_fence(__ATOMIC_ACQUIRE, "agent");
            xb_add(&bar[XB_XGEN(b.x)], 1u);
            asm volatile("s_waitcnt vmcnt(0)" ::: "memory");
        } else {
            XB_SPIN(xb_ld(&bar[XB_XGEN(b.x)]) == gen, bar);
            __builtin_amdgcn_fence(__ATOMIC_ACQUIRE, "agent");
            asm volatile("s_waitcnt vmcnt(0)" ::: "memory");
        }
    }
    __syncthreads();
}

struct Args { const float* in[19]; float* out; unsigned char* ws; int ph_lo, ph_hi; };
#ifdef TPH
#define TSTART(k) do { if ((k) == TPH) C.tph0 = __builtin_amdgcn_s_memrealtime(); } while (0)
#define TSTOP(k) do { if ((k) == TPH) C.tphd += __builtin_amdgcn_s_memrealtime() - C.tph0; } while (0)
#else
#define TSTART(k) do {} while (0)
#define TSTOP(k) do {} while (0)
#endif
struct Ctx {
    unsigned long long tph0, tphd;
    unsigned char* lds; int tid, lane, wave, G, bid;
    const float *x, *norm_mix, *w_in, *conv_w, *conv_b, *dt_bias, *a_log, *d_skip, *ssd_norm, *sinks, *attn_norm, *w_out, *norm_ffn, *w_rg, *w_re, *w_gate, *w_up, *w_down, *norm_final;
    float* out; unsigned char* ws;
    bf16 *XN, *PROJ, *HID, *YB, *ST, *MIX, *WIN, *WOUT, *WGU, *WD, *HALO, *WRH, *WRL, *ZF, *QF; float *RS, *RATT, *RSG, *LRS, *LG; int vcu; float *DT, *CDEC, *TG; int *TE, *TP, *LIST; unsigned* ctl;
};

namespace pg8 {
typedef short bf16x8 __attribute__((ext_vector_type(8)));
constexpr int BM = 256, BK = 64, HALF = 128, HTB = HALF * BK * 2, STAGE_BYTES = 8 * HTB, NXCD = 8, WGM = 8;
__device__ __forceinline__ int lds_byte(int r, int c) { const int st = (r >> 4) * 2 + (c >> 5), rr = r & 15, cc = c & 31, ob = rr * 64 + cc * 2; return st * 1024 + (ob ^ (((ob >> 9) & 1) << 5)); }
__device__ __forceinline__ void stage_rc(int b, int& R, int& C) { const int st = b / 1024, sb = b % 1024, swz = sb ^ (((sb >> 9) & 1) << 5); R = (st >> 1) * 16 + swz / 64; C = (st & 1) * 32 + (swz % 64) / 2; }
__device__ __forceinline__ int perm32(int rho) { const int n = rho >> 4, i = rho & 15; return 8 * (i >> 2) + 4 * n + (i & 3); }
__device__ __forceinline__ unsigned cvt_pk_bf16(float lo, float hi) { unsigned r; asm volatile("v_cvt_pk_bf16_f32 %0, %1, %2" : "=v"(r) : "v"(lo), "v"(hi)); return r; }

struct Unit { int pm, pn, e, mt, rowbase, cnt, par; const char* bt; };

struct DenseOrder {
    int nM, nN, nwg, G, c, K; const char* Bt;
    __device__ void init(int M, int N, int K_, const bf16* Bt_, int G_, int c_) { nM = M / BM; nN = N / BM; nwg = nM * nN; G = G_; c = c_; K = K_; Bt = (const char*)Bt_; }
    __device__ __forceinline__ bool next(int i, Unit& u) const {
        const long L = (long)i * G + c; if (L >= nwg) return false;
        int wgid = (int)L; { const int q = nwg / NXCD, r = nwg % NXCD, xcd = wgid % NXCD, off = wgid / NXCD; wgid = (xcd < r ? xcd * (q + 1) : r * (q + 1) + (xcd - r) * q) + off; }
        const int nig = WGM * nN, gid = wgid / nig, fm = gid * WGM, gsz = (nM - fm) < WGM ? (nM - fm) : WGM;
        u.pm = fm + ((wgid % nig) % gsz); u.pn = (wgid % nig) / gsz; u.e = 0; u.mt = 0; u.rowbase = u.pm * BM; u.cnt = BM;
        u.bt = Bt + (size_t)u.pn * BM * K * 2; return true;
    }
    __device__ __forceinline__ unsigned arow(const Unit& u, int R) const { return (unsigned)(u.rowbase + R); }
};
template <bool GATHER> struct MoeOrder {
    const int *cnt, *pstart, *tstart, *texp; const int* LIST; const char* W; size_t wstride; int K, ntiles, G, c;
    __device__ __forceinline__ bool next(int i, Unit& u) const {
        const int L = i * G + c; if (L >= ntiles * 4) return false;
        const int tile = L >> 2; u.pn = L & 3; u.pm = tile;
        const int e = texp[tile];
        u.e = e; u.mt = tile - tstart[e]; u.rowbase = pstart[e] + u.mt * BM; u.cnt = cnt[e];
        u.bt = W + (size_t)e * wstride + (size_t)u.pn * BM * K * 2; return true;
    }
    __device__ __forceinline__ unsigned arow(const Unit& u, int R) const {
        if (GATHER) { const int pos = u.mt * BM + R; return pos < u.cnt ? (unsigned)(LIST[(size_t)u.e * LISTCAP + pos] >> 1) : 0u; }
        return (unsigned)(u.rowbase + R);
    }
};

struct EpiProj {
    static constexpr bool PERM = true, KSEG = false, UBEGIN = false; bf16* O; int ldc; bf16* HALO; bf16 *ZF, *QF;
    __device__ __forceinline__ void operator()(const f32x4 (&acc)[2][2][4][2], const Unit& u, int wr, int wc, int fr, int fq) const {
        const bool fm = u.pn < 4 || (u.pn >= 10 && u.pn < 14); bf16* FB = u.pn < 4 ? ZF : QF; const int pnl = u.pn < 4 ? u.pn : u.pn - 10;
#pragma unroll
        for (int ai = 0; ai < 2; ++ai)
#pragma unroll
            for (int m = 0; m < 4; ++m) { const int rl = wr * 64 + m * 16 + fr;
#pragma unroll
                for (int bj = 0; bj < 2; ++bj) { const f32x4 v0 = acc[ai][bj][m][0], v1 = acc[ai][bj][m][1];
                    u32x4 w; w.x = cvt_pk_bf16(v0[0], v0[1]); w.y = cvt_pk_bf16(v0[2], v0[3]); w.z = cvt_pk_bf16(v1[0], v1[1]); w.w = cvt_pk_bf16(v1[2], v1[3]);
                    if (fm) *(u32x4*)(FB + ((((((size_t)(u.pm * 2 + ai) * 16 + 4 * pnl + 2 * bj + (wc >> 1)) * 4 + 2 * wr + (m >> 1)) * 2 + (wc & 1)) * 2 + (fq >> 1)) * 64 + 16 * (m & 1) + fr + 32 * (fq & 1)) * 8) = w;
                    else if (u.pn >= 14) *(u32x4*)(O + KV_OFF + (size_t)(u.pm * BM + ai * HALF + rl) * 256 + bj * HALF + wc * 32 + 8 * fq) = w;
                    else { const int cb = (u.pn - 4) * BM + bj * HALF, g_ = cb < 1024 ? cb >> 9 : ((cb - 1024) >> 7) & 1, chb = cb < 1024 ? (cb & 511) : (cb < 1280 ? 512 : 640);
                        *(u32x4*)(O + (size_t)((u.pm * 2 + ai) * 2 + g_) * XUNIT + ((chb >> 8) * 128 + rl) * XUW + (chb & 255) + wc * 32 + 8 * fq) = w; }
                    if (m == 3 && wr == 1 && fr >= 13 && u.pn >= 4 && u.pn < 10) {
                        const int row = u.pm * BM + ai * HALF + 125 + (fr - 13), col = u.pn * BM + bj * HALF + wc * 32 + 8 * fq - 1024;
                        *(u32x4*)(HALO + ((size_t)(row >> 7) * 3 + (fr - 13)) * CONVCH + col) = w; } } }
    }
};
struct EpiResid {
    static constexpr bool PERM = true, KSEG = true, UBEGIN = true; const float* base; float* out; bf16* HB; const float* RSG; const float* RATT; LAS float* tab;
    __device__ __forceinline__ f32x4 unit_fetch(const Unit& u) const {
        const int tid = threadIdx.x; f32x4 r = (f32x4){1.f, 1.f, 1.f, 0.f};
        if (tid < 256) { const size_t row = (size_t)(u.pm * BM + tid); r[0] = RSG[row * 2]; r[1] = RSG[row * 2 + 1]; r[2] = RATT[row]; }
        return r;
    }
    __device__ __forceinline__ void unit_commit(const Unit& u, const f32x4 r) const {
        const int tid = threadIdx.x;
        if (tid < 256) { LAS float* tb = tab + u.par * 768; tb[tid] = r[0] * __builtin_amdgcn_rcpf(r[1]); tb[256 + tid] = r[1] * __builtin_amdgcn_rcpf(r[2]); tb[512 + tid] = r[2]; }
    }
    __device__ __forceinline__ void kseg(f32x4 (&acc)[2][2][4][2], const Unit& u, int t, int wr, int fr) const {
        const LAS float* tb = tab + u.par * 768 + (t == 8 ? 0 : 256) + wr * 64 + fr;
#pragma unroll
        for (int ai = 0; ai < 2; ++ai)
#pragma unroll
            for (int m = 0; m < 4; ++m) { const float rt = tb[ai * HALF + m * 16];
#pragma unroll
                for (int bj = 0; bj < 2; ++bj)
#pragma unroll
                    for (int n = 0; n < 2; ++n) acc[ai][bj][m][n] *= rt; }
    }
    __device__ __forceinline__ void operator()(const f32x4 (&acc)[2][2][4][2], const Unit& u, int wr, int wc, int fr, int fq) const {
        const size_t o0 = (size_t)(u.pm * BM + wr * 64 + fr) * DM + u.pn * BM + wc * 32 + 8 * fq;
#pragma unroll
        for (int ai = 0; ai < 2; ++ai) {
            f32x4 bv[4][2][2];
#pragma unroll
            for (int m = 0; m < 4; ++m)
#pragma unroll
                for (int bj = 0; bj < 2; ++bj)
#pragma unroll
                    for (int n = 0; n < 2; ++n) bv[m][bj][n] = __builtin_nontemporal_load((const f32x4*)(base + o0 + (size_t)(ai * HALF + m * 16) * DM + bj * HALF + n * 4));
            __builtin_amdgcn_sched_barrier(0);
#pragma unroll
            for (int m = 0; m < 4; ++m)
#pragma unroll
                for (int bj = 0; bj < 2; ++bj) { const size_t off = o0 + (size_t)(ai * HALF + m * 16) * DM + bj * HALF;
                    const float sl = tab[u.par * 768 + 512 + ai * HALF + wr * 64 + m * 16 + fr];
                    const f32x4 v0 = bv[m][bj][0] + acc[ai][bj][m][0] * sl, v1 = bv[m][bj][1] + acc[ai][bj][m][1] * sl;
                    u32x4 w; w.x = cvt_pk_bf16(v0[0], v0[1]); w.y = cvt_pk_bf16(v0[2], v0[3]); w.z = cvt_pk_bf16(v1[0], v1[1]); w.w = cvt_pk_bf16(v1[2], v1[3]);
                    *(u32x4*)(HB + off) = w; }
            __builtin_amdgcn_sched_barrier(0);
        }
    }
};
struct EpiHid {
    static constexpr bool PERM = true, KSEG = false, UBEGIN = true; bf16* HID; const int* LIST; const float* RS; LAS float* tab;
    __device__ __forceinline__ f32x4 unit_fetch(const Unit& u) const {
        const int tid = threadIdx.x; f32x4 r = (f32x4){0.f, 0.f, 0.f, 0.f};
        if (tid < 256) { const int pos = u.mt * BM + tid; if (pos < u.cnt) r[0] = RS[(size_t)u.e * LISTCAP + pos]; }
        return r;
    }
    __device__ __forceinline__ void unit_commit(const Unit& u, const f32x4 r) const { const int tid = threadIdx.x; if (tid < 256) tab[u.par * 256 + tid] = r[0]; }
    __device__ __forceinline__ void operator()(const f32x4 (&acc)[2][2][4][2], const Unit& u, int wr, int wc, int fr, int fq) const {
        bf16* base = HID + (size_t)(u.rowbase + wr * 64 + fr) * FF + u.pn * 128 + wc * 32 + 8 * fq;
#pragma unroll
        for (int ai = 0; ai < 2; ++ai)
#pragma unroll
            for (int m = 0; m < 4; ++m) { f32x4 h0, h1; const int pos = u.mt * BM + ai * HALF + wr * 64 + m * 16 + fr;
                const float rs = tab[u.par * 256 + ai * HALF + wr * 64 + m * 16 + fr]; (void)pos;
#pragma unroll
                for (int i = 0; i < 4; ++i) { h0[i] = silu_f(rs * acc[ai][0][m][0][i]) * (rs * acc[ai][1][m][0][i]); h1[i] = silu_f(rs * acc[ai][0][m][1][i]) * (rs * acc[ai][1][m][1][i]); }
                u32x4 w; w.x = cvt_pk_bf16(h0[0], h0[1]); w.y = cvt_pk_bf16(h0[2], h0[3]); w.z = cvt_pk_bf16(h1[0], h1[1]); w.w = cvt_pk_bf16(h1[2], h1[3]);
                *(u32x4*)(base + (size_t)(ai * HALF + m * 16) * FF) = w; }
    }
};
struct EpiYb {
    static constexpr bool PERM = true, KSEG = false, UBEGIN = true; bf16* YB; const int* LIST; const float* TG; LAS float* tab;
    __device__ __forceinline__ f32x4 unit_fetch(const Unit& u) const {
        const int tid = threadIdx.x; f32x4 r = (f32x4){0.f, 0.f, 0.f, 0.f};
        if (tid < 256) { const int pos = u.mt * BM + tid; if (pos < u.cnt) r[0] = TG[(size_t)u.e * LISTCAP + pos]; }
        return r;
    }
    __device__ __forceinline__ void unit_commit(const Unit& u, const f32x4 r) const { const int tid = threadIdx.x; if (tid < 256) tab[u.par * 256 + tid] = r[0]; }
    __device__ __forceinline__ void operator()(const f32x4 (&acc)[2][2][4][2], const Unit& u, int wr, int wc, int fr, int fq) const {
        bf16* base = YB + (size_t)(u.rowbase + wr * 64 + fr) * DM + u.pn * BM + wc * 32 + 8 * fq;
#pragma unroll
        for (int ai = 0; ai < 2; ++ai)
#pragma unroll
            for (int m = 0; m < 4; ++m) { const int pos = u.mt * BM + ai * HALF + wr * 64 + m * 16 + fr;
                const float gt = tab[u.par * 256 + ai * HALF + wr * 64 + m * 16 + fr]; (void)pos;
#pragma unroll
                for (int bj = 0; bj < 2; ++bj) { const f32x4 v0 = acc[ai][bj][m][0] * gt, v1 = acc[ai][bj][m][1] * gt;
                    u32x4 w; w.x = cvt_pk_bf16(v0[0], v0[1]); w.y = cvt_pk_bf16(v0[2], v0[3]); w.z = cvt_pk_bf16(v1[0], v1[1]); w.w = cvt_pk_bf16(v1[2], v1[3]);
                    *(u32x4*)(base + (size_t)(ai * HALF + m * 16) * DM + bj * HALF) = w; } }
    }
};

template <class Epi, class Sched, bool ALIGN_EPI>
__device__ __forceinline__ void gemm_phase(LAS unsigned char* lds, const char* Abase, const int K, const Sched& S, const Epi& E) {
    const int tid = threadIdx.x, wid = __builtin_amdgcn_readfirstlane(tid >> 6), lane = tid & 63, wr = wid >> 2, wc = wid & 3, fr = lane & 15, fq = lane >> 4;
    const int nt = K / BK;
    int Rp[2], Cp[2]; unsigned voffB[2];
#pragma unroll
    for (int i = 0; i < 2; ++i) { int R, C; stage_rc(tid * 16 + i * 8192, R, C); Rp[i] = R; Cp[i] = C; const int Rb = Epi::PERM ? ((R & ~31) + perm32(R & 31)) : R; voffB[i] = (unsigned)(Rb * K + C) * 2u; }
    const size_t kstep = (size_t)(BK * 2);
    const size_t hstep = (size_t)HALF * K * 2;
    const unsigned ldsw = (unsigned)wid * 1024u;
    const int aoff = lds_byte(wr * 64 + fr, fq * 8), boff = lds_byte(wc * 32 + fr, fq * 8);
#define PG8_SA(b, h) (((b) * 2 + (h)) * HTB)
#define PG8_SB(b, h) ((4 + (b) * 2 + (h)) * HTB)
#define PG8_STAGE(bufoff, gbase, voff) do { _Pragma("unroll") for (int _i = 0; _i < 2; ++_i) \
        __builtin_amdgcn_global_load_lds((const unsigned*)((const char*)(gbase) + (voff)[_i]), (LAS unsigned*)(lds + (bufoff) + ldsw + _i * 8192), 16, 0, 0); } while (0)
#define PG8_LDA(dst, b, h) do { _Pragma("unroll") for (int m = 0; m < 4; ++m) _Pragma("unroll") for (int k = 0; k < 2; ++k) dst[m][k] = *(const LAS bf16x8*)(lds + PG8_SA(b, h) + aoff + m * 2048 + k * 1024); } while (0)
#define PG8_LDB(dst, b, h) do { _Pragma("unroll") for (int n = 0; n < 2; ++n) _Pragma("unroll") for (int k = 0; k < 2; ++k) dst[n][k] = *(const LAS bf16x8*)(lds + PG8_SB(b, h) + boff + n * 2048 + k * 1024); } while (0)
#define PG8_MMA(ai, bj, At, Bt) do { __builtin_amdgcn_s_setprio(1); _Pragma("unroll") for (int m = 0; m < 4; ++m) _Pragma("unroll") for (int n = 0; n < 2; ++n) _Pragma("unroll") for (int k = 0; k < 2; ++k) \
        acc[ai][bj][m][n] = __builtin_amdgcn_mfma_f32_16x16x32_bf16(Bt[n][k], At[m][k], acc[ai][bj][m][n], 0, 0, 0); __builtin_amdgcn_s_setprio(0); } while (0)
#define PG8_WAIT_V(n) asm volatile("s_waitcnt vmcnt(" #n ")" ::: "memory")
#define PG8_WAIT_L(n) asm volatile("s_waitcnt lgkmcnt(" #n ")" ::: "memory")
#define PG8_BAR __builtin_amdgcn_s_barrier()
#define PG8_SCHED __builtin_amdgcn_sched_barrier(0)
#define PG8_OFFS(dst, un) do { _Pragma("unroll") for (int _h = 0; _h < 2; ++_h) _Pragma("unroll") for (int _i = 0; _i < 2; ++_i) \
        dst[_h][_i] = (S.arow(un, _h * HALF + Rp[_i]) * (unsigned)K + (unsigned)Cp[_i]) * 2u; } while (0)
    Unit cur, nxt; int ui = 0;
    if (!S.next(0, cur)) return;
    f32x4 acc[2][2][4][2];
#pragma unroll
    for (int a = 0; a < 2; ++a)
#pragma unroll
        for (int b = 0; b < 2; ++b)
#pragma unroll
            for (int m = 0; m < 4; ++m)
#pragma unroll
                for (int n = 0; n < 2; ++n) acc[a][b][m][n] = (f32x4){0.f, 0.f, 0.f, 0.f};
    bf16x8 At[4][2], B0[2][2], B1[2][2];
    unsigned co[2][2], no[2][2];
    cur.par = 0;
    if constexpr (Epi::UBEGIN) E.unit_commit(cur, E.unit_fetch(cur));
    PG8_OFFS(co, cur);
    const char* cB = cur.bt;
    PG8_STAGE(PG8_SB(0, 0), cB, voffB); PG8_STAGE(PG8_SB(0, 1), cB + hstep, voffB); PG8_STAGE(PG8_SA(0, 0), Abase, co[0]); PG8_STAGE(PG8_SA(0, 1), Abase, co[1]);
    if (wr == 1) PG8_BAR;
    PG8_WAIT_V(2); PG8_BAR;
    PG8_STAGE(PG8_SB(1, 0), cB + kstep, voffB); PG8_STAGE(PG8_SA(1, 0), Abase + kstep, co[0]); PG8_STAGE(PG8_SB(1, 1), cB + hstep + kstep, voffB);
    PG8_WAIT_V(6); PG8_BAR;
    for (;;) {
        const bool has_next = S.next(ui + 1, nxt);
        nxt.par = (ui + 1) % 3;
        f32x4 pend = (f32x4){0.f, 0.f, 0.f, 0.f};
        if constexpr (Epi::UBEGIN) { if (has_next) pend = E.unit_fetch(nxt); }
        if (has_next) { PG8_OFFS(no, nxt); } else {
#pragma unroll
            for (int h = 0; h < 2; ++h) { no[h][0] = co[h][0]; no[h][1] = co[h][1]; } }
        const char* nB = has_next ? nxt.bt : cB;
        for (int t = 0; t < nt; t += 2) {
            const bool last = (t == nt - 2);
            const char* a1 = Abase + (size_t)(t + 1) * kstep;
            const char* a2 = last ? Abase : Abase + (size_t)(t + 2) * kstep; const char* b2 = last ? nB : cB + (size_t)(t + 2) * kstep;
            const char* a3 = a2 + kstep; const char* b3 = b2 + kstep;
            unsigned s2[2][2];
#pragma unroll
            for (int h = 0; h < 2; ++h) { s2[h][0] = last ? no[h][0] : co[h][0]; s2[h][1] = last ? no[h][1] : co[h][1]; }
            if constexpr (Epi::KSEG) { if (t == 8 || t == 16) E.kseg(acc, cur, t, wr, fr); }
            PG8_LDB(B0, 0, 0); PG8_LDB(B1, 0, 1); PG8_SCHED; PG8_LDA(At, 0, 0); PG8_STAGE(PG8_SA(1, 1), a1, co[1]);
            PG8_WAIT_V(8); PG8_WAIT_L(0); PG8_BAR; PG8_MMA(0, 0, At, B0); PG8_MMA(0, 1, At, B1); PG8_BAR; PG8_SCHED;
            PG8_LDA(At, 0, 1); PG8_STAGE(PG8_SB(0, 0), b2, voffB); PG8_STAGE(PG8_SB(0, 1), b2 + hstep, voffB); PG8_STAGE(PG8_SA(0, 0), a2, s2[0]);
            PG8_WAIT_V(8); PG8_WAIT_L(0); PG8_BAR; PG8_MMA(1, 0, At, B0); PG8_MMA(1, 1, At, B1); PG8_BAR; PG8_SCHED;
            PG8_LDB(B0, 1, 0); PG8_LDB(B1, 1, 1); PG8_SCHED; PG8_LDA(At, 1, 0); PG8_STAGE(PG8_SA(0, 1), a2, s2[1]);
            PG8_WAIT_V(8); PG8_WAIT_L(0); PG8_BAR; PG8_MMA(0, 0, At, B0); PG8_MMA(0, 1, At, B1); PG8_BAR; PG8_SCHED;
            PG8_LDA(At, 1, 1); PG8_STAGE(PG8_SB(1, 0), b3, voffB); PG8_STAGE(PG8_SB(1, 1), b3 + hstep, voffB); PG8_STAGE(PG8_SA(1, 0), a3, s2[0]);
            PG8_WAIT_V(8); PG8_WAIT_L(0); PG8_BAR; PG8_MMA(1, 0, At, B0); PG8_MMA(1, 1, At, B1); PG8_BAR; PG8_SCHED;
        }
        if constexpr (ALIGN_EPI) { if (wr == 0) PG8_BAR; }
        E(acc, cur, wr, wc, fr, fq);
        if (!has_next) break;
        if constexpr (Epi::UBEGIN) E.unit_commit(nxt, pend);
#pragma unroll
        for (int a = 0; a < 2; ++a)
#pragma unroll
            for (int b = 0; b < 2; ++b)
#pragma unroll
                for (int m = 0; m < 4; ++m)
#pragma unroll
                    for (int n = 0; n < 2; ++n) acc[a][b][m][n] = (f32x4){0.f, 0.f, 0.f, 0.f};
        cur = nxt; cB = nB; ++ui;
#pragma unroll
        for (int h = 0; h < 2; ++h) { co[h][0] = no[h][0]; co[h][1] = no[h][1]; }
        if constexpr (ALIGN_EPI) { if (wr == 1) PG8_BAR; }
    }
    PG8_WAIT_V(0);
    if constexpr (!ALIGN_EPI) { if (wr == 0) PG8_BAR; }
    PG8_BAR;
#undef PG8_SA
#undef PG8_SB
#undef PG8_STAGE
#undef PG8_LDA
#undef PG8_LDB
#undef PG8_MMA
#undef PG8_WAIT_V
#undef PG8_WAIT_L
#undef PG8_BAR
#undef PG8_SCHED
#undef PG8_OFFS
}
}

__device__ __forceinline__ void transpose_load(const float* W, int ldw, int k0, int n0, int lane, const float* kscale, f32x4 (&tv)[8], f32x4 (&ks)[2]) {
#pragma unroll
    for (int i = 0; i < 8; ++i) { const int kk = 8 * i + (lane >> 3); tv[i] = __builtin_nontemporal_load((const f32x4*)(W + (size_t)(k0 + kk) * ldw + n0 + 4 * (lane & 7))); }
    ks[0] = (f32x4){1.f, 1.f, 1.f, 1.f}; ks[1] = ks[0];
    if (kscale) { ks[0] = *(const f32x4*)(kscale + k0 + 8 * (lane & 7)); ks[1] = *(const f32x4*)(kscale + k0 + 8 * (lane & 7) + 4); }
}
__device__ __forceinline__ void transpose_store(const f32x4 (&tv)[8], const f32x4 (&ks)[2], bf16* WT, int K, int drow0, int k0, LAS float* scr, int lane) {
#pragma unroll
    for (int i = 0; i < 8; ++i) { LAS float* d = scr + (8 * i + (lane >> 3)) * 33 + 4 * (lane & 7); d[0] = tv[i][0]; d[1] = tv[i][1]; d[2] = tv[i][2]; d[3] = tv[i][3]; }
    asm volatile("s_waitcnt lgkmcnt(0)" ::: "memory");
    const int c = lane & 7;
#pragma unroll
    for (int j = 0; j < 4; ++j) { const int n = (lane >> 3) + 8 * j; const LAS float* s = scr + (8 * c) * 33 + n;
        u32x4 o; o.x = pk2(s[0 * 33] * ks[0][0], s[1 * 33] * ks[0][1]); o.y = pk2(s[2 * 33] * ks[0][2], s[3 * 33] * ks[0][3]); o.z = pk2(s[4 * 33] * ks[1][0], s[5 * 33] * ks[1][1]); o.w = pk2(s[6 * 33] * ks[1][2], s[7 * 33] * ks[1][3]);
        *(u32x4*)(WT + (size_t)(drow0 + n) * K + k0 + 8 * c) = o; }
    asm volatile("s_waitcnt lgkmcnt(0)" ::: "memory");
}
__device__ __forceinline__ void transpose_item(const float* W, int ldw, int k0, int n0, bf16* WT, int K, int drow0, LAS float* scr, int lane, const float* kscale = nullptr) {
    f32x4 tv[8]; f32x4 ks[2];
    transpose_load(W, ldw, k0, n0, lane, kscale, tv, ks);
    transpose_store(tv, ks, WT, K, drow0, k0, scr, lane);
}

__device__ __forceinline__ void phase_prologue(Ctx& C) {
    constexpr int WRS = 2064;
    TSTART(1000);
    LAS unsigned char* WH = (LAS unsigned char*)C.lds;
    LAS unsigned char* WLo = WH + 33024;
    LAS float* PD = (LAS float*)(WH + 66048);
    LAS unsigned char* XL = WH + 66048 + 16384;
    const int gw = C.bid * NWAVES + C.wave, NGW = C.G * NWAVES;
    const int lane = C.lane, r32 = lane & 31, h = lane >> 5, w = C.wave;
    const int dcol = (w & 3) + 8 * (w >> 2) + 4 * h; const float dtb = C.dt_bias[dcol];
    f32x4 gn[4], ring[4][4];
#pragma unroll
    for (int j = 0; j < 4; ++j) gn[j] = ((const f32x4*)C.norm_mix)[lane + 64 * j];
    {   const int rbf = C.bid < M / 128 ? C.bid : 0;
#pragma unroll
        for (int s = 0; s < 4; ++s)
#pragma unroll
            for (int j = 0; j < 4; ++j) ring[s][j] = __builtin_nontemporal_load((const f32x4*)(C.x + (size_t)(rbf * 128 + w + 8 * s) * DM) + lane + 64 * j); }
    {   f32x4 wv[8];
#pragma unroll
        for (int i = 0; i < 8; ++i) { const int idx = C.tid + NTHREADS * i, kk = idx >> 2, j4 = idx & 3; wv[i] = *(const f32x4*)(C.w_in + (size_t)kk * INDIM + DT0 + 4 * j4); }
#pragma unroll
        for (int i = 0; i < 8; ++i) { const int idx = C.tid + NTHREADS * i, kk = idx >> 2, j4 = idx & 3;
#pragma unroll
            for (int t = 0; t < 4; ++t) { const float v = wv[i][t]; const int j = 4 * j4 + t;
                const unsigned hi = f2bf(v); *(LAS bf16*)(WH + j * WRS + kk * 2) = (bf16)hi; *(LAS bf16*)(WLo + j * WRS + kk * 2) = (bf16)f2bf(v - bf2f(hi)); } } }
    __syncthreads();
    TSTOP(1000); TSTART(1001);
    for (int rb = C.bid; rb < M / 128; rb += C.G) {
        const int row0 = rb * 128 + w;
        if (rb != C.bid) {
#pragma unroll
            for (int s = 0; s < 4; ++s)
#pragma unroll
                for (int j = 0; j < 4; ++j) ring[s][j] = __builtin_nontemporal_load((const f32x4*)(C.x + (size_t)(row0 + 8 * s) * DM) + lane + 64 * j);
        }
#pragma unroll
        for (int i = 0; i < 16; ++i) {
            const int row = row0 + 8 * i;
            f32x4 v[4];
#pragma unroll
            for (int j = 0; j < 4; ++j) v[j] = ring[i & 3][j];
            if (i + 4 < 16) {
#pragma unroll
                for (int j = 0; j < 4; ++j) ring[i & 3][j] = __builtin_nontemporal_load((const f32x4*)(C.x + (size_t)(row + 32) * DM) + lane + 64 * j);
            }
            float ss = 0.f;
#pragma unroll
            for (int j = 0; j < 4; ++j) ss += v[j][0] * v[j][0] + v[j][1] * v[j][1] + v[j][2] * v[j][2] + v[j][3] * v[j][3];
            const float rstd = 1.0f / sqrtf(wave_sum(ss) * (1.0f / DM) + EPS);
            u32x2* o = (u32x2*)(C.XN + (size_t)row * DM) + lane;
#pragma unroll
            for (int j = 0; j < 4; ++j) { const f32x4 g = gn[j]; v[j] = v[j] * rstd * g; u32x2 wv; wv.x = cvtpk(v[j][0], v[j][1]); wv.y = cvtpk(v[j][2], v[j][3]); o[64 * j] = wv;
                *(LAS u32x2*)(XL + (8 * (i & 3) + w) * WRS + (lane + 64 * j) * 8) = wv; }
            __builtin_amdgcn_sched_barrier(0);
            if ((i & 3) == 3) {
                asm volatile("s_waitcnt lgkmcnt(0)" ::: "memory"); __builtin_amdgcn_s_barrier(); asm volatile("" ::: "memory");
                f32x16 acc;
#pragma unroll
                for (int r = 0; r < 16; ++r) acc[r] = 0.f;
                LAS const unsigned char* wa = WH + (lane & 15) * WRS + (128 * w + 8 * h) * 2;
                LAS const unsigned char* xb = XL + r32 * WRS + (128 * w + 8 * h) * 2;
#pragma unroll
                for (int s = 0; s < 8; ++s) { const bf16x8 xf = *(LAS const bf16x8*)(xb + s * 32), ah = *(LAS const bf16x8*)(wa + s * 32), al = *(LAS const bf16x8*)(wa + 33024 + s * 32);
                    acc = MFMA32(ah, xf, acc); acc = MFMA32(al, xf, acc); }
#pragma unroll
                for (int r = 0; r < 8; ++r) PD[(w * 8 + r) * 64 + lane] = acc[r];
                asm volatile("s_waitcnt lgkmcnt(0)" ::: "memory"); __builtin_amdgcn_s_barrier(); asm volatile("" ::: "memory");
                float dv = dtb;
#pragma unroll
                for (int ws = 0; ws < 8; ++ws) dv += PD[(ws * 8 + w) * 64 + lane];
                C.DT[((size_t)rb * 16 + dcol) * 128 + 32 * (i >> 2) + r32] = softplus_f(dv);
                __builtin_amdgcn_sched_barrier(0);
            }
        }
        __syncthreads();
        TSTOP(1001);
    }
    TSTOP(1002); TSTART(1003);
    __syncthreads();
    for (int idx = C.bid * NTHREADS + C.tid; idx < 96 * 1024; idx += C.G * NTHREADS) {
        const int e = idx >> 10, kk = idx & 1023;
        float v = 0.f; if (e < 64) v = C.w_re[kk * 64 + e]; else if (e < 72) v = C.w_rg[kk * 8 + (e - 64)];
        v *= C.norm_ffn[kk];
        const unsigned hi = f2bf(v);
        const int fi = (((e >> 5) * 64 + (kk >> 4)) * 64 + (e & 31) + 32 * ((kk >> 3) & 1)) * 8 + (kk & 7);
        C.WRH[fi] = (bf16)hi; C.WRL[fi] = (bf16)f2bf(v - bf2f(hi));
    }
    LAS float* scr = (LAS float*)((LAS unsigned char*)C.lds + C.wave * 8704);
    for (int it = gw; it < 1920 + 1024; it += NGW) {
        if (it < 1920) { const int kb = it / 120, nb = it % 120, n0 = nb * 32; transpose_item(C.w_in, INDIM, kb * 64, n0 < DT0 ? n0 : n0 + 16, C.WIN, DM, n0, scr, C.lane); }
        else { const int r = it - 1920, kb = r >> 5, nb = r & 31; transpose_item(C.w_out, DM, kb * 64, nb * 32, C.WOUT, 2048, nb * 32, scr, C.lane, kb < 16 ? C.ssd_norm : C.attn_norm - 1024); }
    }
    TSTOP(1003);
}

__device__ __forceinline__ void phase_gemm1(Ctx& C) {
    pg8::DenseOrder S; S.init(M, NIN, DM, C.WIN, C.G - NCONV, C.bid - NCONV);
    pg8::EpiProj E{C.PROJ, 0, C.HALO, C.ZF, C.QF};
    pg8::gemm_phase<pg8::EpiProj, pg8::DenseOrder, true>((LAS unsigned char*)C.lds, (const char*)C.XN, DM, S, E);
}

constexpr int KRS = 144, VRS = 192;
__device__ __forceinline__ void attn_unit_fast(Ctx& C, int u) {
    const int blk = u & 31, b = u >> 5, t0 = blk * 128;
    LAS unsigned char* L = (LAS unsigned char*)C.lds;
    LAS unsigned char* Kimg = L;
    LAS unsigned char* Vimg = L + 36864;
    LAS float* ssq = (LAS float*)(L + 86016);
    LAS float* rsv = ssq + 16 * 128;
    const int lane = C.lane, r32 = lane & 31, h = lane >> 5, q4 = (lane & 15) >> 2, p4 = lane & 3, b16 = (lane >> 4) & 1;
    const float c2 = 0.125f * 1.4426950408889634f;
    for (int kv = 0; kv < 2; ++kv) {
        TSTART(210);
        __syncthreads();
#pragma unroll
        for (int i = 0; i < 4; ++i) {
            const int idx = C.tid + NTHREADS * i, row = idx >> 3, ch = idx & 7, t = t0 - 128 + row;
            u32x4 kk = (u32x4){0u, 0u, 0u, 0u}, vv = (u32x4){0u, 0u, 0u, 0u};
            if (t >= 0) { const bf16* pr = C.PROJ + KV_OFF + (size_t)(b * SEQ + t) * 256; kk = *(const u32x4*)(pr + kv * 64 + ch * 8); vv = *(const u32x4*)(pr + 128 + kv * 64 + ch * 8); }
            *(LAS u32x4*)(Kimg + row * KRS + ch * 16) = kk; *(LAS u32x4*)(Vimg + row * VRS + ch * 16) = vv;
        }
        __syncthreads();
        TSTOP(210);
        const int hq = kv * 8 + C.wave;
        const float sink2 = C.sinks[hq] * 1.4426950408889634f;
        const bf16* qbase = C.QF + ((size_t)(u * 16 + hq) * 16 * 64 + lane) * 8;
        bf16x8 qf[4], qn[4];
#pragma unroll
        for (int d0 = 0; d0 < 4; ++d0) { qf[d0] = *(const bf16x8*)(qbase + d0 * 512); qn[d0] = qf[d0]; }
        for (int rb = 0; rb < 4; ++rb) {
            const int qi = 32 * rb + r32;
            if (rb < 3) {
#pragma unroll
                for (int d0 = 0; d0 < 4; ++d0) qn[d0] = *(const bf16x8*)(qbase + ((rb + 1) * 4 + d0) * 512);
            }
            f32x16 o0, o1;
#pragma unroll
            for (int r = 0; r < 16; ++r) { o0[r] = 0.f; o1[r] = 0.f; }
            float m = sink2, l = (h == 0) ? 1.f : 0.f;
            const int kt0 = rb >> 1;
            const int dm = r32 - 4 * h;
            auto do_tile = [&](const int kt, const bool L0, const int M0, const bool L1, const int M1) __attribute__((always_inline)) {
                f32x16 p0, p1;
#pragma unroll
                for (int r = 0; r < 16; ++r) { p0[r] = 0.f; p1[r] = 0.f; }
                LAS const unsigned char* ka = Kimg + (kt * 64 + r32) * KRS + 16 * h;
#pragma unroll
                for (int d0 = 0; d0 < 4; ++d0) {
                    if (L0) { const bf16x8 a0 = *(LAS const bf16x8*)(ka + d0 * 32); p0 = MFMA32(a0, qf[d0], p0); }
                    if (L1) { const bf16x8 a1 = *(LAS const bf16x8*)(ka + 32 * KRS + d0 * 32); p1 = MFMA32(a1, qf[d0], p1); }
                }
                float mt = -INFINITY;
#pragma unroll
                for (int r = 0; r < 16; ++r) {
                    const int cr = (r & 3) + 8 * (r >> 2);
                    if (L0) { if (M0 == 1 && !(cr > dm)) p0[r] = -INFINITY; if (M0 == 2 && !(cr <= dm)) p0[r] = -INFINITY; mt = fmaxf(mt, p0[r]); }
                    if (L1) { if (M1 == 1 && !(cr > dm)) p1[r] = -INFINITY; if (M1 == 2 && !(cr <= dm)) p1[r] = -INFINITY; mt = fmaxf(mt, p1[r]); }
                }
                mt = fmaxf(mt, __shfl_xor(mt, 32)) * c2;
                const float mn = fmaxf(m, mt), alpha = __builtin_amdgcn_exp2f(m - mn);
                m = mn;
                float ls = 0.f;
#pragma unroll
                for (int r = 0; r < 16; ++r) {
                    if (L0) { p0[r] = __builtin_amdgcn_exp2f(__builtin_fmaf(p0[r], c2, -mn)); ls += p0[r]; }
                    if (L1) { p1[r] = __builtin_amdgcn_exp2f(__builtin_fmaf(p1[r], c2, -mn)); ls += p1[r]; }
                }
                l = l * alpha + ls;
#pragma unroll
                for (int r = 0; r < 16; ++r) { o0[r] *= alpha; o1[r] *= alpha; }
                LAS const unsigned char* va = Vimg + (kt * 64 + 4 * h + q4) * VRS + 32 * b16 + 8 * p4;
#pragma unroll
                for (int s = 0; s < 4; ++s) {
                    if ((s < 2) ? L0 : L1) {
                        const bf16x8 pf = (s < 2) ? PACK8(p0, (s & 1) * 8) : PACK8(p1, (s & 1) * 8);
                        const bf16x8 v0f = cat8(tr16(va + (16 * s) * VRS), tr16(va + (16 * s + 8) * VRS));
                        const bf16x8 v1f = cat8(tr16(va + (16 * s) * VRS + 64), tr16(va + (16 * s + 8) * VRS + 64));
                        o0 = MFMA32(v0f, pf, o0); o1 = MFMA32(v1f, pf, o1);
                    }
                }
            };
            TSTART(211);
            if (blk > 0 || kt0 + 1 >= 2) do_tile(kt0 + 1, true, 0, true, 0);
            if (rb & 1) {
                if (blk > 0 || kt0 >= 2) do_tile(kt0, false, 0, true, 1);
                do_tile(kt0 + 2, true, 0, true, 2);
            } else {
                if (blk > 0 || kt0 >= 2) do_tile(kt0, true, 1, true, 0);
                do_tile(kt0 + 2, true, 2, false, 0);
            }
            TSTOP(211); TSTART(212);
            const float ltot = l + __shfl_xor(l, 32), inv = 1.0f / ltot;
            float sq = 0.f;
#pragma unroll
            for (int r = 0; r < 16; ++r) { o0[r] *= inv; o1[r] *= inv; sq += o0[r] * o0[r] + o1[r] * o1[r]; }
            sq += __shfl_xor(sq, 32);
            if (h == 0) ssq[hq * 128 + qi] = sq;
            LAS unsigned char* ost = L + 94720 + C.wave * 4608;
#pragma unroll
            for (int g = 0; g < 4; g += 2) {
                u32x2 a0, b0, a1, b1;
                a0.x = cvtpk(o0[4 * g], o0[4 * g + 1]); a0.y = cvtpk(o0[4 * g + 2], o0[4 * g + 3]); b0.x = cvtpk(o0[4 * g + 4], o0[4 * g + 5]); b0.y = cvtpk(o0[4 * g + 6], o0[4 * g + 7]);
                a1.x = cvtpk(o1[4 * g], o1[4 * g + 1]); a1.y = cvtpk(o1[4 * g + 2], o1[4 * g + 3]); b1.x = cvtpk(o1[4 * g + 4], o1[4 * g + 5]); b1.y = cvtpk(o1[4 * g + 6], o1[4 * g + 7]);
                *(LAS u32x4*)(ost + r32 * 144 + (8 * g + 8 * h) * 2) = widen16(a0, b0); *(LAS u32x4*)(ost + r32 * 144 + (32 + 8 * g + 8 * h) * 2) = widen16(a1, b1);
            }
            {   bf16* orow = C.MIX + (size_t)(b * SEQ + t0 + 32 * rb + (lane >> 3)) * 2048 + 1024 + hq * 64 + (lane & 7) * 8;
#pragma unroll
                for (int i = 0; i < 4; ++i) *(u32x4*)(orow + (size_t)(8 * i) * 2048) = *(LAS const u32x4*)(ost + (8 * i + (lane >> 3)) * 144 + (lane & 7) * 16);
            }
#pragma unroll
            for (int d0 = 0; d0 < 4; ++d0) qf[d0] = qn[d0];
            TSTOP(212);
        }
    }
    __syncthreads();
    if (C.tid < 128) { float s = 0.f;
#pragma unroll
        for (int hh = 0; hh < 16; ++hh) s += ssq[hh * 128 + C.tid];
        C.RATT[b * SEQ + t0 + C.tid] = 1.0f / sqrtf(s * (1.0f / 1024.f) + EPS); }
    __syncthreads();
}

__device__ __forceinline__ void chunk_cumsum(const Ctx& C, int rowbase, int hd, float& d0, float& d1, float& c0, float& c1, float& total) {
    const float A = -expf(C.a_log[hd]);
    { const f32x2_t dd = *(const f32x2_t*)(C.DT + ((size_t)(rowbase >> 7) * 16 + hd) * 128 + 2 * C.lane); d0 = dd.x; d1 = dd.y; }
    const float a0 = d0 * A, a1 = d1 * A;
    float v = a0 + a1;
#pragma unroll
    for (int o = 1; o < 64; o <<= 1) { const float t = __shfl_up(v, o); if (C.lane >= o) v += t; }
    c1 = v; c0 = v - a1; total = __shfl(v, 63);
}

constexpr int X4RS = 576, BRS = 320;
template <int PS> __device__ __forceinline__ int st_ch768(int cg) { return PS == 1 ? 128 * XUW + cg * 8 : (cg < 32 ? cg * 8 : 2 * 128 * XUW + (cg - 32) * 8); }
template <int PS> __device__ __forceinline__ void st_task(const Ctx& C, int g, int& cg, int& ch, int& l0) {
    const int t = C.tid;
    cg = PS == 0 ? (t & 63) : (t & 31); const int run = PS == 0 ? (t >> 6) : (t >> 5);
    ch = PS == 1 ? g * 512 + 256 + cg * 8 : (cg < 32 ? g * 512 + cg * 8 : (cg < 48 ? 1024 + g * 128 + (cg - 32) * 8 : 1280 + g * 128 + (cg - 48) * 8));
    l0 = (PS == 0 ? 16 : 8) * run;
}
template <int PS> __device__ __forceinline__ void st_load_raw(const Ctx& C, int u, u32x4 (&raw)[19]) {
    const int g = u & 1, c = (u >> 1) & 31, b = u >> 6, rowbase = b * SEQ + c * CHK;
    int cg, ch, l0; st_task<PS>(C, g, cg, ch, l0);
    int toff = l0 * XUW + st_ch768<PS>(cg); asm volatile("" : "+v"(toff));
    const bf16* ub = C.PROJ + (size_t)((rowbase >> 7) * 2 + g) * XUNIT;
    const bf16* hp = l0 > 0 ? ub + (toff - 3 * XUW) : C.HALO + ((size_t)(b * NCH + (c > 0 ? c - 1 : 0)) * 3) * CONVCH + ch;
    const size_t hs = l0 > 0 ? (size_t)XUW : (size_t)CONVCH;
    const bool hz = l0 == 0 && c == 0;
#pragma unroll
    for (int i = 0; i < 3; ++i) { const u32x4 v = *(const u32x4*)(hp + i * hs); raw[i] = hz ? (u32x4){0u, 0u, 0u, 0u} : v; }
#pragma unroll
    for (int i = 3; i < (PS == 0 ? 19 : 11); ++i) raw[i] = *(const u32x4*)(ub + (i - 3) * XUW + toff);
}
template <int PS> __device__ __forceinline__ void st_step(Ctx& C, int u, int un, const u32x4 (&raw)[19], u32x4 (&nxt)[19]) {
    const int g = u & 1, c = (u >> 1) & 31, b = u >> 6, t0 = c * CHK, rowbase = b * SEQ + t0;
    LAS unsigned char* L = (LAS unsigned char*)C.lds;
    LAS unsigned char* XI = L;
    LAS unsigned char* BI = L + 73728;
    LAS float* WL = (LAS float*)(L + 114688);
    const int lane = C.lane, h = lane >> 5, q4 = (lane & 15) >> 2, p4 = lane & 3, b16 = (lane >> 4) & 1, w = C.wave;
    int cg, ch, l0; st_task<PS>(C, g, cg, ch, l0);
    const bool task = true;
    f32x4 cwv[4][2], cbv[2];
#pragma unroll
    for (int j = 0; j < 4; ++j) { cwv[j][0] = *(const f32x4*)(C.conv_w + j * CONVCH + ch); cwv[j][1] = *(const f32x4*)(C.conv_w + j * CONVCH + ch + 4); }
    cbv[0] = *(const f32x4*)(C.conv_b + ch); cbv[1] = *(const f32x4*)(C.conv_b + ch + 4);
    float d0 = 0.f, d1 = 0.f, Aneg = 0.f;
    if (PS == 0) { const int hd = g * 8 + w; Aneg = C.a_log[hd]; const f32x2_t dd = *(const f32x2_t*)(C.DT + ((size_t)(rowbase >> 7) * 16 + hd) * 128 + 2 * lane); d0 = dd.x; d1 = dd.y; }
    asm volatile("s_waitcnt vmcnt(0)" ::: "memory");
    __syncthreads();
    if (PS == 0) {
        const float A = -expf(Aneg), a0 = d0 * A, a1 = d1 * A;
        float v = a0 + a1;
#pragma unroll
        for (int o = 1; o < 64; o <<= 1) { const float t = __shfl_up(v, o); if (lane >= o) v += t; }
        const float c1 = v, c0 = v - a1, tot = __shfl(v, 63);
        WL[w * 128 + 2 * lane] = d0 * expf(tot - c0); WL[w * 128 + 2 * lane + 1] = d1 * expf(tot - c1);
        if (lane == 0) C.CDEC[(b * NCH + c) * NH + g * 8 + w] = expf(tot);
    }
    st_load_raw<1 - PS>(C, un, nxt);
    int soff = l0 * XUW + st_ch768<PS>(cg), xoff = l0 * X4RS + (cg & 31) * 16, boff = l0 * BRS + (cg - 32) * 16; asm volatile("" : "+v"(soff), "+v"(xoff), "+v"(boff));
    if (task) {
#pragma unroll
        for (int i = 0; i < (PS == 0 ? 16 : 8); ++i) {
            float o[8];
#pragma unroll
            for (int kq = 0; kq < 8; ++kq) o[kq] = cbv[kq >> 2][kq & 3];
#pragma unroll
            for (int j = 0; j < 4; ++j) { const u32x4 rv = raw[i + j];
                o[0] += cwv[j][0][0] * bf2f(rv.x); o[1] += cwv[j][0][1] * bf2f(rv.x >> 16); o[2] += cwv[j][0][2] * bf2f(rv.y); o[3] += cwv[j][0][3] * bf2f(rv.y >> 16);
                o[4] += cwv[j][1][0] * bf2f(rv.z); o[5] += cwv[j][1][1] * bf2f(rv.z >> 16); o[6] += cwv[j][1][2] * bf2f(rv.w); o[7] += cwv[j][1][3] * bf2f(rv.w >> 16); }
            u32x4 pk; pk.x = cvtpk(silu_f(o[0]), silu_f(o[1])); pk.y = cvtpk(silu_f(o[2]), silu_f(o[3])); pk.z = cvtpk(silu_f(o[4]), silu_f(o[5])); pk.w = cvtpk(silu_f(o[6]), silu_f(o[7]));
            *(u32x4*)(C.PROJ + (size_t)((rowbase >> 7) * 2 + g) * XUNIT + i * XUW + soff) = pk;
            if (PS == 1 || cg < 32) *(LAS u32x4*)(XI + i * X4RS + xoff) = pk;
            else if (cg < 48) *(LAS u32x4*)(BI + i * BRS + boff) = pk;
            __builtin_amdgcn_sched_barrier(0);
        }
    }
    asm volatile("s_waitcnt lgkmcnt(0)" ::: "memory"); __builtin_amdgcn_s_barrier(); asm volatile("" ::: "memory");
    const int hl = w & 3, hh = PS * 4 + hl, nt0 = 2 * (w >> 2);
    f32x16 acc[2][2];
#pragma unroll
    for (int i = 0; i < 2; ++i)
#pragma unroll
        for (int pt = 0; pt < 2; ++pt)
#pragma unroll
            for (int r = 0; r < 16; ++r) acc[i][pt][r] = 0.f;
#pragma unroll 2
    for (int ks = 0; ks < 8; ++ks) {
        const f32x4 w0 = *(LAS const f32x4*)(WL + hh * 128 + 16 * ks + 8 * h), w1 = *(LAS const f32x4*)(WL + hh * 128 + 16 * ks + 8 * h + 4);
        LAS const unsigned char* xa = XI + (16 * ks + 8 * h + q4) * X4RS + (hl * 64) * 2 + 32 * b16 + 8 * p4;
        LAS const unsigned char* ba = BI + (16 * ks + 8 * h + q4) * BRS + (nt0 * 32) * 2 + 32 * b16 + 8 * p4;
        bf16x8 xf[2];
#pragma unroll
        for (int pt = 0; pt < 2; ++pt) {
            const s16x4 lo = tr16(xa + pt * 64), hi = tr16(xa + 4 * X4RS + pt * 64);
            u32x4 sc;
            sc.x = cvtpk(bf2f((unsigned short)lo[0]) * w0[0], bf2f((unsigned short)lo[1]) * w0[1]); sc.y = cvtpk(bf2f((unsigned short)lo[2]) * w0[2], bf2f((unsigned short)lo[3]) * w0[3]);
            sc.z = cvtpk(bf2f((unsigned short)hi[0]) * w1[0], bf2f((unsigned short)hi[1]) * w1[1]); sc.w = cvtpk(bf2f((unsigned short)hi[2]) * w1[2], bf2f((unsigned short)hi[3]) * w1[3]);
            xf[pt] = __builtin_bit_cast(bf16x8, sc);
        }
#pragma unroll
        for (int i = 0; i < 2; ++i) {
            const bf16x8 bfr = cat8(tr16(ba + i * 64), tr16(ba + 4 * BRS + i * 64));
            acc[i][0] = MFMA32(bfr, xf[0], acc[i][0]); acc[i][1] = MFMA32(bfr, xf[1], acc[i][1]);
        }
    }
    bf16* st = C.ST + ((size_t)((b * NCH + c) * NH + g * 8 + hh)) * (HD * NST);
#pragma unroll
    for (int i = 0; i < 2; ++i)
#pragma unroll
        for (int pt = 0; pt < 2; ++pt)
#pragma unroll
            for (int gq = 0; gq < 4; gq += 2) { u32x2 wa, wb;
                wa.x = cvtpk(acc[i][pt][4 * gq], acc[i][pt][4 * gq + 1]); wa.y = cvtpk(acc[i][pt][4 * gq + 2], acc[i][pt][4 * gq + 3]);
                wb.x = cvtpk(acc[i][pt][4 * gq + 4], acc[i][pt][4 * gq + 5]); wb.y = cvtpk(acc[i][pt][4 * gq + 6], acc[i][pt][4 * gq + 7]);
                const int ks = 2 * (nt0 + i) + (gq >> 1);
                *(u32x4*)(st + ((size_t)(pt * 8 + ks) * 64 + lane) * 8) = widen16(wa, wb); }
}
__device__ __forceinline__ void ssd_states_run(Ctx& C, int u0, int stride, int uend) {
    if (u0 >= uend) return;
    u32x4 ra[19], rb[19];
    st_load_raw<0>(C, u0, ra);
    for (int u = u0; u < uend; u += stride) {
        const int un = u + stride < uend ? u + stride : u;
        st_step<0>(C, u, u, ra, rb);
        st_step<1>(C, u, un, rb, ra);
    }
    __syncthreads();
}

__device__ __forceinline__ void phase_scan_fast(Ctx& C) {
    const int total = NB * NH * HD * NST / 8;
    for (int e = C.bid * NTHREADS + C.tid; e < total; e += C.G * NTHREADS) {
        const int pn = e & 1023, hd = (e >> 10) & 15, b = e >> 14;
        float carry[8];
#pragma unroll
        for (int k = 0; k < 8; ++k) carry[k] = 0.f;
        u32x4* p = (u32x4*)(C.ST + ((size_t)(b * NCH * NH + hd)) * (HD * NST)) + pn;
        const float* dc = C.CDEC + b * NCH * NH + hd;
        for (int c0 = 0; c0 < NCH; c0 += 8) {
            u32x4 sv[8]; float dv[8];
#pragma unroll
            for (int i = 0; i < 8; ++i) { sv[i] = p[(size_t)(c0 + i) * NH * 1024]; dv[i] = dc[(c0 + i) * NH]; }
#pragma unroll
            for (int i = 0; i < 8; ++i) {
                const u32x4 s = sv[i]; const float dec = dv[i];
                u32x4 o; o.x = cvtpk(carry[0], carry[1]); o.y = cvtpk(carry[2], carry[3]); o.z = cvtpk(carry[4], carry[5]); o.w = cvtpk(carry[6], carry[7]);
                p[(size_t)(c0 + i) * NH * 1024] = o;
                carry[0] = carry[0] * dec + bf2f(s.x); carry[1] = carry[1] * dec + bf2f(s.x >> 16); carry[2] = carry[2] * dec + bf2f(s.y); carry[3] = carry[3] * dec + bf2f(s.y >> 16);
                carry[4] = carry[4] * dec + bf2f(s.z); carry[5] = carry[5] * dec + bf2f(s.z >> 16); carry[6] = carry[6] * dec + bf2f(s.w); carry[7] = carry[7] * dec + bf2f(s.w >> 16);
            }
        }
    }
}

constexpr int BCRS = 272;
__device__ __forceinline__ void ssd_out_fast(Ctx& C, int u) {
    const int g = u & 1, c = (u >> 1) & 31, b = u >> 6, t0 = c * CHK, rowbase = b * SEQ + t0;
    LAS unsigned char* L = (LAS unsigned char*)C.lds;
    LAS unsigned char* BI = L;
    LAS unsigned char* CI = L + 34816;
    LAS unsigned char* XI = L + 69632;
    LAS float* AC = (LAS float*)(L + 143360);
    LAS float* DL = AC + 1024;
    LAS float* ssl = DL + 1024;
    LAS float* rsl = ssl + 128;
    const int lane = C.lane, r32 = lane & 31, h = lane >> 5, q4 = (lane & 15) >> 2, p4 = lane & 3, b16 = (lane >> 4) & 1, w = C.wave;
    int tq = C.tid; asm volatile("" : "+v"(tq));
    u32x4 xq[8];
#pragma unroll
    for (int i = 0; i < 8; ++i) { const int idx = tq + NTHREADS * i, row = idx >> 5, cc = idx & 31; xq[i] = *(const u32x4*)(C.PROJ + (size_t)((rowbase >> 7) * 2 + g) * XUNIT + row * XUW + cc * 8); }
    const f32x2_t ddq = *(const f32x2_t*)(C.DT + ((size_t)(rowbase >> 7) * 16 + g * 8 + w) * 128 + 2 * lane); const float alq = C.a_log[g * 8 + w];
    __syncthreads();
    TSTART(40);
    {
        const float A = -expf(alq), d0 = ddq.x, d1 = ddq.y, a1 = d1 * A;
        float v = d0 * A + a1;
#pragma unroll
        for (int o = 1; o < 64; o <<= 1) { const float t = __shfl_up(v, o); if (lane >= o) v += t; }
        const float c1 = v, c0 = v - a1;
        AC[w * 128 + 2 * lane] = c0 * 1.4426950408889634f; AC[w * 128 + 2 * lane + 1] = c1 * 1.4426950408889634f;
        DL[w * 128 + 2 * lane] = d0; DL[w * 128 + 2 * lane + 1] = d1; }
    if (C.tid < 128) ssl[C.tid] = 0.f;
#pragma unroll
    for (int i = 0; i < 8; ++i) { const int idx = tq + NTHREADS * i, row = idx >> 5, cc = idx & 31;
        const u32x4 v = *(const u32x4*)(C.PROJ + (size_t)((rowbase >> 7) * 2 + g) * XUNIT + (256 + row) * XUW + cc * 8);
        *(LAS u32x4*)((cc < 16 ? BI : CI) + row * BCRS + (cc & 15) * 16) = v; }
#pragma unroll
    for (int i = 0; i < 8; ++i) { const int idx = tq + NTHREADS * i, row = idx >> 5, cc = idx & 31; *(LAS u32x4*)(XI + row * X4RS + cc * 16) = xq[i]; }
    TSTOP(40);
    for (int ps = 0; ps < 2; ++ps) {
        TSTART(41);
        if (ps == 1) {
            __syncthreads();
#pragma unroll
            for (int i = 0; i < 8; ++i) { const int idx = tq + NTHREADS * i, row = idx >> 5, cc = idx & 31; *(LAS u32x4*)(XI + row * X4RS + cc * 16) = xq[i]; }
        }
        __syncthreads();
        TSTOP(41);
        const int hl = w & 3, hh = ps * 4 + hl, hd = g * 8 + hh;
        const float dsk = C.d_skip[hd];
        const bf16* prev = C.ST + ((size_t)((b * NCH + c) * NH + hd)) * (HD * NST);
        f32x16 yoff[2][2];
        {   bf16x8 pf[2][8];
#pragma unroll
            for (int pt = 0; pt < 2; ++pt)
#pragma unroll
                for (int ks = 0; ks < 8; ++ks) pf[pt][ks] = *(const bf16x8*)(prev + ((size_t)(pt * 8 + ks) * 64 + lane) * 8);
#pragma unroll
            for (int li = 0; li < 2; ++li) {
                const int lt = (w >> 2) ? (1 + li) : (3 * li), l = 32 * lt + r32;
                bf16x8 cf[8];
#pragma unroll
                for (int ks = 0; ks < 8; ++ks) cf[ks] = *(LAS const bf16x8*)(CI + l * BCRS + (16 * ks + 8 * h) * 2);
#pragma unroll
                for (int r = 0; r < 16; ++r) { yoff[li][0][r] = 0.f; yoff[li][1][r] = 0.f; }
#pragma unroll
                for (int pt = 0; pt < 2; ++pt)
#pragma unroll
                    for (int ks = 0; ks < 8; ++ks) yoff[li][pt] = MFMA32(pf[pt][ks], cf[ks], yoff[li][pt]);
                const float el = __builtin_amdgcn_exp2f(AC[hh * 128 + l]);
#pragma unroll
                for (int r = 0; r < 16; ++r) { yoff[li][0][r] *= el; yoff[li][1][r] *= el; }
            }
        }
#pragma unroll
        for (int li = 0; li < 2; ++li) {
            const int lt = (w >> 2) ? (1 + li) : (3 * li);
            const int l = 32 * lt + r32;
            f32x16 acc[2];
            acc[0] = yoff[li][0]; acc[1] = yoff[li][1];
            TSTART(42);
            const size_t grow = (size_t)(rowbase + l);
            u32x4 zw[2][2];
#pragma unroll
            for (int pt = 0; pt < 2; ++pt)
#pragma unroll
                for (int kq = 0; kq < 2; ++kq) zw[pt][kq] = *(const u32x4*)(C.ZF + (((((size_t)(rowbase >> 7) * 16 + hd) * 4 + lt) * 2 + pt) * 2 + kq) * 512 + lane * 8);
            bf16x8 cf[8];
#pragma unroll
            for (int ks = 0; ks < 8; ++ks) cf[ks] = *(LAS const bf16x8*)(CI + l * BCRS + (16 * ks + 8 * h) * 2);
            const float al = AC[hh * 128 + l];
            TSTOP(42); TSTART(43);
            for (int st = 0; st <= lt; ++st) {
                f32x16 X;
#pragma unroll
                for (int r = 0; r < 16; ++r) X[r] = 0.f;
#pragma unroll
                for (int ks = 0; ks < 8; ++ks) { const bf16x8 bfr = *(LAS const bf16x8*)(BI + (32 * st + r32) * BCRS + (16 * ks + 8 * h) * 2); X = MFMA32(bfr, cf[ks], X); }
#pragma unroll
                for (int gq = 0; gq < 4; ++gq) {
                    const int s0 = 32 * st + 8 * gq + 4 * h;
                    const f32x4 as = *(LAS const f32x4*)(AC + hh * 128 + s0), ds = *(LAS const f32x4*)(DL + hh * 128 + s0);
#pragma unroll
                    for (int i = 0; i < 4; ++i) { const float e = __builtin_amdgcn_exp2f(fminf(al - as[i], 0.f)) * ds[i]; X[4 * gq + i] = (s0 + i <= l) ? X[4 * gq + i] * e : 0.f; }
                }
                LAS const unsigned char* xa = XI + (32 * st + 4 * h + q4) * X4RS + (hl * 64) * 2 + 32 * b16 + 8 * p4;
#pragma unroll
                for (int tq = 0; tq < 2; ++tq) {
                    const bf16x8 mf = (tq == 0) ? PACK8(X, 0) : PACK8(X, 8);
#pragma unroll
                    for (int pt = 0; pt < 2; ++pt) { const bf16x8 xf = cat8(tr16(xa + (16 * tq) * X4RS + pt * 64), tr16(xa + (16 * tq + 8) * X4RS + pt * 64)); acc[pt] = MFMA32(xf, mf, acc[pt]); }
                }
            }
            TSTOP(43); TSTART(44);
            float sq = 0.f;
#pragma unroll
            for (int pt = 0; pt < 2; ++pt) {
                u32x2 pc[4], zr[2][4];
#pragma unroll
                for (int kq = 0; kq < 2; ++kq) {
                    const auto r0 = __builtin_amdgcn_permlane32_swap(zw[pt][kq].x, zw[pt][kq].z, false, false), r1 = __builtin_amdgcn_permlane32_swap(zw[pt][kq].y, zw[pt][kq].w, false, false);
                    zr[pt][2 * kq].x = r0[0]; zr[pt][2 * kq].y = r1[0]; zr[pt][2 * kq + 1].x = r0[1]; zr[pt][2 * kq + 1].y = r1[1];
                }
#pragma unroll
                for (int gq = 0; gq < 4; ++gq) {
                    const int p0 = 32 * pt + 8 * gq + 4 * h;
                    const u32x2 xv = *(LAS const u32x2*)(XI + l * X4RS + (hl * 64 + p0) * 2);
                    const u32x2 zv = zr[pt][gq];
                    const float y0 = (acc[pt][4 * gq] + dsk * bf2f(xv.x)) * silu_f(bf2f(zv.x)), y1 = (acc[pt][4 * gq + 1] + dsk * bf2f(xv.x >> 16)) * silu_f(bf2f(zv.x >> 16));
                    const float y2 = (acc[pt][4 * gq + 2] + dsk * bf2f(xv.y)) * silu_f(bf2f(zv.y)), y3 = (acc[pt][4 * gq + 3] + dsk * bf2f(xv.y >> 16)) * silu_f(bf2f(zv.y >> 16));
                    sq += y0 * y0 + y1 * y1 + y2 * y2 + y3 * y3;
                    pc[gq].x = cvtpk(y0, y1); pc[gq].y = cvtpk(y2, y3);
                }
                bf16* mp = C.MIX + grow * 2048 + hd * 64 + 32 * pt + 8 * h;
                *(u32x4*)(mp) = widen16(pc[0], pc[1]); *(u32x4*)(mp + 16) = widen16(pc[2], pc[3]);
            }
            sq += __shfl_xor(sq, 32);
            if (h == 0) atomicAdd((float*)(ssl + l), sq);
            TSTOP(44);
        }
        if (ps == 0) {
#pragma unroll
            for (int i = 0; i < 8; ++i) { const int idx = tq + NTHREADS * i, row = idx >> 5, cc = idx & 31; xq[i] = *(const u32x4*)(C.PROJ + (size_t)((rowbase >> 7) * 2 + g) * XUNIT + (128 + row) * XUW + cc * 8); }
        }
    }
    __syncthreads();
    if (C.tid < 128) C.RSG[(size_t)(rowbase + C.tid) * 2 + g] = 1.0f / sqrtf(ssl[C.tid] * (1.0f / 512.f) + EPS);
    __syncthreads();
}

__device__ __forceinline__ void phase_gemm2(Ctx& C) {
    pg8::DenseOrder S; S.init(M, DM, 2048, C.WOUT, C.G, C.bid);
    pg8::EpiResid E{C.x, C.out, C.XN, C.RSG, C.RATT, (LAS float*)((LAS unsigned char*)C.lds + 135168)};
    pg8::gemm_phase<pg8::EpiResid, pg8::DenseOrder, true>((LAS unsigned char*)C.lds, (const char*)C.MIX, 2048, S, E);
}

struct MoeItem { const float* W; int ldw, k0, n0; bf16* WT; int K, drow0; const float* ks; };
__device__ __forceinline__ MoeItem moe_item(const Ctx& C, int it) {
    MoeItem I; const int e = it / 768; int r = it % 768;
    if (r < 512) { const bool up = r >= 256; r &= 255; const int kb = r >> 4, nb = r & 15, n0 = nb * 32;
        I.W = (up ? C.w_up : C.w_gate) + (size_t)e * DM * FF; I.ldw = FF; I.k0 = kb * 64; I.n0 = n0; I.WT = C.WGU + (size_t)e * 1024 * 1024; I.K = DM; I.drow0 = (n0 >> 7) * 256 + (n0 & 127) + (up ? 128 : 0); I.ks = C.norm_ffn; }
    else { r -= 512; const int kb = r >> 5, nb = r & 31;
        I.W = C.w_down + (size_t)e * FF * DM; I.ldw = DM; I.k0 = kb * 64; I.n0 = nb * 32; I.WT = C.WD + (size_t)e * 1024 * FF; I.K = FF; I.drow0 = nb * 32; I.ks = nullptr; }
    return I;
}
__device__ __forceinline__ void moe_convert_item(Ctx& C, int it, LAS float* scr) {
    const int e = it / 768; int r = it % 768;
    if (r < 512) { const bool up = r >= 256; r &= 255; const int kb = r >> 4, nb = r & 15, n0 = nb * 32;
        transpose_item((up ? C.w_up : C.w_gate) + (size_t)e * DM * FF, FF, kb * 64, n0, C.WGU + (size_t)e * 1024 * 1024, DM, (n0 >> 7) * 256 + (n0 & 127) + (up ? 128 : 0), scr, C.lane, C.norm_ffn); }
    else { r -= 512; const int kb = r >> 5, nb = r & 31; transpose_item(C.w_down + (size_t)e * FF * DM, DM, kb * 64, nb * 32, C.WD + (size_t)e * 1024 * FF, FF, nb * 32, scr, C.lane); }
}
constexpr int NREM = (NE - E1) * 512 + (NE - E7) * 256;
__device__ __forceinline__ int rem_item(int j) { if (j < (NE - E1) * 512) return (E1 + j / 512) * 768 + (j % 512); j -= (NE - E1) * 512; return (E7 + j / 256) * 768 + 512 + (j % 256); }
template <class ItemOf> __device__ __forceinline__ void conv_stream(Ctx& C, int j0, int step, int nitems, ItemOf item_of) {
    LAS float* scr = (LAS float*)((LAS unsigned char*)C.lds + C.wave * 8704);
    if (j0 >= nitems) return;
    f32x4 ta[8], tb[8]; f32x4 ka[2], kb2[2];
    MoeItem A = moe_item(C, item_of(j0)), B = A;
    transpose_load(A.W, A.ldw, A.k0, A.n0, C.lane, A.ks, ta, ka);
    for (int j = j0; j < nitems; j += 2 * step) {
        const bool hb = j + step < nitems, ha = j + 2 * step < nitems;
        if (hb) { B = moe_item(C, item_of(j + step)); transpose_load(B.W, B.ldw, B.k0, B.n0, C.lane, B.ks, tb, kb2); }
        transpose_store(ta, ka, A.WT, A.K, A.drow0, A.k0, scr, C.lane);
        if (ha) { A = moe_item(C, item_of(j + 2 * step)); transpose_load(A.W, A.ldw, A.k0, A.n0, C.lane, A.ks, ta, ka); }
        if (hb) transpose_store(tb, kb2, B.WT, B.K, B.drow0, B.k0, scr, C.lane);
    }
}
__device__ __forceinline__ void conv_gateup_early(Ctx& C) { conv_stream(C, C.bid * NWAVES + C.wave, NCONV * NWAVES, E1 * 512, [](int j) { return (j / 512) * 768 + (j % 512); }); }
__device__ __forceinline__ void conv_down_early(Ctx& C) { conv_stream(C, C.bid * NWAVES + C.wave, NCONV * NWAVES, E7 * 256, [](int j) { return (j / 256) * 768 + 512 + (j % 256); }); }
__device__ __forceinline__ void phase_router_fast(Ctx& C) {
    LAS float* scr = (LAS float*)((LAS unsigned char*)C.lds + C.wave * 8704);
    LAS float* PA = (LAS float*)((LAS unsigned char*)C.lds + 71680);
    int cit = C.bid * NWAVES + C.wave;
    const int lane = C.lane, r32 = lane & 31, h = lane >> 5, w = C.wave, tt = w & 3, kh = w >> 2;
    const int gw = C.bid * NWAVES + C.wave, NGW = C.G * NWAVES;
    unsigned* cnt = C.ctl + CW_CNT;
    LAS unsigned* hist = (LAS unsigned*)(PA + 4 * 49 * 64);
    LAS unsigned* hbase = hist + 64;
    TSTART(60);
    for (int rb = C.bid; rb < M / 128; rb += C.G) {
        const int row = rb * 128 + 32 * tt + r32;
        if (C.tid < 64) hist[C.tid] = 0u;
        const bf16* hp = C.XN + (size_t)row * DM + 512 * kh + 8 * h;
        const bf16* whp = C.WRH + ((size_t)(32 * kh) * 64 + lane) * 8;
        const bf16* wlp = C.WRL + ((size_t)(32 * kh) * 64 + lane) * 8;
        f32x16 acc[3];
#pragma unroll
        for (int t = 0; t < 3; ++t)
#pragma unroll
            for (int r = 0; r < 16; ++r) acc[t][r] = 0.f;
        float ss = 0.f;
#pragma unroll 1
        for (int kb = 0; kb < 16; ++kb) {
            u32x4 hv[2]; bf16x8 wh[2][3], wl[2][3];
#pragma unroll
            for (int i = 0; i < 2; ++i) hv[i] = *(const u32x4*)(hp + (kb * 2 + i) * 16);
#pragma unroll
            for (int i = 0; i < 2; ++i)
#pragma unroll
                for (int t = 0; t < 3; ++t) { wh[i][t] = *(const bf16x8*)(whp + ((size_t)t * 64 + kb * 2 + i) * 512); wl[i][t] = *(const bf16x8*)(wlp + ((size_t)t * 64 + kb * 2 + i) * 512); }
            __builtin_amdgcn_sched_barrier(0);
            if (cit < NREM) { moe_convert_item(C, rem_item(cit), scr); cit += NGW; }
            __builtin_amdgcn_sched_barrier(0);
#pragma unroll
            for (int i = 0; i < 2; ++i) {
                const u32x4 a = hv[i];
                const float f0 = bf2f(a.x), f1 = bf2f(a.x >> 16), f2 = bf2f(a.y), f3 = bf2f(a.y >> 16), f4 = bf2f(a.z), f5 = bf2f(a.z >> 16), f6 = bf2f(a.w), f7 = bf2f(a.w >> 16);
                ss += f0 * f0 + f1 * f1 + f2 * f2 + f3 * f3 + f4 * f4 + f5 * f5 + f6 * f6 + f7 * f7;
                const bf16x8 thf = __builtin_bit_cast(bf16x8, a);
#pragma unroll
                for (int t = 0; t < 3; ++t) { acc[t] = MFMA32(wh[i][t], thf, acc[t]); acc[t] = MFMA32(wl[i][t], thf, acc[t]); }
            }
            __builtin_amdgcn_sched_barrier(0);
        }
        __syncthreads();
        if (kh == 1) {
#pragma unroll
            for (int t = 0; t < 3; ++t)
#pragma unroll
                for (int r = 0; r < 16; ++r) PA[(tt * 49 + t * 16 + r) * 64 + lane] = acc[t][r];
            PA[(tt * 49 + 48) * 64 + lane] = ss;
        }
        __syncthreads();
        int es0 = 0, es1 = 0; float gs0 = 0.f, gs1 = 0.f, rstd_s = 0.f; unsigned lp0 = 0u, lp1 = 0u;
        if (kh == 0) {
#pragma unroll
            for (int t = 0; t < 3; ++t)
#pragma unroll
                for (int r = 0; r < 16; ++r) acc[t][r] += PA[(tt * 49 + t * 16 + r) * 64 + lane];
            ss += PA[(tt * 49 + 48) * 64 + lane];
            ss += __shfl_xor(ss, 32);
            const float rstd = 1.0f / sqrtf(ss * (1.0f / DM) + EPS);
            if (h == 0) C.RS[row] = rstd;
            float gm[4], go[4], gl[8];
#pragma unroll
            for (int i = 0; i < 4; ++i) { gm[i] = acc[2][i] * rstd; go[i] = __shfl_xor(gm[i], 32); }
#pragma unroll
            for (int i = 0; i < 4; ++i) { gl[i] = h ? go[i] : gm[i]; gl[4 + i] = h ? gm[i] : go[i]; }
            int gsel = 0; float gmax = gl[0];
#pragma unroll
            for (int c2 = 1; c2 < 8; ++c2) if (gl[c2] > gmax) { gmax = gl[c2]; gsel = c2; }
            float gsum = 0.f;
#pragma unroll
            for (int c2 = 0; c2 < 8; ++c2) gsum += expf(gl[c2] - gmax);
            const float pgrp = 1.0f / gsum;
            float em[4], eo[4], el[8];
#pragma unroll
            for (int i = 0; i < 4; ++i) { float v = acc[0][i];
#pragma unroll
                for (int gg = 1; gg < 8; ++gg) v = (gsel == gg) ? acc[gg >> 2][4 * (gg & 3) + i] : v;
                em[i] = v * rstd; eo[i] = __shfl_xor(em[i], 32); }
#pragma unroll
            for (int i = 0; i < 4; ++i) { el[i] = h ? eo[i] : em[i]; el[4 + i] = h ? em[i] : eo[i]; }
            int i0 = 0; float l0 = el[0];
#pragma unroll
            for (int i = 1; i < 8; ++i) if (el[i] > l0) { l0 = el[i]; i0 = i; }
            int i1 = -1; float l1 = -INFINITY;
#pragma unroll
            for (int i = 0; i < 8; ++i) if (i != i0 && el[i] > l1) { l1 = el[i]; i1 = i; }
            const float e1 = expf(l1 - l0), g0 = pgrp / (1.0f + e1), g1 = pgrp * e1 / (1.0f + e1);
            es0 = gsel * 8 + i0; es1 = gsel * 8 + i1; gs0 = g0; gs1 = g1; rstd_s = rstd;
            if (h == 0) { lp0 = atomicAdd((unsigned*)(hist + es0), 1u); lp1 = atomicAdd((unsigned*)(hist + es1), 1u); }
        }
        __syncthreads();
        if (w == 0) { const unsigned n = hist[lane]; unsigned bs = 0u; if (n) bs = atomicAdd(&cnt[lane], n); hbase[lane] = bs; }
        __syncthreads();
        if (kh == 0 && h == 0) {
            const unsigned p0 = hbase[es0] + lp0, p1 = hbase[es1] + lp1;
            C.TE[row * 2] = es0; C.TP[row * 2] = (int)p0; C.LIST[(size_t)es0 * LISTCAP + p0] = row * 2; C.LG[(size_t)es0 * LISTCAP + p0] = gs0; C.LRS[(size_t)es0 * LISTCAP + p0] = rstd_s;
            C.TE[row * 2 + 1] = es1; C.TP[row * 2 + 1] = (int)p1; C.LIST[(size_t)es1 * LISTCAP + p1] = row * 2 + 1; C.LG[(size_t)es1 * LISTCAP + p1] = gs1; C.LRS[(size_t)es1 * LISTCAP + p1] = rstd_s;
        }
    }
    __syncthreads();
    TSTOP(60); TSTART(61);
    conv_stream(C, cit, NGW, NREM, [](int j) { return rem_item(j); });
    TSTOP(61);
}

struct MoeTab { int* cnt; int* pstart; int* tstart; int* texp; };
__device__ __forceinline__ MoeTab moe_tables(Ctx& C, int off) {
    MoeTab T; T.cnt = (int*)(C.lds + off); T.pstart = T.cnt + 64; T.tstart = T.pstart + 65; T.texp = T.tstart + 65;
    __syncthreads();
    if (C.wave == 0) {
        const int ce = (int)__hip_atomic_load(C.ctl + CW_CNT + C.lane, __ATOMIC_RELAXED, __HIP_MEMORY_SCOPE_AGENT);
        const int nt = (ce + 255) >> 8;
        int ts = nt;
#pragma unroll
        for (int o = 1; o < 64; o <<= 1) { const int t = __shfl_up(ts, o); if (C.lane >= o) ts += t; }
        const int tex = ts - nt;
        T.cnt[C.lane] = ce; T.tstart[C.lane] = tex; T.pstart[C.lane] = tex << 8;
        if (C.lane == 63) { T.tstart[64] = ts; T.pstart[64] = ts << 8; }
        for (int j = 0; j < nt; ++j) T.texp[tex + j] = C.lane;
    }
    __syncthreads();
    return T;
}
constexpr int MOE_TAB_OFF = 132096;
__device__ __forceinline__ MoeTab moe_tables_built(Ctx& C, int off) { MoeTab T; T.cnt = (int*)(C.lds + off); T.pstart = T.cnt + 64; T.tstart = T.pstart + 65; T.texp = T.tstart + 65; return T; }
__device__ __forceinline__ void phase_moe_a(Ctx& C) {
    const MoeTab T = moe_tables(C, MOE_TAB_OFF);
    if (C.bid < NCONV) { conv_down_early(C); return; }
    const int G2 = C.G - NCONV, b2 = C.bid - NCONV, vcu2 = (G2 % 8 == 0) ? (b2 % 8) * (G2 / 8) + b2 / 8 : b2;
    pg8::MoeOrder<true> S{T.cnt, T.pstart, T.tstart, T.texp, C.LIST, (const char*)C.WGU, (size_t)1024 * 1024 * 2, DM, T.tstart[64], G2, vcu2};
    pg8::EpiHid E{C.HID, C.LIST, C.LRS, (LAS float*)((LAS unsigned char*)C.lds + 135168)};
    pg8::gemm_phase<pg8::EpiHid, pg8::MoeOrder<true>, true>((LAS unsigned char*)C.lds, (const char*)C.XN, DM, S, E);
}
__device__ __forceinline__ void phase_moe_b(Ctx& C) {
    const MoeTab T = ONE_LAUNCH ? moe_tables_built(C, MOE_TAB_OFF) : moe_tables(C, MOE_TAB_OFF);
    pg8::MoeOrder<false> S{T.cnt, T.pstart, T.tstart, T.texp, C.LIST, (const char*)C.WD, (size_t)1024 * FF * 2, FF, T.tstart[64], C.G, C.vcu};
    pg8::EpiYb E{C.YB, C.LIST, C.LG, (LAS float*)((LAS unsigned char*)C.lds + 135168)};
    pg8::gemm_phase<pg8::EpiYb, pg8::MoeOrder<false>, true>((LAS unsigned char*)C.lds, (const char*)C.HID, FF, S, E);
}
__device__ __forceinline__ void phase_final(Ctx& C) {
    const MoeTab T = ONE_LAUNCH ? moe_tables_built(C, MOE_TAB_OFF) : moe_tables(C, MOE_TAB_OFF);
    f32x4 gfin[4];
#pragma unroll
    for (int j = 0; j < 4; ++j) gfin[j] = ((const f32x4*)C.norm_final)[C.lane + 64 * j];
    for (int rb = C.bid; rb < M / 128; rb += C.G) {
        const int row0 = rb * 128 + C.wave * 16;
        int sl; { const int L = C.lane & 31; const int te = C.TE[row0 * 2 + L], tp = C.TP[row0 * 2 + L]; sl = T.pstart[te] + tp; }
        u32x2 hq[2][4], aq[2][4], cq[2][4];
#define FIN_LOAD(i_, s_) do { const size_t s0_ = (size_t)__builtin_amdgcn_readlane(sl, 2 * (i_)), s1_ = (size_t)__builtin_amdgcn_readlane(sl, 2 * (i_) + 1); \
        _Pragma("unroll") for (int j = 0; j < 4; ++j) { hq[s_][j] = ((const u32x2*)(C.XN + (size_t)(row0 + (i_)) * DM) + C.lane)[64 * j]; \
            aq[s_][j] = ((const u32x2*)(C.YB + s0_ * DM) + C.lane)[64 * j]; cq[s_][j] = ((const u32x2*)(C.YB + s1_ * DM) + C.lane)[64 * j]; } } while (0)
        FIN_LOAD(0, 0); FIN_LOAD(1, 1);
#pragma unroll
        for (int i = 0; i < 16; ++i) {
            const int row = row0 + i;
            u32x2 hb[4], ya[4], yc[4];
#pragma unroll
            for (int j = 0; j < 4; ++j) { hb[j] = hq[i & 1][j]; ya[j] = aq[i & 1][j]; yc[j] = cq[i & 1][j]; }
            if (i + 2 < 16) FIN_LOAD(i + 2, i & 1);
            f32x4 v[4];
            float ss = 0.f;
#pragma unroll
            for (int j = 0; j < 4; ++j) { const u32x2 hh = hb[j], a = ya[j], c = yc[j];
                v[j][0] = bf2f(hh.x) + bf2f(a.x) + bf2f(c.x); v[j][1] = bf2f(hh.x >> 16) + bf2f(a.x >> 16) + bf2f(c.x >> 16);
                v[j][2] = bf2f(hh.y) + bf2f(a.y) + bf2f(c.y); v[j][3] = bf2f(hh.y >> 16) + bf2f(a.y >> 16) + bf2f(c.y >> 16);
                ss += v[j][0] * v[j][0] + v[j][1] * v[j][1] + v[j][2] * v[j][2] + v[j][3] * v[j][3]; }
            const float rstd = 1.0f / sqrtf(wave_sum(ss) * (1.0f / DM) + EPS);
            f32x4* hr = (f32x4*)(C.out + (size_t)row * DM) + C.lane;
#pragma unroll
            for (int j = 0; j < 4; ++j) __builtin_nontemporal_store(v[j] * rstd * gfin[j], hr + 64 * j);
            __builtin_amdgcn_sched_barrier(0);
        }
#undef FIN_LOAD
    }
}

constexpr int NPHASE = 10;
__global__ void __launch_bounds__(NTHREADS, 2) fwd_kernel(Args args) {
    extern __shared__ __attribute__((aligned(16))) unsigned char lds[];
    Ctx C;
    C.tph0 = 0; C.tphd = 0;
    C.lds = lds; C.tid = threadIdx.x; C.lane = C.tid & 63; C.wave = __builtin_amdgcn_readfirstlane(C.tid >> 6); C.G = gridDim.x; C.bid = blockIdx.x;
    C.x = args.in[0]; C.norm_mix = args.in[1]; C.w_in = args.in[2]; C.conv_w = args.in[3]; C.conv_b = args.in[4]; C.dt_bias = args.in[5]; C.a_log = args.in[6]; C.d_skip = args.in[7];
    C.ssd_norm = args.in[8]; C.sinks = args.in[9]; C.attn_norm = args.in[10]; C.w_out = args.in[11]; C.norm_ffn = args.in[12]; C.w_rg = args.in[13]; C.w_re = args.in[14];
    C.w_gate = args.in[15]; C.w_up = args.in[16]; C.w_down = args.in[17]; C.norm_final = args.in[18];
    C.out = args.out; C.ws = args.ws;
    unsigned char* ws = args.ws;
    C.ctl = (unsigned*)(ws + WS_CTL);
    C.XN = (bf16*)(ws + WS_XN); C.DT = (float*)(ws + WS_DT); C.PROJ = (bf16*)(ws + WS_PROJ); C.HID = (bf16*)(ws + WS_HID); C.YB = (bf16*)(ws + WS_YB);
    C.ST = (bf16*)(ws + WS_ST); C.MIX = (bf16*)(ws + WS_MIX); C.CDEC = (float*)(ws + WS_CDEC); C.TE = (int*)(ws + WS_TE); C.TP = (int*)(ws + WS_TP); C.TG = (float*)(ws + WS_TG);
    C.LIST = (int*)(ws + WS_LIST); C.WIN = (bf16*)(ws + WS_WIN); C.WOUT = (bf16*)(ws + WS_WOUT); C.WGU = (bf16*)args.out; C.ZF = (bf16*)(ws + WS_ZF); C.QF = (bf16*)(ws + WS_QF);            C.WD = (bf16*)(ws + WS_WD); C.HALO = (bf16*)(ws + WS_HALO); C.WRH = (bf16*)(ws + WS_WRH); C.WRL = (bf16*)(ws + WS_WRL); C.RS = (float*)(ws + WS_RS); C.RATT = C.RS + M; C.RSG = C.RS + 2 * M; C.LRS = (float*)(ws + WS_WGU); C.LG = C.LRS + (size_t)NE * LISTCAP;
    C.vcu = (C.G % 8 == 0) ? (C.bid % 8) * (C.G / 8) + C.bid / 8 : C.bid;
    TSTART(9999);
    volatile LAS unsigned* MISC = (volatile LAS unsigned*)((LAS unsigned char*)lds + MISC_OFF);
    if (C.tid < 64) MISC[C.tid] = 0u;
    __syncthreads();
    XcdBarrier bar; bar.bar = C.ctl + CW_BAR; bar.x = 0; bar.st = nullptr;
#if ONE_LAUNCH
    bar = xcd_barrier_post(C.ctl + CW_BAR, MISC + 8);
#define GRID_BAR() xcd_barrier(bar)
#else
#define GRID_BAR() do {} while (0)
#endif
    const int lo = args.ph_lo, hi = args.ph_hi;
#define IN(k) (lo <= (k) && (k) < hi)
#define SEAM(k) do { if (IN(k) && IN((k) + 1)) GRID_BAR(); } while (0)
#define REP(k) for (int _rep = 0; _rep < ((k) == RPH ? 2 : 1); ++_rep)
    TSTART(0); if (IN(0)) { REP(0) phase_prologue(C); } SEAM(0); TSTOP(0);
    TSTART(1); if (IN(1)) { if (C.bid < NCONV) conv_gateup_early(C); else phase_gemm1(C); } SEAM(1); TSTOP(1);
    TSTART(2); if (IN(2)) {
        const bool af = (C.bid >> 3) & 1;
        if (af) { for (int u = C.bid; u < NB * 32; u += C.G) attn_unit_fast(C, u); }
        ssd_states_run(C, C.bid, C.G, NB * NCH * 2);
        if (!af) { for (int u = C.bid; u < NB * 32; u += C.G) attn_unit_fast(C, u); } } SEAM(2); TSTOP(2);
    TSTART(3); if (IN(3)) { phase_scan_fast(C); } SEAM(3); TSTOP(3);
    TSTART(4); if (IN(4)) { REP(4) for (int u = C.bid; u < NB * NCH * 2; u += C.G) ssd_out_fast(C, u); } SEAM(4); TSTOP(4);
    TSTART(5); if (IN(5)) { REP(5) phase_gemm2(C); } SEAM(5); TSTOP(5);
    TSTART(6); if (IN(6)) { phase_router_fast(C); } SEAM(6); TSTOP(6);
    TSTART(7); if (IN(7)) { REP(7) phase_moe_a(C); } SEAM(7); TSTOP(7);
    TSTART(8); if (IN(8)) { REP(8) phase_moe_b(C); } SEAM(8); TSTOP(8);
    TSTART(9); if (IN(9)) { phase_final(C); } TSTOP(9); TSTOP(9999);
#ifdef TPH
    if (C.tid == 0) { const unsigned long long te = __builtin_amdgcn_s_memrealtime(); while (__builtin_amdgcn_s_memrealtime() - te < C.tphd) __builtin_amdgcn_s_sleep(8); }
#endif
}

extern "C" void kernel_launch(void* const* d_in, const int* in_sizes, int n_in, void* d_out, int out_size, void* d_ws, size_t ws_size, hipStream_t stream) {
    static int grid = 0;
    if (grid == 0) {
        if (n_in != 19 || in_sizes[0] != M * DM || out_size != M * DM || ws_size < WS_END) { fprintf(stderr, "kernel_launch: unexpected shapes (n_in %d, in0 %d, out %d, ws %zu)\n", n_in, n_in > 0 ? in_sizes[0] : -1, out_size, ws_size); grid = -1; return; }
        int dev = 0, cus = 0, per_cu = 0;
        if (hipGetDevice(&dev) != hipSuccess || hipDeviceGetAttribute(&cus, hipDeviceAttributeMultiprocessorCount, dev) != hipSuccess) { grid = -1; return; }
        if (hipFuncSetAttribute((const void*)fwd_kernel, hipFuncAttributeMaxDynamicSharedMemorySize, LDS_BYTES) != hipSuccess) { fprintf(stderr, "kernel_launch: hipFuncSetAttribute failed\n"); grid = -1; return; }
        if (hipOccupancyMaxActiveBlocksPerMultiprocessor(&per_cu, (const void*)fwd_kernel, NTHREADS, LDS_BYTES) != hipSuccess || per_cu < 1) { fprintf(stderr, "kernel_launch: occupancy query says %d\n", per_cu); (void)hipGetLastError(); per_cu = 1; }
        grid = cus;
    }
    if (grid < 0) return;
    (void)hipMemsetAsync((char*)d_ws + WS_CTL, 0, CTL_BYTES, stream);
    Args a{};
    for (int i = 0; i < 19; ++i) a.in[i] = (const float*)d_in[i];
    a.out = (float*)d_out; a.ws = (unsigned char*)d_ws;
#if ONE_LAUNCH
    a.ph_lo = 0; a.ph_hi = NPHASE;
    hipLaunchKernelGGL(fwd_kernel, dim3(grid), dim3(NTHREADS), LDS_BYTES, stream, a);
#else
    for (int p = 0; p < NPHASE; ++p) { a.ph_lo = p; a.ph_hi = p + 1; hipLaunchKernelGGL(fwd_kernel, dim3(grid), dim3(NTHREADS), LDS_BYTES, stream, a); }
#endif
}
```
